# Optimizing an MI355X kernel written in HIP

```python
import jax, jax.numpy as jnp
from jax import lax
import numpy as np

D_MODEL = 1024
BATCH = 2
SEQ = 8192
DEPTH = 4

GLA_HEADS = 4
GLA_DK = 128
GLA_DV = 128
GLA_LOWRANK = 16
GLA_GATE_NORM = 16.0
GLA_CHUNK = 64
MOBA_HEADS = 8
MOBA_HD = 64
MOBA_BLOCK = 256
MOBA_TOPK = 3
MOBA_QCHUNK = 64
ROPE_THETA = 10000.0
MLSTM_HEADS = 4
MLSTM_DQK = 64
MLSTM_DV = 128
MLSTM_CHUNK = 64
MLSTM_CONV = 4
D_FF = 4 * D_MODEL
N_BRANCH = 3
EPS = 1e-6

GLA_K = GLA_HEADS * GLA_DK
GLA_V = GLA_HEADS * GLA_DV
MOBA_W = MOBA_HEADS * MOBA_HD
MLSTM_QK = MLSTM_HEADS * MLSTM_DQK
MLSTM_V = MLSTM_HEADS * MLSTM_DV
IN_SPLITS = (GLA_K, GLA_K, GLA_V, GLA_V, GLA_LOWRANK,
             MOBA_W, MOBA_W, MOBA_W,
             MLSTM_QK, MLSTM_QK, MLSTM_V, MLSTM_V, MLSTM_HEADS, MLSTM_HEADS,
             N_BRANCH * D_MODEL)
D_IN = sum(IN_SPLITS)

kernel_name = "hybrid_gla_moba_mlstm_block"


def rms_norm(x, g):
    xf = x.astype(jnp.float32)
    y = xf * lax.rsqrt(jnp.mean(xf * xf, axis=-1, keepdims=True) + EPS)
    return (y * g.astype(jnp.float32)).astype(x.dtype)


def split_heads(x, h):
    b, t, _ = x.shape
    return x.reshape(b, t, h, -1).transpose(0, 2, 1, 3)


def merge_heads(x):
    b, h, t, d = x.shape
    return x.transpose(0, 2, 1, 3).reshape(b, t, h * d)


def rope_tables(seq, dim):
    inv = 1.0 / (ROPE_THETA ** (jnp.arange(0, dim, 2, dtype=jnp.float32) / dim))
    ang = jnp.arange(seq, dtype=jnp.float32)[:, None] * inv[None, :]
    return jnp.cos(ang), jnp.sin(ang)


def apply_rope(x, cos, sin):
    x1, x2 = jnp.split(x, 2, axis=-1)
    return jnp.concatenate([x1 * cos - x2 * sin, x2 * cos + x1 * sin], axis=-1)


def causal_dwconv(x, w):
    wd, c = w.shape
    return lax.conv_general_dilated(x, w[:, None, :], window_strides=(1,), padding=((wd - 1, 0),),
                                    dimension_numbers=('NWC', 'WIO', 'NWC'), feature_group_count=c)


def gla_mixer(q, k, v, log_a):
    b, h, t, dk = q.shape
    dv = v.shape[-1]
    L = GLA_CHUNK
    n = t // L
    qc = (q * dk ** -0.5).reshape(b, h, n, L, dk)
    kc = k.reshape(b, h, n, L, dk)
    vc = v.reshape(b, h, n, L, dv)
    bcum = jnp.cumsum(log_a.reshape(b, h, n, L, dk), axis=3)
    b_last = bcum[:, :, :, -1:, :]
    q_dec = qc * jnp.exp(bcum)
    k_inv = kc * jnp.exp(-bcum)
    k_end = kc * jnp.exp(b_last - bcum)
    causal = jnp.tril(jnp.ones((L, L), dtype=bool))
    attn = jnp.where(causal, jnp.einsum('bhnid,bhnjd->bhnij', q_dec, k_inv), 0.0)
    o_intra = jnp.einsum('bhnij,bhnjv->bhniv', attn, vc)
    chunk_kv = jnp.einsum('bhnld,bhnlv->bhndv', k_end, vc)
    decay = jnp.exp(b_last[:, :, :, 0, :])

    def step(S, inp):
        dec, kv = inp
        return dec[..., None] * S + kv, S

    S0 = jnp.zeros((b, h, dk, dv), q.dtype)
    _, S_prev = lax.scan(step, S0, (jnp.moveaxis(decay, 2, 0), jnp.moveaxis(chunk_kv, 2, 0)))
    S_prev = jnp.moveaxis(S_prev, 0, 2)
    o_inter = jnp.einsum('bhnld,bhndv->bhnlv', q_dec, S_prev)
    return (o_intra + o_inter).reshape(b, h, t, dv)


def moba_mixer(q, k, v):
    b, h, t, d = q.shape
    t_pad = -(-t // MOBA_BLOCK) * MOBA_BLOCK
    pad = ((0, 0), (0, 0), (0, t_pad - t), (0, 0))
    q, k, v = jnp.pad(q, pad), jnp.pad(k, pad), jnp.pad(v, pad)
    nb = t_pad // MOBA_BLOCK
    k_sel = min(MOBA_TOPK, nb)
    scale = d ** -0.5
    k_blocks = k.reshape(b, h, nb, MOBA_BLOCK, d)
    v_blocks = v.reshape(b, h, nb, MOBA_BLOCK, d)
    k_mean = jnp.mean(k_blocks, axis=3)
    pos = jnp.arange(t_pad)
    past = jnp.arange(nb)[None, :] < (pos // MOBA_BLOCK)[:, None]
    gate = jnp.einsum('bhtd,bhnd->bhtn', q, k_mean)
    gate = jnp.where(past, gate, -jnp.inf)
    top_val, top_idx = lax.top_k(gate, k_sel)
    valid = jnp.isfinite(top_val)
    bi = jnp.arange(b)[:, None, None, None]
    hi = jnp.arange(h)[None, :, None, None]
    qn = MOBA_QCHUNK

    def chunk_fn(c):
        start = c * qn
        qc = lax.dynamic_slice_in_dim(q, start, qn, axis=2)
        idx = lax.dynamic_slice_in_dim(top_idx, start, qn, axis=2)
        ok = lax.dynamic_slice_in_dim(valid, start, qn, axis=2)
        kg = k_blocks[bi, hi, idx]
        vg = v_blocks[bi, hi, idx]
        s_sel = jnp.einsum('bhqd,bhqskd->bhqsk', qc, kg) * scale
        s_sel = jnp.where(ok[..., None], s_sel, -jnp.inf).reshape(b, h, qn, k_sel * MOBA_BLOCK)
        own_start = (start // MOBA_BLOCK) * MOBA_BLOCK
        ko = lax.dynamic_slice_in_dim(k, own_start, MOBA_BLOCK, axis=2)
        vo = lax.dynamic_slice_in_dim(v, own_start, MOBA_BLOCK, axis=2)
        s_own = jnp.einsum('bhqd,bhkd->bhqk', qc, ko) * scale
        qpos = start + jnp.arange(qn)
        kpos = own_start + jnp.arange(MOBA_BLOCK)
        s_own = jnp.where(kpos[None, :] <= qpos[:, None], s_own, -jnp.inf)
        p = jax.nn.softmax(jnp.concatenate([s_sel, s_own], axis=-1).astype(jnp.float32), axis=-1)
        p_sel = p[..., :k_sel * MOBA_BLOCK].reshape(b, h, qn, k_sel, MOBA_BLOCK)
        p_own = p[..., k_sel * MOBA_BLOCK:]
        return (jnp.einsum('bhqsk,bhqskd->bhqd', p_sel, vg)
                + jnp.einsum('bhqk,bhkd->bhqd', p_own, vo))

    outs = lax.map(chunk_fn, jnp.arange(t_pad // qn))
    out = outs.transpose(1, 2, 0, 3, 4).reshape(b, h, t_pad, d)
    return out[:, :, :t]


def mlstm_mixer(q, k, v, log_i, log_f):
    b, h, t, dk = q.shape
    dv = v.shape[-1]
    L = MLSTM_CHUNK
    n = t // L
    qc = q.reshape(b, h, n, L, dk)
    kc = (k * dk ** -0.5).reshape(b, h, n, L, dk)
    vc = v.reshape(b, h, n, L, dv)
    li = log_i.reshape(b, h, n, L)
    bcum = jnp.cumsum(log_f.reshape(b, h, n, L), axis=-1)
    b_last = bcum[..., -1]
    causal = jnp.tril(jnp.ones((L, L), dtype=bool))
    logD = jnp.where(causal, bcum[..., :, None] - bcum[..., None, :] + li[..., None, :], -jnp.inf)
    log_end = b_last[..., None] - bcum + li
    m_local = jnp.max(log_end, axis=-1)
    w_loc = jnp.exp(log_end - m_local[..., None])
    chunk_kv = jnp.einsum('bhnl,bhnld,bhnlv->bhndv', w_loc, kc, vc)
    chunk_k = jnp.einsum('bhnl,bhnld->bhnd', w_loc, kc)

    def step(carry, inp):
        S, nv, m = carry
        bl, ml, ckv, ck = inp
        m_new = jnp.maximum(bl + m, ml)
        a = jnp.exp(bl + m - m_new)
        c = jnp.exp(ml - m_new)
        S_new = a[..., None, None] * S + c[..., None, None] * ckv
        n_new = a[..., None] * nv + c[..., None] * ck
        return (S_new, n_new, m_new), (S, nv, m)

    init = (jnp.zeros((b, h, dk, dv), q.dtype), jnp.zeros((b, h, dk), q.dtype), jnp.zeros((b, h), q.dtype))
    xs = (jnp.moveaxis(b_last, 2, 0), jnp.moveaxis(m_local, 2, 0),
          jnp.moveaxis(chunk_kv, 2, 0), jnp.moveaxis(chunk_k, 2, 0))
    _, (S_prev, n_prev, m_prev) = lax.scan(step, init, xs)
    S_prev = jnp.moveaxis(S_prev, 0, 2)
    n_prev = jnp.moveaxis(n_prev, 0, 2)
    m_prev = jnp.moveaxis(m_prev, 0, 2)
    m_inter = bcum + m_prev[..., None]
    m_row = jnp.maximum(m_inter, jnp.max(logD, axis=-1))
    s = jnp.einsum('bhnid,bhnjd->bhnij', qc, kc) * jnp.exp(logD - m_row[..., None])
    inter_w = jnp.exp(m_inter - m_row)
    num = (jnp.einsum('bhnij,bhnjv->bhniv', s, vc)
           + inter_w[..., None] * jnp.einsum('bhnid,bhndv->bhniv', qc, S_prev))
    den = jnp.sum(s, axis=-1) + inter_w * jnp.einsum('bhnid,bhnd->bhni', qc, n_prev)
    hid = num / jnp.maximum(jnp.abs(den), jnp.exp(-m_row))[..., None]
    return hid.reshape(b, h, t, dv)


def hybrid_layer(x, cos, sin, norm1_g, w_in, gla_a_up, gla_a_b, gla_norm_g, moba_qn_g, moba_kn_g,
                 mlstm_conv_w, mlstm_i_b, mlstm_f_b, mlstm_norm_g, gate_b, w_br_gla, w_br_moba,
                 w_br_mlstm, w_out, norm2_g, w_ff1, w_ff2):
    dt = x.dtype
    f32 = jnp.float32
    bsz, t, _ = x.shape
    hn = rms_norm(x, norm1_g)
    proj = hn @ w_in
    offsets = np.cumsum(IN_SPLITS)[:-1].tolist()
    (g_q, g_k, g_v, g_g, g_a, m_q, m_k, m_v,
     l_q, l_k, l_v, l_o, l_i, l_f, br_gate) = jnp.split(proj, offsets, axis=-1)

    log_a = jax.nn.log_sigmoid((g_a @ gla_a_up + gla_a_b).astype(f32)) / GLA_GATE_NORM
    o_gla = gla_mixer(split_heads(g_q.astype(f32), GLA_HEADS), split_heads(g_k.astype(f32), GLA_HEADS),
                      split_heads(g_v.astype(f32), GLA_HEADS), split_heads(log_a, GLA_HEADS))
    o_gla = rms_norm(o_gla, gla_norm_g)
    y_gla = (merge_heads(o_gla) * jax.nn.silu(g_g.astype(f32))).astype(dt)

    mq = apply_rope(rms_norm(split_heads(m_q.astype(f32), MOBA_HEADS), moba_qn_g), cos, sin)
    mk = apply_rope(rms_norm(split_heads(m_k.astype(f32), MOBA_HEADS), moba_kn_g), cos, sin)
    mv = split_heads(m_v.astype(f32), MOBA_HEADS)
    y_moba = merge_heads(moba_mixer(mq, mk, mv)).astype(dt)

    qk = causal_dwconv(jnp.concatenate([l_q, l_k], axis=-1).astype(f32), mlstm_conv_w.astype(f32))
    lq, lk = jnp.split(qk, 2, axis=-1)
    log_i = (l_i + mlstm_i_b).astype(f32).transpose(0, 2, 1)
    log_f = jax.nn.log_sigmoid((l_f + mlstm_f_b).astype(f32)).transpose(0, 2, 1)
    h_ml = mlstm_mixer(split_heads(lq, MLSTM_HEADS), split_heads(lk, MLSTM_HEADS),
                       split_heads(l_v.astype(f32), MLSTM_HEADS), log_i, log_f)
    h_ml = rms_norm(h_ml, mlstm_norm_g)
    y_mlstm = (merge_heads(h_ml) * jax.nn.sigmoid(l_o.astype(f32))).astype(dt)

    gates = jax.nn.sigmoid(br_gate + gate_b).reshape(bsz, t, N_BRANCH, D_MODEL)
    mixed = (gates[:, :, 0] * (y_gla @ w_br_gla)
             + gates[:, :, 1] * (y_moba @ w_br_moba)
             + gates[:, :, 2] * (y_mlstm @ w_br_mlstm))
    x = x + mixed @ w_out

    h2 = rms_norm(x, norm2_g)
    x = x + jnp.square(jax.nn.relu(h2 @ w_ff1)) @ w_ff2
    return x


def setup_inputs(seed: int = 0) -> dict:
    key = jax.random.key(seed)
    ks = jax.random.split(key, 24)

    def nrm(k, shape, fan_in):
        return jax.random.normal(k, shape, jnp.float32) * (fan_in ** -0.5)

    def gain(k, shape):
        return 1.0 + 0.02 * jax.random.normal(k, shape, jnp.float32)

    f_bias = (jnp.linspace(3.0, 6.0, MLSTM_HEADS, dtype=jnp.float32)[None, :]
              + 0.1 * jax.random.normal(ks[10], (DEPTH, MLSTM_HEADS), jnp.float32))
    return {
        "x": jax.random.normal(ks[0], (BATCH, SEQ, D_MODEL), jnp.float32),
        "norm1_g": gain(ks[1], (DEPTH, D_MODEL)),
        "w_in": nrm(ks[2], (DEPTH, D_MODEL, D_IN), D_MODEL),
        "gla_a_up": nrm(ks[3], (DEPTH, GLA_LOWRANK, GLA_K), GLA_LOWRANK),
        "gla_a_b": 0.02 * jax.random.normal(ks[4], (DEPTH, GLA_K), jnp.float32),
        "gla_norm_g": gain(ks[5], (DEPTH, GLA_DV)),
        "moba_qn_g": gain(ks[6], (DEPTH, MOBA_HD)),
        "moba_kn_g": gain(ks[7], (DEPTH, MOBA_HD)),
        "mlstm_conv_w": nrm(ks[8], (DEPTH, MLSTM_CONV, 2 * MLSTM_QK), MLSTM_CONV),
        "mlstm_i_b": 0.1 * jax.random.normal(ks[9], (DEPTH, MLSTM_HEADS), jnp.float32),
        "mlstm_f_b": f_bias,
        "mlstm_norm_g": gain(ks[11], (DEPTH, MLSTM_DV)),
        "gate_b": 0.02 * jax.random.normal(ks[12], (DEPTH, N_BRANCH * D_MODEL), jnp.float32),
        "w_br_gla": nrm(ks[13], (DEPTH, GLA_V, D_MODEL), GLA_V),
        "w_br_moba": nrm(ks[14], (DEPTH, MOBA_W, D_MODEL), MOBA_W),
        "w_br_mlstm": nrm(ks[15], (DEPTH, MLSTM_V, D_MODEL), MLSTM_V),
        "w_out": nrm(ks[16], (DEPTH, D_MODEL, D_MODEL), D_MODEL),
        "norm2_g": gain(ks[17], (DEPTH, D_MODEL)),
        "w_ff1": nrm(ks[18], (DEPTH, D_MODEL, D_FF), D_MODEL),
        "w_ff2": nrm(ks[19], (DEPTH, D_FF, D_MODEL), D_FF),
    }


def reference(x, norm1_g, w_in, gla_a_up, gla_a_b, gla_norm_g, moba_qn_g, moba_kn_g, mlstm_conv_w,
              mlstm_i_b, mlstm_f_b, mlstm_norm_g, gate_b, w_br_gla, w_br_moba, w_br_mlstm, w_out,
              norm2_g, w_ff1, w_ff2):
    cos, sin = rope_tables(x.shape[1], MOBA_HD)
    for l in range(DEPTH):
        x = hybrid_layer(x, cos, sin, norm1_g[l], w_in[l], gla_a_up[l], gla_a_b[l], gla_norm_g[l],
                         moba_qn_g[l], moba_kn_g[l], mlstm_conv_w[l], mlstm_i_b[l], mlstm_f_b[l],
                         mlstm_norm_g[l], gate_b[l], w_br_gla[l], w_br_moba[l], w_br_mlstm[l], w_out[l],
                         norm2_g[l], w_ff1[l], w_ff2[l])
    return x
```

```cpp
#include <hip/hip_runtime.h>
#include <cstdio>
#include <cstdint>
#include <cmath>
namespace ref {
constexpr int B_ = 2, T_ = 8192, D_ = 1024, M_ = B_ * T_, DEPTH_ = 4, D_IN_ = 8216, D_FF_ = 4096;
constexpr int OFF_GQ = 0, OFF_GK = 512, OFF_GV = 1024, OFF_GG = 1536, OFF_GA = 2048, OFF_MQ = 2064, OFF_MK = 2576, OFF_MV = 3088,
              OFF_LQ = 3600, OFF_LK = 3856, OFF_LV = 4112, OFF_LO = 4624, OFF_LI = 5136, OFF_LF = 5140, OFF_BG = 5144;
constexpr float EPS_ = 1e-6f;

__device__ __forceinline__ float wsum(float v) {
#pragma unroll
    for (int o = 1; o < 64; o <<= 1) v += __shfl_xor(v, o);
    return v;
}
__device__ __forceinline__ float wmax(float v) {
#pragma unroll
    for (int o = 1; o < 64; o <<= 1) v = fmaxf(v, __shfl_xor(v, o));
    return v;
}
__device__ __forceinline__ float log_sigmoid(float x) { return fminf(x, 0.f) - log1pf(expf(-fabsf(x))); }
__device__ __forceinline__ float sigmoidf(float x) { return 1.f / (1.f + expf(-x)); }

struct EpiStore { float* C; long ldc; __device__ void operator()(int m, int n, float a) const { C[(size_t)m * ldc + n] = a; } };
struct EpiGate {
    float* mixed; const float* bg; const float* gate_b; long br; long first;
    __device__ void operator()(int m, int n, float a) const {
        const float g = sigmoidf(bg[(size_t)m * 3072 + br * 1024 + n] + gate_b[br * 1024 + n]);
        float* p = mixed + (size_t)m * 1024 + n;
        *p = first ? g * a : (*p + g * a);
    }
};
struct EpiResid { const float* xin; float* out; __device__ void operator()(int m, int n, float a) const { out[(size_t)m * 1024 + n] = xin[(size_t)m * 1024 + n] + a; } };
struct EpiRelu2 { float* H; __device__ void operator()(int m, int n, float a) const { const float r = fmaxf(a, 0.f); H[(size_t)m * 4096 + n] = r * r; } };

template <class Epi>
__global__ void __launch_bounds__(256) gemm_f32(const float* __restrict__ A, const float* __restrict__ W, Epi epi, long lda_, long ldw_, long N_, long K_) {
    const int lda = (int)lda_, ldw = (int)ldw_, N = (int)N_, K = (int)K_;
    __shared__ float As[16][132];
    __shared__ float Bs[16][132];
    const int bm = blockIdx.y * 128, bn = blockIdx.x * 128, tid = threadIdx.x, ty = tid >> 4, tx = tid & 15;
    float acc[8][8];
#pragma unroll
    for (int i = 0; i < 8; ++i)
#pragma unroll
        for (int j = 0; j < 8; ++j) acc[i][j] = 0.f;
    for (int k0 = 0; k0 < K; k0 += 16) {
        {
            const int r = tid >> 1, kk = (tid & 1) * 8;
            const float* p = A + (size_t)(bm + r) * lda + k0 + kk;
            const float4 a0 = *(const float4*)p, a1 = *(const float4*)(p + 4);
            As[kk + 0][r] = a0.x; As[kk + 1][r] = a0.y; As[kk + 2][r] = a0.z; As[kk + 3][r] = a0.w;
            As[kk + 4][r] = a1.x; As[kk + 5][r] = a1.y; As[kk + 6][r] = a1.z; As[kk + 7][r] = a1.w;
        }
#pragma unroll
        for (int i = 0; i < 8; ++i) {
            const int kk = (tid >> 7) + 2 * i, nn = tid & 127;
            Bs[kk][nn] = (bn + nn < N) ? W[(size_t)(k0 + kk) * ldw + bn + nn] : 0.f;
        }
        __syncthreads();
#pragma unroll
        for (int kk = 0; kk < 16; ++kk) {
            float a[8], b[8];
#pragma unroll
            for (int i = 0; i < 8; ++i) a[i] = As[kk][ty * 8 + i];
#pragma unroll
            for (int j = 0; j < 8; ++j) b[j] = Bs[kk][tx * 8 + j];
#pragma unroll
            for (int i = 0; i < 8; ++i)
#pragma unroll
                for (int j = 0; j < 8; ++j) acc[i][j] += a[i] * b[j];
        }
        __syncthreads();
    }
#pragma unroll
    for (int i = 0; i < 8; ++i)
#pragma unroll
        for (int j = 0; j < 8; ++j) { const int m = bm + ty * 8 + i, n = bn + tx * 8 + j; if (n < N) epi(m, n, acc[i][j]); }
}

__global__ void __launch_bounds__(256) rmsnorm_rows(const float* __restrict__ x, const float* __restrict__ g, float* __restrict__ out) {
    const int row = blockIdx.x * 4 + (threadIdx.x >> 6), lane = threadIdx.x & 63;
    const float4* xr = (const float4*)(x + (size_t)row * 1024) + lane;
    float4 v[4]; float s = 0.f;
#pragma unroll
    for (int j = 0; j < 4; ++j) { v[j] = xr[64 * j]; s += v[j].x * v[j].x + v[j].y * v[j].y + v[j].z * v[j].z + v[j].w * v[j].w; }
    const float r = rsqrtf(wsum(s) * (1.f / 1024.f) + EPS_);
    float4* o = (float4*)(out + (size_t)row * 1024) + lane;
#pragma unroll
    for (int j = 0; j < 4; ++j) { const float4 gg = ((const float4*)g)[lane + 64 * j]; o[64 * j] = make_float4(v[j].x * r * gg.x, v[j].y * r * gg.y, v[j].z * r * gg.z, v[j].w * r * gg.w); }
}

__global__ void __launch_bounds__(256) gla_loga(const float* __restrict__ P, const float* __restrict__ a_up, const float* __restrict__ a_b, float* __restrict__ LA) {
    const size_t idx = (size_t)blockIdx.x * 256 + threadIdx.x;
    const int m = (int)(idx >> 9), c = (int)(idx & 511);
    const float* ga = P + (size_t)m * 2064 + 2048;
    float s = a_b[c];
#pragma unroll
    for (int r = 0; r < 16; ++r) s += ga[r] * a_up[r * 512 + c];
    LA[idx] = log_sigmoid(s) * (1.f / 16.f);
}
__global__ void __launch_bounds__(512) gla_rec(const float* __restrict__ P, const float* __restrict__ LA, float* __restrict__ O) {
    const int bh = blockIdx.y, b = bh >> 2, h = bh & 3, w = threadIdx.x >> 6, lane = threadIdx.x & 63, e = blockIdx.x * 8 + w;
    const float scale = 0.08838834764831845f;
    float S0 = 0.f, S1 = 0.f;
    const size_t m0 = (size_t)b * T_;
#pragma unroll 4
    for (int t = 0; t < T_; ++t) {
        const size_t m = m0 + t; const float* pr = P + m * 2064; const float* la = LA + m * 512 + h * 128;
        const float a0 = expf(la[lane]), a1 = expf(la[64 + lane]);
        const float k0 = pr[512 + h * 128 + lane], k1 = pr[512 + h * 128 + 64 + lane];
        const float q0 = pr[h * 128 + lane] * scale, q1 = pr[h * 128 + 64 + lane] * scale;
        const float v = pr[1024 + h * 128 + e];
        S0 = a0 * S0 + k0 * v; S1 = a1 * S1 + k1 * v;
        const float p = wsum(q0 * S0 + q1 * S1);
        if (lane == 0) O[m * 512 + h * 128 + e] = p;
    }
}
template <int ACT>
__global__ void __launch_bounds__(256) head_post(const float* __restrict__ O, const float* __restrict__ gate, const float* __restrict__ g, float* __restrict__ Y, long ldg_) {
    const int ldg = (int)ldg_;
    const size_t wid = (size_t)blockIdx.x * 4 + (threadIdx.x >> 6); const int lane = threadIdx.x & 63;
    const int m = (int)(wid >> 2), h = (int)(wid & 3);
    const float* o = O + (size_t)m * 512 + h * 128;
    const float o0 = o[lane], o1 = o[64 + lane];
    const float r = rsqrtf(wsum(o0 * o0 + o1 * o1) * (1.f / 128.f) + EPS_);
    const float g0 = gate[(size_t)m * ldg + h * 128 + lane], g1 = gate[(size_t)m * ldg + h * 128 + 64 + lane];
    const float a0 = ACT == 0 ? g0 * sigmoidf(g0) : sigmoidf(g0), a1 = ACT == 0 ? g1 * sigmoidf(g1) : sigmoidf(g1);
    Y[(size_t)m * 512 + h * 128 + lane] = o0 * r * g[lane] * a0;
    Y[(size_t)m * 512 + h * 128 + 64 + lane] = o1 * r * g[64 + lane] * a1;
}

__global__ void __launch_bounds__(256) ml_conv(const float* __restrict__ P, const float* __restrict__ cw, float* __restrict__ QK) {
    const size_t idx = (size_t)blockIdx.x * 256 + threadIdx.x;
    const int m = (int)(idx >> 9), c = (int)(idx & 511), t = m % T_;
    float s = 0.f;
#pragma unroll
    for (int j = 0; j < 4; ++j) { const int tt = t - 3 + j; if (tt >= 0) s += cw[j * 512 + c] * P[(size_t)(m - 3 + j) * 1544 + c]; }
    QK[idx] = s;
}
__global__ void __launch_bounds__(512) ml_rec(const float* __restrict__ P, const float* __restrict__ QK, const float* __restrict__ i_b, const float* __restrict__ f_b, float* __restrict__ O) {
    const int bh = blockIdx.y, b = bh >> 2, h = bh & 3, w = threadIdx.x >> 6, lane = threadIdx.x & 63, e = blockIdx.x * 8 + w;
    float C = 0.f, n = 0.f;
    const size_t m0 = (size_t)b * T_; const float ib = i_b[h], fb = f_b[h];
#pragma unroll 4
    for (int t = 0; t < T_; ++t) {
        const size_t m = m0 + t; const float* pr = P + m * 1544;
        const float li = pr[1536 + h] + ib, lf = log_sigmoid(pr[1540 + h] + fb);
        const float f = expf(lf), ig = expf(li);
        const float q = QK[m * 512 + h * 64 + lane], k = QK[m * 512 + 256 + h * 64 + lane] * 0.125f;
        const float v = pr[512 + h * 128 + e];
        C = f * C + ig * v * k; n = f * n + ig * k;
        const float num = wsum(C * q), den = wsum(n * q);
        if (lane == 0) O[m * 512 + h * 128 + e] = num / fmaxf(fabsf(den), 1.f);
    }
}

__global__ void rope_table(float* __restrict__ COS, float* __restrict__ SIN) {
    const int idx = blockIdx.x * 256 + threadIdx.x; const int t = idx >> 5, i = idx & 31;
    const float inv = 1.0f / powf(10000.0f, (float)(2 * i) / 64.0f);
    const float ang = (float)t * inv;
    COS[idx] = cosf(ang); SIN[idx] = sinf(ang);
}
__global__ void __launch_bounds__(256) mb_prep(const float* __restrict__ P, const float* __restrict__ qg, const float* __restrict__ kg, const float* __restrict__ COS, const float* __restrict__ SIN,
                                               float* __restrict__ QN, float* __restrict__ KN) {
    const size_t wid = (size_t)blockIdx.x * 4 + (threadIdx.x >> 6); const int lane = threadIdx.x & 63;
    const int which = (int)(wid & 1), h = (int)((wid >> 1) & 7), m = (int)(wid >> 4), t = m % T_;
    const float x = P[(size_t)m * 1536 + which * 512 + h * 64 + lane];
    const float r = rsqrtf(wsum(x * x) * (1.f / 64.f) + EPS_);
    const float y = x * r * (which ? kg[lane] : qg[lane]);
    const float other = __shfl_xor(y, 32);
    const int i = lane & 31; const float c = COS[t * 32 + i], s = SIN[t * 32 + i];
    const float o = lane < 32 ? (y * c - other * s) : (y * c + other * s);
    (which ? KN : QN)[(size_t)m * 512 + h * 64 + lane] = o;
}
__global__ void __launch_bounds__(256) mb_kmean(const float* __restrict__ KN, float* __restrict__ KM) {
    const int wid = blockIdx.x * 4 + (threadIdx.x >> 6), lane = threadIdx.x & 63;
    const int blk = wid & 31, h = (wid >> 5) & 7, b = wid >> 8;
    float s = 0.f;
    for (int j = 0; j < 256; ++j) s += KN[((size_t)b * T_ + blk * 256 + j) * 512 + h * 64 + lane];
    KM[(size_t)wid * 64 + lane] = s * (1.f / 256.f);
}
__global__ void __launch_bounds__(256) mb_attn(const float* __restrict__ QN, const float* __restrict__ KN, const float* __restrict__ P, const float* __restrict__ KM, float* __restrict__ Y) {
    __shared__ float ps[4][1024];
    const int w = threadIdx.x >> 6, lane = threadIdx.x & 63;
    const size_t qi = (size_t)blockIdx.x * 4 + w;
    const int m = (int)(qi >> 3), h = (int)(qi & 7), b = m / T_, t = m % T_, ib = t >> 8;
    float q[64];
#pragma unroll
    for (int d = 0; d < 64; ++d) q[d] = QN[(size_t)m * 512 + h * 64 + d];
    float g = -INFINITY;
    if (lane < 32 && lane < ib) { const float* km = KM + ((size_t)(b * 8 + h) * 32 + lane) * 64; float s = 0.f;
#pragma unroll
        for (int d = 0; d < 64; ++d) s += q[d] * km[d];
        g = s; }
    int sel[4];
#pragma unroll
    for (int r = 0; r < 3; ++r) {
        float v = g; int idx = lane;
#pragma unroll
        for (int off = 32; off >= 1; off >>= 1) { const float ov = __shfl_xor(v, off); const int oi = __shfl_xor(idx, off); if (ov > v || (ov == v && oi < idx)) { v = ov; idx = oi; } }
        sel[r] = (v == -INFINITY) ? -1 : idx;
        if (lane == idx) g = -INFINITY;
    }
    sel[3] = ib;
    float sc[4][4]; float mx = -INFINITY;
#pragma unroll
    for (int r = 0; r < 4; ++r) {
#pragma unroll
        for (int c = 0; c < 4; ++c) {
            float s = -INFINITY;
            if (sel[r] >= 0) {
                const int kp = sel[r] * 256 + lane + 64 * c;
                if (r < 3 || kp <= t) { const float4* kr = (const float4*)(KN + ((size_t)b * T_ + kp) * 512 + h * 64); float a = 0.f;
#pragma unroll
                    for (int d4 = 0; d4 < 16; ++d4) { const float4 kk = kr[d4]; a += q[4 * d4] * kk.x + q[4 * d4 + 1] * kk.y + q[4 * d4 + 2] * kk.z + q[4 * d4 + 3] * kk.w; }
                    s = a * 0.125f; }
            }
            sc[r][c] = s; mx = fmaxf(mx, s);
        }
    }
    mx = wmax(mx);
    float sum = 0.f;
#pragma unroll
    for (int r = 0; r < 4; ++r)
#pragma unroll
        for (int c = 0; c < 4; ++c) { const float p = (sc[r][c] == -INFINITY) ? 0.f : expf(sc[r][c] - mx); sc[r][c] = p; sum += p; }
    sum = wsum(sum);
    const float inv = 1.f / sum;
#pragma unroll
    for (int r = 0; r < 4; ++r)
#pragma unroll
        for (int c = 0; c < 4; ++c) ps[w][r * 256 + lane + 64 * c] = sc[r][c] * inv;
    __syncthreads();
    float o = 0.f;
#pragma unroll
    for (int r = 0; r < 4; ++r) {
        if (sel[r] < 0) continue;
        const float* vb = P + ((size_t)b * T_ + sel[r] * 256) * 1536 + 1024 + h * 64 + lane;
        for (int j = 0; j < 256; ++j) o += ps[w][r * 256 + j] * vb[(size_t)j * 1536];
    }
    Y[(size_t)m * 512 + h * 64 + lane] = o;
}

constexpr size_t MiB = 1u << 20;
constexpr size_t R_HN = 1 * MiB, R_PROJ = 65 * MiB, R_TMP = 257 * MiB, R_Y = 321 * MiB, R_MIXED = 417 * MiB, R_SMALL = 481 * MiB, R_END = 484 * MiB;
constexpr size_t R_H = R_PROJ;

static void forward(void* const* d_in, float* d_out, unsigned char* ws, hipStream_t st) {
    const float* x = (const float*)d_in[0];
    float* HN = (float*)(ws + R_HN); float* P = (float*)(ws + R_PROJ); float* TMP = (float*)(ws + R_TMP); float* TMP2 = TMP + (size_t)M_ * 512;
    float* Y = (float*)(ws + R_Y); float* MIXED = (float*)(ws + R_MIXED); float* H = (float*)(ws + R_H);
    float* COS = (float*)(ws + R_SMALL); float* SIN = COS + 8192 * 32; float* KM = SIN + 8192 * 32;
    rope_table<<<8192 * 32 / 256, 256, 0, st>>>(COS, SIN);
    for (int l = 0; l < DEPTH_; ++l) {
        const float* xin = (l == 0) ? x : d_out;
        const float* norm1_g = (const float*)d_in[1] + (size_t)l * 1024;
        const float* w_in = (const float*)d_in[2] + (size_t)l * 1024 * D_IN_;
        const float* a_up = (const float*)d_in[3] + (size_t)l * 16 * 512;
        const float* a_b = (const float*)d_in[4] + (size_t)l * 512;
        const float* gla_g = (const float*)d_in[5] + (size_t)l * 128;
        const float* qn_g = (const float*)d_in[6] + (size_t)l * 64;
        const float* kn_g = (const float*)d_in[7] + (size_t)l * 64;
        const float* conv_w = (const float*)d_in[8] + (size_t)l * 4 * 512;
        const float* i_b = (const float*)d_in[9] + (size_t)l * 4;
        const float* f_b = (const float*)d_in[10] + (size_t)l * 4;
        const float* ml_g = (const float*)d_in[11] + (size_t)l * 128;
        const float* gate_b = (const float*)d_in[12] + (size_t)l * 3072;
        const float* w_br[3] = {(const float*)d_in[13] + (size_t)l * 512 * 1024, (const float*)d_in[14] + (size_t)l * 512 * 1024, (const float*)d_in[15] + (size_t)l * 512 * 1024};
        const float* w_out = (const float*)d_in[16] + (size_t)l * 1024 * 1024;
        const float* norm2_g = (const float*)d_in[17] + (size_t)l * 1024;
        const float* w_ff1 = (const float*)d_in[18] + (size_t)l * 1024 * 4096;
        const float* w_ff2 = (const float*)d_in[19] + (size_t)l * 4096 * 1024;

        rmsnorm_rows<<<M_ / 4, 256, 0, st>>>(xin, norm1_g, HN);
        gemm_f32<EpiStore><<<dim3((2064 + 127) / 128, M_ / 128), 256, 0, st>>>(HN, w_in + OFF_GQ, EpiStore{P, 2064}, 1024, D_IN_, 2064, 1024);
        gla_loga<<<M_ * 512 / 256, 256, 0, st>>>(P, a_up, a_b, TMP);
        gla_rec<<<dim3(16, 8), 512, 0, st>>>(P, TMP, TMP2);
        head_post<0><<<M_ * 4 / 4, 256, 0, st>>>(TMP2, P + 1536, gla_g, Y, 2064);
        gemm_f32<EpiStore><<<dim3(1536 / 128, M_ / 128), 256, 0, st>>>(HN, w_in + OFF_MQ, EpiStore{P, 1536}, 1024, D_IN_, 1536, 1024);
        mb_prep<<<M_ * 16 / 4, 256, 0, st>>>(P, qn_g, kn_g, COS, SIN, TMP, TMP2);
        mb_kmean<<<512 / 4, 256, 0, st>>>(TMP2, KM);
        mb_attn<<<M_ * 8 / 4, 256, 0, st>>>(TMP, TMP2, P, KM, Y + (size_t)M_ * 512);
        gemm_f32<EpiStore><<<dim3((1544 + 127) / 128, M_ / 128), 256, 0, st>>>(HN, w_in + OFF_LQ, EpiStore{P, 1544}, 1024, D_IN_, 1544, 1024);
        ml_conv<<<M_ * 512 / 256, 256, 0, st>>>(P, conv_w, TMP);
        ml_rec<<<dim3(16, 8), 512, 0, st>>>(P, TMP, i_b, f_b, TMP2);
        head_post<1><<<M_ * 4 / 4, 256, 0, st>>>(TMP2, P + 1024, ml_g, Y + (size_t)2 * M_ * 512, 1544);
        gemm_f32<EpiStore><<<dim3(3072 / 128, M_ / 128), 256, 0, st>>>(HN, w_in + OFF_BG, EpiStore{P, 3072}, 1024, D_IN_, 3072, 1024);
        for (int br = 0; br < 3; ++br)
            gemm_f32<EpiGate><<<dim3(1024 / 128, M_ / 128), 256, 0, st>>>(Y + (size_t)br * M_ * 512, w_br[br], EpiGate{MIXED, P, gate_b, br, br == 0}, 512, 1024, 1024, 512);
        gemm_f32<EpiResid><<<dim3(1024 / 128, M_ / 128), 256, 0, st>>>(MIXED, w_out, EpiResid{xin, d_out}, 1024, 1024, 1024, 1024);
        rmsnorm_rows<<<M_ / 4, 256, 0, st>>>(d_out, norm2_g, HN);
        gemm_f32<EpiRelu2><<<dim3(4096 / 128, M_ / 128), 256, 0, st>>>(HN, w_ff1, EpiRelu2{H}, 1024, 4096, 4096, 1024);
        gemm_f32<EpiResid><<<dim3(1024 / 128, M_ / 128), 256, 0, st>>>(H, w_ff2, EpiResid{d_out, d_out}, 4096, 1024, 1024, 4096);
    }
}
}
extern "C" void kernel_launch(void* const* d_in, const int* in_sizes, int n_in, void* d_out, int out_size, void* d_ws, size_t ws_size, hipStream_t stream) {
    if (n_in != 20 || out_size != ref::M_ * ref::D_ || ws_size < ref::R_END) { fprintf(stderr, "kernel_launch: unexpected shapes (n_in %d out %d ws %zu)\n", n_in, out_size, ws_size); return; }
    ref::forward(d_in, (float*)d_out, (unsigned char*)d_ws, stream);
}
```

```cpp
#include <hip/hip_runtime.h>
#include <cstdio>
#include <cstdint>
#include <cmath>
#define LAS __attribute__((address_space(3)))
#define GAS __attribute__((address_space(1)))
typedef unsigned short bf16_t;
typedef short bf16x8 __attribute__((ext_vector_type(8)));
typedef short bf16x4 __attribute__((ext_vector_type(4)));
typedef float f32x4 __attribute__((ext_vector_type(4)));
typedef float f32x2 __attribute__((ext_vector_type(2)));
typedef unsigned u32x4 __attribute__((ext_vector_type(4)));
typedef unsigned u32x2 __attribute__((ext_vector_type(2)));
typedef GAS unsigned gu32;
#define RLX_AGENT __ATOMIC_RELAXED, __HIP_MEMORY_SCOPE_AGENT
#define LDS_WAIT() asm volatile("s_waitcnt lgkmcnt(0)" ::: "memory")
#define VM_WAIT() asm volatile("s_waitcnt vmcnt(0)" ::: "memory")

__device__ __forceinline__ unsigned cvt_pk_bf16(float lo, float hi) { unsigned r; asm volatile("v_cvt_pk_bf16_f32 %0, %1, %2" : "=v"(r) : "v"(lo), "v"(hi)); return r; }
__device__ __forceinline__ float bf_lo(unsigned u) { return __uint_as_float(u << 16); }
__device__ __forceinline__ float bf_hi(unsigned u) { return __uint_as_float(u & 0xffff0000u); }
__device__ __forceinline__ float bf2f(bf16_t h) { return __uint_as_float(((unsigned)h) << 16); }
__device__ __forceinline__ bf16_t f2bf(float f) { return (bf16_t)(cvt_pk_bf16(f, 0.f) & 0xffffu); }
__device__ __forceinline__ float wave_sum(float v) {
#pragma unroll
    for (int o = 1; o < 64; o <<= 1) v += __shfl_xor(v, o);
    return v;
}
__device__ __forceinline__ float fast_sigmoid(float x) { return 1.f / (1.f + __expf(-x)); }

namespace pg8 {
constexpr int BM = 256, BK = 64, HALF = 128, HTB = HALF * BK * 2, STAGE_BYTES = 8 * HTB, NXCD = 8, WGM = 8;
__host__ __device__ __forceinline__ int lds_byte(int r, int c) { const int st = (r >> 4) * 2 + (c >> 5), rr = r & 15, cc = c & 31, ob = rr * 64 + cc * 2; return st * 1024 + (ob ^ (((ob >> 9) & 1) << 5)); }
__host__ __device__ __forceinline__ void stage_rc(int b, int& R, int& C) { const int st = b / 1024, sb = b % 1024, swz = sb ^ (((sb >> 9) & 1) << 5); R = (st >> 1) * 16 + swz / 64; C = (st & 1) * 32 + (swz % 64) / 2; }
__host__ __device__ __forceinline__ int perm32(int rho) { const int n = rho >> 4, i = rho & 15; return 8 * (i >> 2) + 4 * n + (i & 3); }

struct Unit { int pm, pn, z; };
struct Gemm { const bf16_t* A; const bf16_t* Bt; };

template <int NN> struct StaticOrder {
    static constexpr int nM = 64, nN = NN, nwg = nM * nN;
    static constexpr size_t ZSA = 0, ZSB = 0;
    int G, c;
    __device__ void init(int G_, int c_) { G = G_; c = c_; }
    __device__ bool next(int i, Unit& u) const {
        const long L = (long)i * G + c; if (L >= nwg) return false;
        int wgid = (int)L; { const int q = nwg / NXCD, r = nwg % NXCD, xcd = wgid % NXCD, off = wgid / NXCD; wgid = (xcd < r ? xcd * (q + 1) : r * (q + 1) + (xcd - r) * q) + off; }
        const int nig = WGM * nN, gid = wgid / nig, fm = gid * WGM, gsz = (nM - fm) < WGM ? (nM - fm) : WGM;
        u.pm = fm + ((wgid % nig) % gsz); u.pn = (wgid % nig) / gsz; u.z = 0; return true;
    }
};
template <int NN, int NZ, size_t ZSA_, size_t ZSB_> struct ZOrder {
    static constexpr size_t ZSA = ZSA_, ZSB = ZSB_;
    StaticOrder<NN> S;
    __device__ void init(int G_, int c_) { S.init(G_, c_); }
    __device__ bool next(int i, Unit& u) const { const bool ok = S.next(i / NZ, u); u.z = i % NZ; return ok; }
};

template <int K, class Epi, class Sched, bool ALIGN_EPI, bool SP2>
__device__ __forceinline__ void gemm_phase(LAS unsigned char* lds, const Gemm g, const Sched& S, const Epi& E) {
    int tid_ = threadIdx.x; asm volatile("" : "+v"(tid_));
    const int tid = tid_, wid = __builtin_amdgcn_readfirstlane(tid >> 6), lane = tid & 63, wr = wid >> 2, wc = wid & 3, fr = lane & 15, fq = lane >> 4;
    constexpr int nt = K / BK, lda = K;
    unsigned voffA[2], voffB[2];
#pragma unroll
    for (int i = 0; i < 2; ++i) { int R, C; stage_rc(tid * 16 + i * 8192, R, C); const int Rb = Epi::PERM ? ((R & ~31) + perm32(R & 31)) : R;
        voffA[i] = (unsigned)(R * lda + C) * 2u; voffB[i] = (unsigned)(Rb * K + C) * 2u; }
    constexpr size_t kstep = (size_t)(BK * 2);
    constexpr size_t hstepA = (size_t)HALF * lda * 2, hstepB = (size_t)HALF * K * 2;
    constexpr size_t tstepA = 2 * hstepA, tstepB = 2 * hstepB;
    const unsigned ldsw = (unsigned)wid * 1024u;
    const int aoff = lds_byte(wr * 64 + fr, fq * 8), boff = lds_byte(wc * 32 + fr, fq * 8);
#define PG8_SA(b, h) (((b) * 2 + (h)) * HTB)
#define PG8_SB(b, h) ((4 + (b) * 2 + (h)) * HTB)
#define PG8_STAGE(bufoff, gbase, voff) do { _Pragma("unroll") for (int _i = 0; _i < 2; ++_i) \
        __builtin_amdgcn_global_load_lds((const unsigned*)((const char*)(gbase) + (voff)[_i]), (LAS unsigned*)(lds + (bufoff) + ldsw + _i * 8192), 16, 0, 0); } while (0)
#define PG8_LDA(dst, b, h) do { _Pragma("unroll") for (int m = 0; m < 4; ++m) _Pragma("unroll") for (int k = 0; k < 2; ++k) dst[m][k] = *(const LAS bf16x8*)(lds + PG8_SA(b, h) + aoff + m * 2048 + k * 1024); } while (0)
#define PG8_LDB(dst, b, h) do { _Pragma("unroll") for (int n = 0; n < 2; ++n) _Pragma("unroll") for (int k = 0; k < 2; ++k) dst[n][k] = *(const LAS bf16x8*)(lds + PG8_SB(b, h) + boff + n * 2048 + k * 1024); } while (0)
#define PG8_MMA(ai, bj, At, Bt) do { __builtin_amdgcn_s_setprio(1); _Pragma("unroll") for (int m = 0; m < 4; ++m) _Pragma("unroll") for (int n = 0; n < 2; ++n) _Pragma("unroll") for (int k = 0; k < 2; ++k) \
        acc[ai][bj][m][n] = __builtin_amdgcn_mfma_f32_16x16x32_bf16(Bt[n][k], At[m][k], acc[ai][bj][m][n], 0, 0, 0); __builtin_amdgcn_s_setprio(0); } while (0)
#define PG8_WAIT_V(n) asm volatile("s_waitcnt vmcnt(" #n ")" ::: "memory")
#define PG8_WAIT_L(n) asm volatile("s_waitcnt lgkmcnt(" #n ")" ::: "memory")
#define PG8_BAR __builtin_amdgcn_s_barrier()
#define PG8_SCHED __builtin_amdgcn_sched_barrier(0)
#define PG8_ABASE(u) ((const char*)g.A + (size_t)(u).z * Sched::ZSA + (size_t)(u).pm * tstepA)
#define PG8_BBASE(u) ((const char*)g.Bt + (size_t)(u).z * Sched::ZSB + (size_t)(u).pn * tstepB)
    Unit cur, nxt; int ui = 0;
    if (!S.next(0, cur)) return;
    f32x4 acc[2][2][4][2];
#pragma unroll
    for (int a = 0; a < 2; ++a)
#pragma unroll
        for (int b = 0; b < 2; ++b)
#pragma unroll
            for (int m = 0; m < 4; ++m)
#pragma unroll
                for (int n = 0; n < 2; ++n) acc[a][b][m][n] = (f32x4){0.f, 0.f, 0.f, 0.f};
    bf16x8 At[4][2], B0[2][2], B1[2][2];
    const char* cA = PG8_ABASE(cur); const char* cB = PG8_BBASE(cur);
    if constexpr (SP2) {
        PG8_STAGE(PG8_SB(0, 0), cB, voffB); PG8_STAGE(PG8_SB(0, 1), cB + hstepB, voffB); PG8_STAGE(PG8_SA(0, 0), cA, voffA); PG8_STAGE(PG8_SA(0, 1), cA + hstepA, voffA);
        if (wr == 1) PG8_BAR;
        PG8_WAIT_V(2); PG8_BAR;
        PG8_STAGE(PG8_SB(1, 0), cB + kstep, voffB); PG8_STAGE(PG8_SA(1, 0), cA + kstep, voffA); PG8_STAGE(PG8_SB(1, 1), cB + hstepB + kstep, voffB);
        PG8_WAIT_V(6); PG8_BAR;
    } else {
        PG8_STAGE(PG8_SB(0, 0), cB, voffB); PG8_STAGE(PG8_SA(0, 0), cA, voffA); PG8_STAGE(PG8_SB(0, 1), cB + hstepB, voffB); PG8_STAGE(PG8_SA(0, 1), cA + hstepA, voffA);
        if (wr == 1) PG8_BAR;
        PG8_WAIT_V(4); PG8_BAR;
        PG8_STAGE(PG8_SB(1, 0), cB + kstep, voffB); PG8_STAGE(PG8_SA(1, 0), cA + kstep, voffA); PG8_STAGE(PG8_SB(1, 1), cB + hstepB + kstep, voffB);
        PG8_WAIT_V(6); PG8_BAR;
    }
    for (;;) {
        const bool has_next = S.next(ui + 1, nxt);
        const char* nA = has_next ? PG8_ABASE(nxt) : cA; const char* nB = has_next ? PG8_BBASE(nxt) : cB;
        for (int t = 0; t < nt; t += 2) {
            const bool last = (t == nt - 2);
            const char* a1 = cA + (size_t)(t + 1) * kstep;
            const char* a2 = last ? nA : cA + (size_t)(t + 2) * kstep; const char* b2 = last ? nB : cB + (size_t)(t + 2) * kstep;
            const char* a3 = a2 + kstep; const char* b3 = b2 + kstep;
            if constexpr (SP2) {
            PG8_LDB(B0, 0, 0); PG8_LDB(B1, 0, 1); PG8_SCHED; PG8_LDA(At, 0, 0); PG8_STAGE(PG8_SA(1, 1), a1 + hstepA, voffA);
            PG8_WAIT_V(8); PG8_WAIT_L(0); PG8_BAR; PG8_MMA(0, 0, At, B0); PG8_MMA(0, 1, At, B1); PG8_BAR; PG8_SCHED;
            PG8_LDA(At, 0, 1); PG8_STAGE(PG8_SB(0, 0), b2, voffB); PG8_STAGE(PG8_SB(0, 1), b2 + hstepB, voffB); PG8_STAGE(PG8_SA(0, 0), a2, voffA);
            PG8_WAIT_V(8); PG8_WAIT_L(0); PG8_BAR; PG8_MMA(1, 0, At, B0); PG8_MMA(1, 1, At, B1); PG8_BAR; PG8_SCHED;
            PG8_LDB(B0, 1, 0); PG8_LDB(B1, 1, 1); PG8_SCHED; PG8_LDA(At, 1, 0); PG8_STAGE(PG8_SA(0, 1), a2 + hstepA, voffA);
            PG8_WAIT_V(8); PG8_WAIT_L(0); PG8_BAR; PG8_MMA(0, 0, At, B0); PG8_MMA(0, 1, At, B1); PG8_BAR; PG8_SCHED;
            PG8_LDA(At, 1, 1); PG8_STAGE(PG8_SB(1, 0), b3, voffB); PG8_STAGE(PG8_SB(1, 1), b3 + hstepB, voffB); PG8_STAGE(PG8_SA(1, 0), a3, voffA);
            PG8_WAIT_V(8); PG8_WAIT_L(0); PG8_BAR; PG8_MMA(1, 0, At, B0); PG8_MMA(1, 1, At, B1); PG8_BAR; PG8_SCHED;
            } else {
            PG8_LDB(B0, 0, 0); PG8_SCHED; PG8_LDA(At, 0, 0); PG8_STAGE(PG8_SA(1, 1), a1 + hstepA, voffA);
            PG8_WAIT_L(8); PG8_BAR; PG8_WAIT_L(0); PG8_MMA(0, 0, At, B0); PG8_BAR; PG8_SCHED;
            PG8_LDB(B1, 0, 1); PG8_STAGE(PG8_SB(0, 0), b2, voffB);
            PG8_BAR; PG8_WAIT_L(0); PG8_MMA(0, 1, At, B1); PG8_BAR;
            PG8_LDA(At, 0, 1); PG8_STAGE(PG8_SA(0, 0), a2, voffA);
            PG8_BAR; PG8_WAIT_L(0); PG8_MMA(1, 0, At, B0); PG8_BAR; PG8_SCHED;
            PG8_STAGE(PG8_SB(0, 1), b2 + hstepB, voffB);
            PG8_WAIT_V(6); PG8_BAR; PG8_MMA(1, 1, At, B1); PG8_BAR;
            PG8_LDB(B0, 1, 0); PG8_SCHED; PG8_LDA(At, 1, 0); PG8_STAGE(PG8_SA(0, 1), a2 + hstepA, voffA);
            PG8_WAIT_L(8); PG8_BAR; PG8_WAIT_L(0); PG8_MMA(0, 0, At, B0); PG8_BAR; PG8_SCHED;
            PG8_LDB(B1, 1, 1); PG8_STAGE(PG8_SB(1, 0), b3, voffB);
            PG8_BAR; PG8_WAIT_L(0); PG8_MMA(0, 1, At, B1); PG8_BAR;
            PG8_LDA(At, 1, 1); PG8_STAGE(PG8_SA(1, 0), a3, voffA);
            PG8_BAR; PG8_WAIT_L(0); PG8_MMA(1, 0, At, B0); PG8_BAR; PG8_SCHED;
            PG8_STAGE(PG8_SB(1, 1), b3 + hstepB, voffB);
            PG8_WAIT_V(6); PG8_BAR; PG8_MMA(1, 1, At, B1); PG8_BAR;
            }
        }
        if constexpr (ALIGN_EPI) { if (wr == 0) PG8_BAR; }
        { int tz = threadIdx.x; asm volatile("" : "+v"(tz)); const int l2 = tz & 63; E(acc, cur, wr, wc, l2 & 15, l2 >> 4); }
        if (!has_next) break;
#pragma unroll
        for (int a = 0; a < 2; ++a)
#pragma unroll
            for (int b = 0; b < 2; ++b)
#pragma unroll
                for (int m = 0; m < 4; ++m)
#pragma unroll
                    for (int n = 0; n < 2; ++n) acc[a][b][m][n] = (f32x4){0.f, 0.f, 0.f, 0.f};
        cur = nxt; cA = nA; cB = nB; ++ui;
        if constexpr (ALIGN_EPI) { if (wr == 1) PG8_BAR; }
    }
    PG8_WAIT_V(0);
    if constexpr (!ALIGN_EPI) { if (wr == 0) PG8_BAR; }
    PG8_BAR;
#undef PG8_SA
#undef PG8_SB
#undef PG8_STAGE
#undef PG8_LDA
#undef PG8_LDB
#undef PG8_MMA
#undef PG8_WAIT_V
#undef PG8_WAIT_L
#undef PG8_BAR
#undef PG8_SCHED
#undef PG8_ABASE
#undef PG8_BBASE
}
}

#define XB_TMO      128
#define XB_XCNT(j)  (256  + 64 * (j))
#define XB_XSUB(j)  (1280 + 64 * (j))
#define XB_XGEN(j)  (2304 + 64 * (j))
#define XB_TOP      3328
#define XB_TOPGEN   3392
#define XCD_BAR_WORDS 3456
#define XB_SPIN_CAP (1u << 18)
__device__ __forceinline__ unsigned xb_ld(unsigned* p)              { return __hip_atomic_load(p, __ATOMIC_RELAXED, __HIP_MEMORY_SCOPE_AGENT); }
__device__ __forceinline__ unsigned xb_add(unsigned* p, unsigned v) { return __hip_atomic_fetch_add(p, v, __ATOMIC_RELAXED, __HIP_MEMORY_SCOPE_AGENT); }
__device__ __forceinline__ unsigned xb_xcc_id() { return (unsigned)__builtin_amdgcn_s_getreg((3 << 11) | 20) & 0xFu; }
#define XB_SPIN(cond, bar) do { unsigned _sp = 0; while (cond) { __builtin_amdgcn_s_sleep(1); \
    if ((++_sp & 255u) == 0u) { if (xb_ld(&(bar)[XB_TMO])) break; if (_sp > XB_SPIN_CAP) { atomicAdd(&(bar)[XB_TMO], 1u); break; } } } } while (0)
struct XcdBarrier { unsigned* bar; unsigned x; volatile LAS unsigned* st; };
__device__ __forceinline__ XcdBarrier xcd_barrier_post(unsigned* bar, volatile LAS unsigned* st) {
    XcdBarrier b; b.bar = bar; b.x = xb_xcc_id(); b.st = st;
    if (threadIdx.x == 0) (void)xb_add(&bar[XB_XCNT(b.x)], 1u);
    return b;
}
__device__ __forceinline__ void xcd_barrier_complete(unsigned* bar, unsigned x, unsigned& nloc, unsigned& nx) {
    const unsigned G = gridDim.x * gridDim.y * gridDim.z;
    unsigned sum, cnt, mine, sp = 0u;
    for (;;) {
        sum = 0u; cnt = 0u; mine = 0u;
#pragma unroll
        for (unsigned j = 0; j < 16; ++j) { const unsigned c = xb_ld(&bar[XB_XCNT(j)]); sum += c; cnt += (c > 0u) ? 1u : 0u; mine = (j == x) ? c : mine; }
        if (sum == G) break;
        __builtin_amdgcn_s_sleep(1);
        if ((++sp & 255u) == 0u) { if (xb_ld(&bar[XB_TMO])) break; if (sp > XB_SPIN_CAP) { atomicAdd(&bar[XB_TMO], 1u); break; } }
    }
    nloc = mine > 0u ? mine : 1u; nx = cnt > 0u ? cnt : 1u;
}
__device__ __forceinline__ void xcd_barrier(const XcdBarrier& b) {
    asm volatile("s_waitcnt vmcnt(0)" ::: "memory");
    __syncthreads();
    if (threadIdx.x == 0) {
        unsigned* bar = b.bar;
        __builtin_amdgcn_s_waitcnt(0);
        unsigned nloc = b.st[0], nx = b.st[1];
        if (nloc == 0u) { xcd_barrier_complete(bar, b.x, nloc, nx); b.st[0] = nloc; b.st[1] = nx; }
        const unsigned old = xb_add(&bar[XB_XSUB(b.x)], 1u);
        const unsigned gen = old / nloc;
        if (old + 1u == (gen + 1u) * nloc) {
            __builtin_amdgcn_fence(__ATOMIC_RELEASE, "agent");
            asm volatile("s_waitcnt vmcnt(0)" ::: "memory");
            const unsigned og = xb_add(&bar[XB_TOP], 1u);
            const unsigned tg = og / nx;
            if (og + 1u == (tg + 1u) * nx) xb_add(&bar[XB_TOPGEN], 1u);
            else XB_SPIN(xb_ld(&bar[XB_TOPGEN]) == tg, bar);
            __builtin_amdgcn_fence(__ATOMIC_ACQUIRE, "agent");
            xb_add(&bar[XB_XGEN(b.x)], 1u);
            asm volatile("s_waitcnt vmcnt(0)" ::: "memory");
        } else {
            XB_SPIN(xb_ld(&bar[XB_XGEN(b.x)]) == gen, bar);
            __builtin_amdgcn_fence(__ATOMIC_ACQUIRE, "agent");
            asm volatile("s_waitcnt vmcnt(0)" ::: "memory");
        }
    }
    __syncthreads();
}
namespace mk {
constexpr int NWAVES = 8, NTHREADS = 512;
constexpr int B_ = 2, T_ = 8192, D_ = 1024, M_ = B_ * T_, DEPTH_ = 4, D_IN_ = 8216, D_FF_ = 4096, NPAD_ = 8448;
constexpr int OFF_GQ = 0, OFF_GK = 512, OFF_GV = 1024, OFF_GG = 1536, OFF_GA = 2048, OFF_MQ = 2064, OFF_MK = 2576, OFF_MV = 3088,
              OFF_LQ = 3600, OFF_LK = 3856, OFF_LV = 4112, OFF_LO = 4624, OFF_LI = 5136, OFF_LF = 5140, OFF_BG = 5144;
constexpr float EPS_ = 1e-6f;
constexpr size_t MiB = 1u << 20;
constexpr size_t WS_CTL = 0, CTL_ZERO_BYTES = 1 * MiB;
constexpr size_t WS_SS = 1 * MiB;
constexpr size_t WS_SMALL = 2 * MiB;
constexpr size_t WS_ROPE = 4 * MiB;
constexpr size_t WS_MISC = 6 * MiB;
constexpr size_t WS_WTS = 8 * MiB;
constexpr size_t WL_WIN = 0, WL_WBR = 16 * MiB + MiB / 2, WL_WOUT = WL_WBR + 3 * MiB, WL_FF1 = WL_WOUT + 2 * MiB, WL_FF2 = WL_FF1 + 8 * MiB, WL_STRIDE = WL_FF2 + 8 * MiB;
static_assert(WL_STRIDE == 37 * MiB + MiB / 2, "weights per layer");
constexpr size_t WS_SEG = 158 * MiB;
constexpr size_t SEG_GQ = 0, SEG_GK = 16 * MiB, SEG_GV = 32 * MiB, SEG_MK = 48 * MiB, SEG_MV = 64 * MiB, SEG_LQ = 80 * MiB, SEG_LK = 88 * MiB, SEG_LV = 96 * MiB,
                 SEG_GG = 112 * MiB, SEG_MQ = 128 * MiB, SEG_LO = 144 * MiB, SEG_BG = 160 * MiB;
constexpr size_t WS_MIXED = WS_SEG;
constexpr size_t WS_MIXB = WS_SEG + 64 * MiB;
constexpr size_t WS_H = WS_SEG;
constexpr size_t WS_ACT = 414 * MiB;
constexpr size_t WS_SCR = 446 * MiB;
constexpr size_t WS_END = 512 * MiB;
static_assert(WS_WTS + 4 * WL_STRIDE <= WS_SEG, "weights fit");
constexpr int CW_BAR = 4096;
constexpr int N_BAR_REGIONS = 16;
constexpr int RING_BYTES = 131072, MISC_OFF = RING_BYTES + 320, LDS_BYTES = 147456;

struct Args { const float* in[20]; float* out; unsigned char* ws; int ph_lo, ph_hi, li, mix; };

struct Frame {
    LAS unsigned char* lds; volatile LAS unsigned* MISC; gu32* ctl; unsigned char* ws;
    int tid, lane, wave, G, vcu;
};

__device__ __forceinline__ int win_src(int n) {
    if (n < 512) return OFF_GQ + n;
    if (n < 1024) return OFF_GK + (n - 512);
    if (n < 1536) return OFF_GV + (n - 1024);
    if (n < 2048) return OFF_MK + (n - 1536);
    if (n < 2560) return OFF_MV + (n - 2048);
    if (n < 2816) return OFF_LQ + (n - 2560);
    if (n < 3072) return OFF_LK + (n - 2816);
    if (n < 3584) return OFF_LV + (n - 3072);
    if (n < 4096) return OFF_GG + (n - 3584);
    if (n < 4608) return OFF_MQ + (n - 4096);
    if (n < 5120) return OFF_LO + (n - 4608);
    if (n < 8192) return OFF_BG + (n - 5120);
    if (n < 8208) return OFF_GA + (n - 8192);
    if (n < 8212) return OFF_LI + (n - 8208);
    if (n < 8216) return OFF_LF + (n - 8212);
    return -1;
}
__device__ __forceinline__ void transpose_item(const float* W, int ldw, bf16_t* WT, int K, int k0, int n0, int sc, LAS float* scr, int lane) {
#pragma unroll 8
    for (int i = 0; i < 32; ++i) { const int kk = 2 * i + (lane >> 5); scr[kk * 33 + (lane & 31)] = sc >= 0 ? W[(size_t)(k0 + kk) * ldw + sc] : 0.f; }
    LDS_WAIT(); asm volatile("" ::: "memory");
    const int c = lane & 7;
#pragma unroll
    for (int j = 0; j < 4; ++j) { const int n = (lane >> 3) + 8 * j; const LAS float* s = scr + (8 * c) * 33 + n;
        u32x4 o; o.x = cvt_pk_bf16(s[0 * 33], s[1 * 33]); o.y = cvt_pk_bf16(s[2 * 33], s[3 * 33]); o.z = cvt_pk_bf16(s[4 * 33], s[5 * 33]); o.w = cvt_pk_bf16(s[6 * 33], s[7 * 33]);
        *(GAS u32x4*)(WT + (size_t)(n0 + n) * K + k0 + 8 * c) = o; }
    LDS_WAIT(); asm volatile("" ::: "memory");
}
constexpr int IT_WIN = 16 * (NPAD_ / 32), IT_BR = 8 * 32, IT_WOUT = 16 * 32, IT_FF1 = 16 * 128, IT_FF2 = 64 * 32;
constexpr int IT_LAYER = IT_WIN + 3 * IT_BR + IT_WOUT + IT_FF1 + IT_FF2;
__device__ __forceinline__ void weights_item(const Args& a, unsigned char* ws, int l, int it, LAS float* scr, int lane) {
    unsigned char* wl = ws + WS_WTS + (size_t)l * WL_STRIDE;
    int r = it;
    if (r < IT_WIN) { const int kb = r / (NPAD_ / 32), nb = r % (NPAD_ / 32); const int sc = win_src(nb * 32 + (lane & 31));
        transpose_item(a.in[2] + (size_t)l * 1024 * D_IN_, D_IN_, (bf16_t*)(wl + WL_WIN), 1024, kb * 64, nb * 32, sc, scr, lane); return; }
    r -= IT_WIN;
    if (r < 3 * IT_BR) { const int z = r / IT_BR, q = r % IT_BR, kb = q / 32, nb = q % 32;
        transpose_item((z == 0 ? a.in[13] : (z == 1 ? a.in[14] : a.in[15])) + (size_t)l * 512 * 1024, 1024, (bf16_t*)(wl + WL_WBR + (size_t)z * MiB), 512, kb * 64, nb * 32, nb * 32 + (lane & 31), scr, lane); return; }
    r -= 3 * IT_BR;
    if (r < IT_WOUT) { const int kb = r / 32, nb = r % 32;
        transpose_item(a.in[16] + (size_t)l * 1024 * 1024, 1024, (bf16_t*)(wl + WL_WOUT), 1024, kb * 64, nb * 32, nb * 32 + (lane & 31), scr, lane); return; }
    r -= IT_WOUT;
    if (r < IT_FF1) { const int kb = r / 128, nb = r % 128;
        transpose_item(a.in[18] + (size_t)l * 1024 * 4096, 4096, (bf16_t*)(wl + WL_FF1), 1024, kb * 64, nb * 32, nb * 32 + (lane & 31), scr, lane); return; }
    r -= IT_FF1;
    { const int kb = r / 32, nb = r % 32;
        transpose_item(a.in[19] + (size_t)l * 4096 * 1024, 1024, (bf16_t*)(wl + WL_FF2), 4096, kb * 64, nb * 32, nb * 32 + (lane & 31), scr, lane); }
}
__device__ __forceinline__ void prep_row(const float* xrow, const float* g, bf16_t* arow, float* ssrow, int lane) {
    const GAS f32x4* xr = (const GAS f32x4*)xrow + lane;
    f32x4 v[4]; float s = 0.f;
#pragma unroll
    for (int j = 0; j < 4; ++j) { v[j] = xr[64 * j]; s += (v[j].x * v[j].x + v[j].y * v[j].y) + (v[j].z * v[j].z + v[j].w * v[j].w); }
    s = wave_sum(s);
    GAS u32x2* o8 = (GAS u32x2*)arow + lane;
#pragma unroll
    for (int j = 0; j < 4; ++j) { const f32x4 gg = ((const GAS f32x4*)g)[lane + 64 * j]; u32x2 w; w.x = cvt_pk_bf16(v[j].x * gg.x, v[j].y * gg.y); w.y = cvt_pk_bf16(v[j].z * gg.z, v[j].w * gg.w); o8[64 * j] = w; }
    if (lane < 16) ssrow[lane] = lane == 0 ? s : 0.f;
}
__device__ __forceinline__ void p0_prologue(Frame& F, const Args& a, int l_lo, int l_hi, bool do_rows) {
    LAS float* scr = (LAS float*)(F.lds + F.wave * 16384);
    const int gw = F.vcu * NWAVES + F.wave, NGW = F.G * NWAVES;
    const int nit = (l_hi - l_lo) * IT_LAYER;
    for (int it = gw; it < nit; it += NGW) weights_item(a, F.ws, l_lo + it / IT_LAYER, it % IT_LAYER, scr, F.lane);
    if (do_rows) {
        for (int m = gw; m < M_; m += NGW) prep_row(a.in[0] + (size_t)m * D_, a.in[1], (bf16_t*)(F.ws + WS_ACT) + (size_t)m * D_, (float*)(F.ws + WS_SS) + (size_t)m * 16, F.lane);
        float* COS = (float*)(F.ws + WS_ROPE); float* SIN = COS + 8192 * 32;
        for (int idx = gw * 64 + F.lane; idx < 8192 * 32; idx += NGW * 64) { const int t = idx >> 5, i = idx & 31;
            const float inv = 1.0f / powf(10000.0f, (float)(2 * i) / 64.0f); const float ang = (float)t * inv; COS[idx] = cosf(ang); SIN[idx] = sinf(ang); }
    }
}

__device__ __forceinline__ void row_rstd(const float* ss, int row0, float (&rs)[2][4]) {
#pragma unroll
    for (int ai = 0; ai < 2; ++ai)
#pragma unroll
        for (int m = 0; m < 4; ++m) { const GAS f32x4* p = (const GAS f32x4*)(ss + (size_t)(row0 + ai * 128 + m * 16) * 16);
            const f32x4 a = p[0], b = p[1], c = p[2], d = p[3];
            const float s = ((a.x + a.y) + (a.z + a.w)) + ((b.x + b.y) + (b.z + b.w)) + ((c.x + c.y) + (c.z + c.w)) + ((d.x + d.y) + (d.z + d.w));
            rs[ai][m] = rsqrtf(s * (1.f / 1024.f) + EPS_); }
}
struct EpiWin {
    static constexpr bool PERM = true;
    bf16_t* seg; float* small_; const float* ss;
    __device__ __forceinline__ void operator()(const f32x4 (&acc)[2][2][4][2], const pg8::Unit& u, int wr, int wc, int fr, int fq) const {
        const int row0 = u.pm * 256 + wr * 64 + fr;
        float rs[2][4]; row_rstd(ss, row0, rs);
        const int pn = u.pn;
        if (pn < 32) {
            int st, width;
            if (pn < 10) { st = pn & ~1; width = 512; } else if (pn < 12) { st = pn; width = 256; } else if (pn < 20) { st = 12 + ((pn - 12) & ~1); width = 512; } else { st = 20; width = 3072; }
            bf16_t* base = seg + (size_t)M_ * 256 * st + (pn - st) * 256 + wc * 32 + 8 * fq;
#pragma unroll
            for (int ai = 0; ai < 2; ++ai)
#pragma unroll
                for (int m = 0; m < 4; ++m) { bf16_t* rowp = base + (size_t)(row0 + ai * 128 + m * 16) * width; const float r = rs[ai][m];
#pragma unroll
                    for (int bj = 0; bj < 2; ++bj) { const f32x4 v0 = acc[ai][bj][m][0] * r, v1 = acc[ai][bj][m][1] * r;
                        u32x4 w; w.x = cvt_pk_bf16(v0[0], v0[1]); w.y = cvt_pk_bf16(v0[2], v0[3]); w.z = cvt_pk_bf16(v1[0], v1[1]); w.w = cvt_pk_bf16(v1[2], v1[3]);
                        *(GAS u32x4*)(rowp + bj * 128) = w; } }
        } else if (wc == 0) {
#pragma unroll
            for (int ai = 0; ai < 2; ++ai)
#pragma unroll
                for (int m = 0; m < 4; ++m) { float* p = small_ + (size_t)(row0 + ai * 128 + m * 16) * 32 + 8 * fq; const float r = rs[ai][m];
                    *(GAS f32x4*)p = acc[ai][0][m][0] * r; *(GAS f32x4*)(p + 4) = acc[ai][0][m][1] * r; }
        }
    }
};
struct EpiFf1 {
    static constexpr bool PERM = true;
    bf16_t* H; const float* ss;
    __device__ __forceinline__ void operator()(const f32x4 (&acc)[2][2][4][2], const pg8::Unit& u, int wr, int wc, int fr, int fq) const {
        const int row0 = u.pm * 256 + wr * 64 + fr;
        float rs[2][4]; row_rstd(ss, row0, rs);
        bf16_t* base = H + u.pn * 256 + wc * 32 + 8 * fq;
#pragma unroll
        for (int ai = 0; ai < 2; ++ai)
#pragma unroll
            for (int m = 0; m < 4; ++m) { bf16_t* rowp = base + (size_t)(row0 + ai * 128 + m * 16) * 4096; const float r = rs[ai][m];
#pragma unroll
                for (int bj = 0; bj < 2; ++bj) { f32x4 v0 = acc[ai][bj][m][0] * r, v1 = acc[ai][bj][m][1] * r;
                    v0 = __builtin_elementwise_max(v0, (f32x4){0.f, 0.f, 0.f, 0.f}); v1 = __builtin_elementwise_max(v1, (f32x4){0.f, 0.f, 0.f, 0.f}); v0 = v0 * v0; v1 = v1 * v1;
                    u32x4 w; w.x = cvt_pk_bf16(v0[0], v0[1]); w.y = cvt_pk_bf16(v0[2], v0[3]); w.z = cvt_pk_bf16(v1[0], v1[1]); w.w = cvt_pk_bf16(v1[2], v1[3]);
                    *(GAS u32x4*)(rowp + bj * 128) = w; } }
    }
};
template <bool LAST> struct EpiRes {
    static constexpr bool PERM = false;
    const float* xin; float* xout; bf16_t* act; float* ss; const float* g;
    __device__ __forceinline__ void operator()(const f32x4 (&acc)[2][2][4][2], const pg8::Unit& u, int wr, int wc, int fr, int fq) const {
        const int row0 = u.pm * 256 + wr * 64 + fr, col0 = u.pn * 256 + wc * 32 + 4 * fq;
        f32x4 gv[2][2];
        if (!LAST) {
#pragma unroll
            for (int bj = 0; bj < 2; ++bj)
#pragma unroll
                for (int n = 0; n < 2; ++n) gv[bj][n] = *(const GAS f32x4*)(g + col0 + bj * 128 + n * 16);
        }
#pragma unroll
        for (int ai = 0; ai < 2; ++ai)
#pragma unroll
            for (int m = 0; m < 4; ++m) { const int row = row0 + ai * 128 + m * 16; const size_t off = (size_t)row * 1024 + col0; float q = 0.f;
#pragma unroll
                for (int bj = 0; bj < 2; ++bj)
#pragma unroll
                    for (int n = 0; n < 2; ++n) { const size_t o2 = off + bj * 128 + n * 16; const f32x4 x = *(const GAS f32x4*)(xin + o2) + acc[ai][bj][m][n];
                        *(GAS f32x4*)(xout + o2) = x;
                        if (!LAST) { q += (x[0] * x[0] + x[1] * x[1]) + (x[2] * x[2] + x[3] * x[3]); const f32x4 a = x * gv[bj][n];
                            u32x2 w; w.x = cvt_pk_bf16(a[0], a[1]); w.y = cvt_pk_bf16(a[2], a[3]); *(GAS u32x2*)(act + o2) = w; } }
                if (!LAST) { q += __shfl_xor(q, 16); q += __shfl_xor(q, 32); if (fq == 0) ss[(size_t)row * 16 + u.pn * 4 + wc] = q; }
                if (m & 1) asm volatile("" ::: "memory"); }
    }
};
struct EpiBranch {
    static constexpr bool PERM = false;
    const bf16_t* bg; const float* gate_b; float* mixed; bf16_t* mixb;
    __device__ __forceinline__ void operator()(const f32x4 (&acc)[2][2][4][2], const pg8::Unit& u, int wr, int wc, int fr, int fq) const {
        const int row0 = u.pm * 256 + wr * 64 + fr, col0 = u.pn * 256 + wc * 32 + 4 * fq, z = u.z;
        f32x4 gb[2][2];
#pragma unroll
        for (int bj = 0; bj < 2; ++bj)
#pragma unroll
            for (int n = 0; n < 2; ++n) gb[bj][n] = *(const GAS f32x4*)(gate_b + z * 1024 + col0 + bj * 128 + n * 16);
#pragma unroll
        for (int ai = 0; ai < 2; ++ai)
#pragma unroll
            for (int m = 0; m < 4; ++m) { const int row = row0 + ai * 128 + m * 16;
#pragma unroll
                for (int bj = 0; bj < 2; ++bj)
#pragma unroll
                    for (int n = 0; n < 2; ++n) { const int c = col0 + bj * 128 + n * 16;
                        const u32x2 br = *(const GAS u32x2*)(bg + (size_t)row * 3072 + z * 1024 + c);
                        f32x4 gt; gt[0] = fast_sigmoid(bf_lo(br.x) + gb[bj][n][0]); gt[1] = fast_sigmoid(bf_hi(br.x) + gb[bj][n][1]); gt[2] = fast_sigmoid(bf_lo(br.y) + gb[bj][n][2]); gt[3] = fast_sigmoid(bf_hi(br.y) + gb[bj][n][3]);
                        f32x4 v = acc[ai][bj][m][n] * gt; float* mp = mixed + (size_t)row * 1024 + c;
                        if (z == 0) { *(GAS f32x4*)mp = v; }
                        else { v = v + *(const GAS f32x4*)mp;
                            if (z == 1) { *(GAS f32x4*)mp = v; }
                            else { u32x2 w; w.x = cvt_pk_bf16(v[0], v[1]); w.y = cvt_pk_bf16(v[2], v[3]); *(GAS u32x2*)(mixb + (size_t)row * 1024 + c) = w; } } }
                if (m & 1) asm volatile("" ::: "memory"); }
    }
};
}
namespace mk {
constexpr size_t SCR_GLA_KV = 36 * MiB;
constexpr size_t MISC_GLA_DT = 256 * 1024;
constexpr int GL_QD = 0, GL_KI = 17408, GL_KET = 34816, GL_VT = 53248, GL_ST = 71680, GL_DEC = 106496, GL_GA = 107008, GL_BC = 111104, GL_NRM = 113152, GL_END = 115200;
constexpr int P128 = 136, P64 = 72;

__device__ __forceinline__ bf16x8 lds16(const LAS bf16_t* p) { return *(const LAS bf16x8*)p; }
__device__ __forceinline__ bf16x8 lds8x2(const LAS bf16_t* p0, const LAS bf16_t* p1) {
    const bf16x4 a = *(const LAS bf16x4*)p0, b = *(const LAS bf16x4*)p1;
    return __builtin_shufflevector(a, b, 0, 1, 2, 3, 4, 5, 6, 7);
}
__device__ __forceinline__ bf16x8 pack8(const f32x4 a, const f32x4 b) {
    u32x4 w; w.x = cvt_pk_bf16(a[0], a[1]); w.y = cvt_pk_bf16(a[2], a[3]); w.z = cvt_pk_bf16(b[0], b[1]); w.w = cvt_pk_bf16(b[2], b[3]);
    return __builtin_bit_cast(bf16x8, w);
}
#define MFMA16(a, b, c) __builtin_amdgcn_mfma_f32_16x16x32_bf16((a), (b), (c), 0, 0, 0)

template <bool PASS_C>
__device__ __forceinline__ void gla_unit(LAS unsigned char* lds, const Args& args, int l, int u) {
    int tid_ = threadIdx.x; asm volatile("" : "+v"(tid_));
    const int tid = tid_, lane = tid & 63, w = __builtin_amdgcn_readfirstlane(tid >> 6), lr = lane & 15, lg = lane >> 4;
    const int bh = u >> 5, sc = u & 31, b = bh >> 2, h = bh & 3;
    const size_t mbase = (size_t)b * T_ + (size_t)sc * 256;
    unsigned char* ws = args.ws; asm volatile("" : "+s"(ws));
    const bf16_t* GQ = (const bf16_t*)(ws + WS_SEG + SEG_GQ) + h * 128; const bf16_t* GK = (const bf16_t*)(ws + WS_SEG + SEG_GK) + h * 128;
    const bf16_t* GV = (const bf16_t*)(ws + WS_SEG + SEG_GV) + h * 128; bf16_t* GG = (bf16_t*)(ws + WS_SEG + SEG_GG) + h * 128;
    const float* SMALL = (const float*)(ws + WS_SMALL);
    float* KV = (float*)(ws + WS_SCR + SCR_GLA_KV) + (size_t)u * 16384; float* DT = (float*)(ws + WS_MISC + MISC_GLA_DT) + (size_t)u * 128;
    LAS bf16_t* QD = (LAS bf16_t*)(lds + GL_QD); LAS bf16_t* KI = (LAS bf16_t*)(lds + GL_KI); LAS bf16_t* KET = (LAS bf16_t*)(lds + GL_KET);
    LAS bf16_t* VT = (LAS bf16_t*)(lds + GL_VT); LAS bf16_t* ST = (LAS bf16_t*)(lds + GL_ST);
    LAS float* DEC = (LAS float*)(lds + GL_DEC); LAS float* GA = (LAS float*)(lds + GL_GA); LAS float* BC = (LAS float*)(lds + GL_BC); LAS float* NRM = (LAS float*)(lds + GL_NRM);
    const int d = tid & 127, tq = tid >> 7;
    float aup[16];
    { const float* a_up = args.in[3] + (size_t)l * 16 * 512 + h * 128 + d;
#pragma unroll
      for (int r = 0; r < 16; ++r) aup[r] = a_up[r * 512]; }
    const float ab = args.in[4][(size_t)l * 512 + h * 128 + d];
    const float scale = 0.08838834764831845f;
    f32x4 S[8];
    if (PASS_C) {
#pragma unroll
        for (int et = 0; et < 8; ++et) {
#pragma unroll
            for (int r = 0; r < 4; ++r) S[et][r] = KV[(size_t)(16 * w + 4 * lg + r) * 128 + 16 * et + lr];
            u32x2 pk; pk.x = cvt_pk_bf16(S[et][0], S[et][1]); pk.y = cvt_pk_bf16(S[et][2], S[et][3]);
            *(LAS u32x2*)(ST + (16 * et + lr) * P128 + 16 * w + 4 * lg) = pk;
        }
    } else {
#pragma unroll
        for (int et = 0; et < 8; ++et) S[et] = (f32x4){0.f, 0.f, 0.f, 0.f};
    }
    float dsum = 0.f;
    for (int c = 0; c < 4; ++c) {
        const size_t mrow = mbase + (size_t)c * 64;
        __syncthreads();
        if (tid < 256) *(LAS f32x4*)(GA + tid * 4) = *(const GAS f32x4*)(SMALL + (mrow + (tid >> 2)) * 32 + (tid & 3) * 4);
        __syncthreads();
        float cs[16]; float run = 0.f;
#pragma unroll
        for (int i = 0; i < 16; ++i) { const LAS f32x4* gp = (const LAS f32x4*)(GA + (tq * 16 + i) * 16); float z = ab;
#pragma unroll
            for (int r4 = 0; r4 < 4; ++r4) { const f32x4 g4 = gp[r4]; z += g4[0] * aup[4 * r4] + g4[1] * aup[4 * r4 + 1] + g4[2] * aup[4 * r4 + 2] + g4[3] * aup[4 * r4 + 3]; }
            const float la = (fminf(z, 0.f) - __logf(1.f + __expf(-fabsf(z)))) * (1.f / 16.f);
            run += la; cs[i] = run; }
        BC[tq * 128 + d] = run;
        __syncthreads();
        float off = 0.f, tot = 0.f;
#pragma unroll
        for (int q = 0; q < 4; ++q) { const float v = BC[q * 128 + d]; off += (q < tq) ? v : 0.f; tot += v; }
        if (tq == 0) { DEC[d] = __expf(tot); dsum += tot; }
        {
            const bf16_t* kp = GK + (mrow + tq * 16) * 512 + d; const bf16_t* qp = GQ + (mrow + tq * 16) * 512 + d; const bf16_t* vp = GV + (mrow + tq * 16) * 512 + d;
            unsigned ke[8], vv[8];
#pragma unroll
            for (int i2 = 0; i2 < 8; ++i2) {
                float kend[2]; unsigned vraw[2];
#pragma unroll
                for (int q2 = 0; q2 < 2; ++q2) { const int i = 2 * i2 + q2; const int j = tq * 16 + i;
                    const float kf = bf2f(kp[(size_t)i * 512]); const float bc = off + cs[i];
                    kend[q2] = kf * __expf(tot - bc); vraw[q2] = vp[(size_t)i * 512];
                    if (PASS_C) { const float qf = bf2f(qp[(size_t)i * 512]);
                        QD[j * P128 + d] = f2bf(qf * scale * __expf(bc)); KI[j * P128 + d] = f2bf(kf * __expf(-bc)); } }
                ke[i2] = cvt_pk_bf16(kend[0], kend[1]); vv[i2] = vraw[0] | (vraw[1] << 16);
            }
            LAS u32x4* kd = (LAS u32x4*)(KET + d * P64 + tq * 16); kd[0] = (u32x4){ke[0], ke[1], ke[2], ke[3]}; kd[1] = (u32x4){ke[4], ke[5], ke[6], ke[7]};
            LAS u32x4* vd = (LAS u32x4*)(VT + d * P64 + tq * 16); vd[0] = (u32x4){vv[0], vv[1], vv[2], vv[3]}; vd[1] = (u32x4){vv[4], vv[5], vv[6], vv[7]};
        }
        __syncthreads();
        if (PASS_C) {
            const int it = w >> 1, eh = w & 1;
            bf16x8 qb[4];
#pragma unroll
            for (int ks = 0; ks < 4; ++ks) qb[ks] = lds16(QD + (16 * it + lr) * P128 + 32 * ks + 8 * lg);
            f32x4 P[4];
#pragma unroll
            for (int jt = 0; jt < 4; ++jt) { P[jt] = (f32x4){0.f, 0.f, 0.f, 0.f};
                if (jt <= it) {
#pragma unroll
                    for (int ks = 0; ks < 4; ++ks) P[jt] = MFMA16(lds16(KI + (16 * jt + lr) * P128 + 32 * ks + 8 * lg), qb[ks], P[jt]);
                    if (jt == it) {
#pragma unroll
                        for (int r = 0; r < 4; ++r) if (4 * lg + r > lr) P[jt][r] = 0.f; }
                } }
            bf16x8 pb[2]; pb[0] = pack8(P[0], P[1]); pb[1] = pack8(P[2], P[3]);
            f32x4 o[4];
#pragma unroll
            for (int et = 0; et < 4; ++et) { o[et] = (f32x4){0.f, 0.f, 0.f, 0.f}; const int er = 64 * eh + 16 * et + lr;
#pragma unroll
                for (int s = 0; s < 2; ++s) o[et] = MFMA16(lds8x2(VT + er * P64 + 32 * s + 4 * lg, VT + er * P64 + 32 * s + 16 + 4 * lg), pb[s], o[et]);
#pragma unroll
                for (int ks = 0; ks < 4; ++ks) o[et] = MFMA16(lds16(ST + er * P128 + 32 * ks + 8 * lg), qb[ks], o[et]); }
            float ssq = 0.f;
#pragma unroll
            for (int et = 0; et < 4; ++et) ssq += (o[et][0] * o[et][0] + o[et][1] * o[et][1]) + (o[et][2] * o[et][2] + o[et][3] * o[et][3]);
            ssq += __shfl_xor(ssq, 16); ssq += __shfl_xor(ssq, 32);
            if (lg == 0) NRM[eh * 64 + 16 * it + lr] = ssq;
            __syncthreads();
            const float rstd = rsqrtf((NRM[16 * it + lr] + NRM[64 + 16 * it + lr]) * (1.f / 128.f) + EPS_);
            const float* gn = args.in[5] + (size_t)l * 128;
#pragma unroll
            for (int et = 0; et < 4; ++et) { const int e0 = 64 * eh + 16 * et + 4 * lg; bf16_t* gp = GG + (mrow + 16 * it + lr) * 512 + e0;
                const u32x2 graw = *(const GAS u32x2*)gp; const f32x4 gnv = *(const GAS f32x4*)(gn + e0);
                const float g0 = bf_lo(graw.x), g1 = bf_hi(graw.x), g2 = bf_lo(graw.y), g3 = bf_hi(graw.y);
                const float y0 = o[et][0] * rstd * gnv[0] * (g0 * fast_sigmoid(g0)), y1 = o[et][1] * rstd * gnv[1] * (g1 * fast_sigmoid(g1));
                const float y2 = o[et][2] * rstd * gnv[2] * (g2 * fast_sigmoid(g2)), y3 = o[et][3] * rstd * gnv[3] * (g3 * fast_sigmoid(g3));
                u32x2 yo; yo.x = cvt_pk_bf16(y0, y1); yo.y = cvt_pk_bf16(y2, y3); *(GAS u32x2*)gp = yo; }
        }
        {
            f32x4 dv4;
#pragma unroll
            for (int r = 0; r < 4; ++r) dv4[r] = DEC[16 * w + 4 * lg + r];
#pragma unroll
            for (int et = 0; et < 8; ++et) S[et] = S[et] * dv4;
#pragma unroll
            for (int s = 0; s < 2; ++s) { const bf16x8 a = lds16(KET + (16 * w + lr) * P64 + 32 * s + 8 * lg);
#pragma unroll
                for (int et = 0; et < 8; ++et) S[et] = MFMA16(a, lds16(VT + (16 * et + lr) * P64 + 32 * s + 8 * lg), S[et]); }
            if (PASS_C) {
#pragma unroll
                for (int et = 0; et < 8; ++et) { u32x2 pk; pk.x = cvt_pk_bf16(S[et][0], S[et][1]); pk.y = cvt_pk_bf16(S[et][2], S[et][3]);
                    *(LAS u32x2*)(ST + (16 * et + lr) * P128 + 16 * w + 4 * lg) = pk; }
            }
        }
    }
    if (!PASS_C) {
#pragma unroll
        for (int et = 0; et < 8; ++et)
#pragma unroll
            for (int r = 0; r < 4; ++r) KV[(size_t)(16 * w + 4 * lg + r) * 128 + 16 * et + lr] = S[et][r];
        if (tq == 0) DT[d] = __expf(dsum);
    }
    __syncthreads();
}
__device__ __forceinline__ void gla_scan(const Args& args, int gtid, int gthreads) {
    float* KV = (float*)(args.ws + WS_SCR + SCR_GLA_KV); const float* DT = (const float*)(args.ws + WS_MISC + MISC_GLA_DT);
    for (int idx = gtid; idx < 8 * 16384; idx += gthreads) {
        const int bh = idx >> 14, de = idx & 16383, dd = de >> 7;
        float kv[32], dt[32];
#pragma unroll
        for (int s = 0; s < 32; ++s) { kv[s] = KV[(size_t)(bh * 32 + s) * 16384 + de]; dt[s] = DT[(bh * 32 + s) * 128 + dd]; }
        float st = 0.f;
#pragma unroll
        for (int s = 0; s < 32; ++s) { KV[(size_t)(bh * 32 + s) * 16384 + de] = st; st = dt[s] * st + kv[s]; }
    }
}
}
namespace mk {
constexpr size_t SCR_ML_KV = 52 * MiB;
constexpr size_t MISC_ML_MS = 512 * 1024;
constexpr int ML_QW = 0, ML_QR = 9216, ML_KS = 18432, ML_KWT = 27648, ML_VT = 36864, ML_ST = 57600, ML_SC = 78336, ML_NRM = 79872, ML_END = 80384;

__device__ __forceinline__ float wave_incl_sum(float x, int lane) {
#pragma unroll
    for (int o = 1; o < 64; o <<= 1) { const float v = __shfl_up(x, o); if (lane >= o) x += v; }
    return x;
}
__device__ __forceinline__ float wave_incl_max(float x, int lane) {
#pragma unroll
    for (int o = 1; o < 64; o <<= 1) { const float v = __shfl_up(x, o); if (lane >= o) x = fmaxf(x, v); }
    return x;
}

template <bool PASS_C>
__device__ __forceinline__ void ml_unit(LAS unsigned char* lds, const Args& args, int l, int u) {
    int tid_ = threadIdx.x; asm volatile("" : "+v"(tid_));
    const int tid = tid_, lane = tid & 63, w = __builtin_amdgcn_readfirstlane(tid >> 6), lr = lane & 15, lg = lane >> 4;
    const int bh = u >> 5, sc = u & 31, b = bh >> 2, h = bh & 3;
    const int t0 = sc * 256;
    const size_t mbase = (size_t)b * T_ + (size_t)t0;
    unsigned char* ws = args.ws; asm volatile("" : "+s"(ws));
    const bf16_t* LQ = (const bf16_t*)(ws + WS_SEG + SEG_LQ) + h * 64; const bf16_t* LK = (const bf16_t*)(ws + WS_SEG + SEG_LK) + h * 64;
    const bf16_t* LV = (const bf16_t*)(ws + WS_SEG + SEG_LV) + h * 128; bf16_t* LO = (bf16_t*)(ws + WS_SEG + SEG_LO) + h * 128;
    const float* SMALL = (const float*)(ws + WS_SMALL);
    float* KVM = (float*)(ws + WS_SCR + SCR_ML_KV) + (size_t)u * (64 * 144); float* MS = (float*)(ws + WS_MISC + MISC_ML_MS) + (size_t)u * 4;
    LAS bf16_t* QW = (LAS bf16_t*)(lds + ML_QW); LAS bf16_t* QR = (LAS bf16_t*)(lds + ML_QR); LAS bf16_t* KS = (LAS bf16_t*)(lds + ML_KS);
    LAS bf16_t* KWT = (LAS bf16_t*)(lds + ML_KWT); LAS bf16_t* VT = (LAS bf16_t*)(lds + ML_VT); LAS bf16_t* ST = (LAS bf16_t*)(lds + ML_ST);
    LAS float* SU = (LAS float*)(lds + ML_SC);
    LAS float* NRM = (LAS float*)(lds + ML_NRM);
    const int ch = tid & 127, tq = tid >> 7;
    float cw[4];
    { const int cidx = (ch < 64) ? (h * 64 + ch) : (256 + h * 64 + (ch - 64)); const float* cwp = args.in[8] + (size_t)l * 4 * 512 + cidx;
#pragma unroll
      for (int j = 0; j < 4; ++j) cw[j] = cwp[j * 512]; }
    const float ib = args.in[9][l * 4 + h], fb = args.in[10][l * 4 + h];
    const int dt = w & 3, eb = (w >> 2) * 4;
    f32x4 S[5];
    float m_prev;
    if (PASS_C) {
        m_prev = MS[2];
#pragma unroll
        for (int k = 0; k < 5; ++k) { const int et = (k < 4) ? (eb + k) : 8;
            if (k < 4 || w < 4) {
#pragma unroll
                for (int r = 0; r < 4; ++r) S[k][r] = KVM[(size_t)(16 * dt + 4 * lg + r) * 144 + 16 * et + lr];
                u32x2 pk; pk.x = cvt_pk_bf16(S[k][0], S[k][1]); pk.y = cvt_pk_bf16(S[k][2], S[k][3]);
                *(LAS u32x2*)(ST + (16 * et + lr) * P64 + 16 * dt + 4 * lg) = pk;
            } else S[k] = (f32x4){0.f, 0.f, 0.f, 0.f}; }
    } else {
        m_prev = -1e30f;
#pragma unroll
        for (int k = 0; k < 5; ++k) S[k] = (f32x4){0.f, 0.f, 0.f, 0.f};
    }
    for (int i = tid; i < 16 * P64; i += NTHREADS) VT[128 * P64 + i] = (i < 64) ? (bf16_t)0x3f80 : (bf16_t)0;
    float bsum = 0.f;
    for (int c = 0; c < 4; ++c) {
        const size_t mrow = mbase + (size_t)c * 64;
        const float lf = ({ const float z = SMALL[(mrow + lane) * 32 + 20 + h] + fb; fminf(z, 0.f) - __logf(1.f + __expf(-fabsf(z))); });
        const float li = SMALL[(mrow + lane) * 32 + 16 + h] + ib;
        const float bcum = wave_incl_sum(lf, lane);
        const float uj = li - bcum;
        const float pmax = wave_incl_max(uj, lane);
        const float b_last = __shfl(bcum, 63), pm63 = __shfl(pmax, 63);
        const float gi = fmaxf(m_prev, pmax);
        const float m_new = fmaxf(b_last + m_prev, b_last + pm63);
        const float a_scale = __expf(b_last + m_prev - m_new);
        __syncthreads();
        if (w == 0) { SU[lane] = uj; SU[64 + lane] = gi; SU[128 + lane] = __expf(m_prev - gi); SU[192 + lane] = __expf(-(bcum + gi)); SU[256 + lane] = __expf(b_last + uj - m_new); }
        __syncthreads();
        {
            const bf16_t* src = (ch < 64) ? (LQ + ch) : (LK + (ch - 64));
            float xv[19];
#pragma unroll
            for (int i = 0; i < 19; ++i) { const int tt = c * 64 + tq * 16 - 3 + i;
                xv[i] = (t0 + tt >= 0) ? bf2f(src[(ptrdiff_t)(mbase + tt) * 256]) : 0.f; }
            unsigned kw[8];
#pragma unroll
            for (int i2 = 0; i2 < 8; ++i2) { float kwv[2];
#pragma unroll
                for (int q2 = 0; q2 < 2; ++q2) { const int i = 2 * i2 + q2, j = tq * 16 + i;
                    const float cv = cw[0] * xv[i] + cw[1] * xv[i + 1] + cw[2] * xv[i + 2] + cw[3] * xv[i + 3];
                    if (ch < 64) { if (PASS_C) { QR[j * P64 + ch] = f2bf(cv); QW[j * P64 + ch] = f2bf(cv * SU[128 + j]); } kwv[q2] = 0.f; }
                    else { const float kv = cv * 0.125f; if (PASS_C) KS[j * P64 + (ch - 64)] = f2bf(kv); kwv[q2] = kv * SU[256 + j]; } }
                kw[i2] = cvt_pk_bf16(kwv[0], kwv[1]); }
            if (ch >= 64) { LAS u32x4* kd = (LAS u32x4*)(KWT + (ch - 64) * P64 + tq * 16); kd[0] = (u32x4){kw[0], kw[1], kw[2], kw[3]}; kd[1] = (u32x4){kw[4], kw[5], kw[6], kw[7]}; }
            const bf16_t* vp = LV + (mrow + tq * 16) * 512 + ch; unsigned vv[8];
#pragma unroll
            for (int i2 = 0; i2 < 8; ++i2) vv[i2] = (unsigned)vp[(size_t)(2 * i2) * 512] | ((unsigned)vp[(size_t)(2 * i2 + 1) * 512] << 16);
            LAS u32x4* vd = (LAS u32x4*)(VT + ch * P64 + tq * 16); vd[0] = (u32x4){vv[0], vv[1], vv[2], vv[3]}; vd[1] = (u32x4){vv[4], vv[5], vv[6], vv[7]};
        }
        __syncthreads();
        if (PASS_C) {
            const int it = w >> 1, eh = w & 1;
            bf16x8 qr[2], qw[2];
#pragma unroll
            for (int ks = 0; ks < 2; ++ks) { qr[ks] = lds16(QR + (16 * it + lr) * P64 + 32 * ks + 8 * lg); qw[ks] = lds16(QW + (16 * it + lr) * P64 + 32 * ks + 8 * lg); }
            const float g_i = SU[64 + 16 * it + lr];
            f32x4 P[4];
#pragma unroll
            for (int jt = 0; jt < 4; ++jt) { P[jt] = (f32x4){0.f, 0.f, 0.f, 0.f};
                if (jt <= it) {
#pragma unroll
                    for (int ks = 0; ks < 2; ++ks) P[jt] = MFMA16(lds16(KS + (16 * jt + lr) * P64 + 32 * ks + 8 * lg), qr[ks], P[jt]);
                    const f32x4 u4 = *(const LAS f32x4*)(SU + 16 * jt + 4 * lg);
#pragma unroll
                    for (int r = 0; r < 4; ++r) { const float f = __expf(u4[r] - g_i); P[jt][r] = (jt == it && 4 * lg + r > lr) ? 0.f : P[jt][r] * f; }
                } }
            bf16x8 pb[2]; pb[0] = pack8(P[0], P[1]); pb[1] = pack8(P[2], P[3]);
            f32x4 o[5];
#pragma unroll
            for (int k = 0; k < 5; ++k) { o[k] = (f32x4){0.f, 0.f, 0.f, 0.f}; const int er = (k < 4 ? 64 * eh + 16 * k : 128) + lr;
#pragma unroll
                for (int s = 0; s < 2; ++s) o[k] = MFMA16(lds8x2(VT + er * P64 + 32 * s + 4 * lg, VT + er * P64 + 32 * s + 16 + 4 * lg), pb[s], o[k]);
#pragma unroll
                for (int ks = 0; ks < 2; ++ks) o[k] = MFMA16(lds16(ST + er * P64 + 32 * ks + 8 * lg), qw[ks], o[k]); }
            const float den = __shfl(o[4][0], lr);
            const float rden = 1.f / fmaxf(fabsf(den), SU[192 + 16 * it + lr]);
            float ssq = 0.f;
#pragma unroll
            for (int k = 0; k < 4; ++k) { o[k] = o[k] * rden; ssq += (o[k][0] * o[k][0] + o[k][1] * o[k][1]) + (o[k][2] * o[k][2] + o[k][3] * o[k][3]); }
            ssq += __shfl_xor(ssq, 16); ssq += __shfl_xor(ssq, 32);
            if (lg == 0) NRM[eh * 64 + 16 * it + lr] = ssq;
            __syncthreads();
            const float rstd = rsqrtf((NRM[16 * it + lr] + NRM[64 + 16 * it + lr]) * (1.f / 128.f) + EPS_);
            const float* gn = args.in[11] + (size_t)l * 128;
#pragma unroll
            for (int k = 0; k < 4; ++k) { const int e0 = 64 * eh + 16 * k + 4 * lg; bf16_t* gp = LO + (mrow + 16 * it + lr) * 512 + e0;
                const u32x2 graw = *(const GAS u32x2*)gp; const f32x4 gnv = *(const GAS f32x4*)(gn + e0);
                const float y0 = o[k][0] * rstd * gnv[0] * fast_sigmoid(bf_lo(graw.x)), y1 = o[k][1] * rstd * gnv[1] * fast_sigmoid(bf_hi(graw.x));
                const float y2 = o[k][2] * rstd * gnv[2] * fast_sigmoid(bf_lo(graw.y)), y3 = o[k][3] * rstd * gnv[3] * fast_sigmoid(bf_hi(graw.y));
                u32x2 yo; yo.x = cvt_pk_bf16(y0, y1); yo.y = cvt_pk_bf16(y2, y3); *(GAS u32x2*)gp = yo; }
        }
        {
#pragma unroll
            for (int k = 0; k < 5; ++k) S[k] = S[k] * a_scale;
#pragma unroll
            for (int s = 0; s < 2; ++s) { const bf16x8 a = lds16(KWT + (16 * dt + lr) * P64 + 32 * s + 8 * lg);
#pragma unroll
                for (int k = 0; k < 5; ++k) { const int et = (k < 4) ? (eb + k) : 8; if (k < 4 || w < 4) S[k] = MFMA16(a, lds16(VT + (16 * et + lr) * P64 + 32 * s + 8 * lg), S[k]); } }
            if (PASS_C) {
#pragma unroll
                for (int k = 0; k < 5; ++k) { const int et = (k < 4) ? (eb + k) : 8;
                    if (k < 4 || w < 4) { u32x2 pk; pk.x = cvt_pk_bf16(S[k][0], S[k][1]); pk.y = cvt_pk_bf16(S[k][2], S[k][3]);
                        *(LAS u32x2*)(ST + (16 * et + lr) * P64 + 16 * dt + 4 * lg) = pk; } }
            }
        }
        m_prev = m_new; bsum += b_last;
    }
    if (!PASS_C) {
#pragma unroll
        for (int k = 0; k < 5; ++k) { const int et = (k < 4) ? (eb + k) : 8;
            if (k < 4 || w < 4) {
#pragma unroll
                for (int r = 0; r < 4; ++r) KVM[(size_t)(16 * dt + 4 * lg + r) * 144 + 16 * et + lr] = S[k][r]; } }
        if (tid == 0) { MS[0] = m_prev; MS[1] = bsum; }
    }
    __syncthreads();
}
__device__ __forceinline__ void ml_scan(const Args& args, int gtid, int gthreads) {
    float* KVM = (float*)(args.ws + WS_SCR + SCR_ML_KV); float* MS = (float*)(args.ws + WS_MISC + MISC_ML_MS);
    for (int idx = gtid; idx < 8 * 9216; idx += gthreads) {
        const int bh = idx / 9216, de = idx % 9216;
        float kv[32], ml[32], Bv[32];
#pragma unroll
        for (int s = 0; s < 32; ++s) { const int u = bh * 32 + s; kv[s] = KVM[(size_t)u * 9216 + de]; ml[s] = MS[u * 4 + 0]; Bv[s] = MS[u * 4 + 1]; }
        float st = 0.f, m = 0.f;
#pragma unroll
        for (int s = 0; s < 32; ++s) { const int u = bh * 32 + s;
            KVM[(size_t)u * 9216 + de] = st; if (de == 0) MS[u * 4 + 2] = m;
            const float mn = fmaxf(Bv[s] + m, ml[s]);
            st = __expf(Bv[s] + m - mn) * st + __expf(ml[s] - mn) * kv[s]; m = mn; }
    }
}
}
namespace mk {
constexpr size_t WS_PO = WS_ACT;
constexpr size_t WS_PML = WS_ACT + 64 * MiB;
constexpr size_t MISC_KM = 0;
constexpr size_t MISC_PAIRS = 1 * MiB;
constexpr size_t MISC_CELL = 1 * MiB + 800 * 1024;
constexpr int CW_MBQ = 1024;
static_assert(WS_PML + 4 * MiB <= WS_SCR + SCR_GLA_KV, "MoBA partials end below the GLA state buffer");
constexpr int MB_NUNITS = 16 * 52;
constexpr int MC_K = 0, MC_KP = 72, MC_VT = 36864, MC_VP = 264, MC_QL = 36864 + 33792, MC_CTL = MC_QL + 32768, MC_END = MC_CTL + 256;

__device__ __forceinline__ void mb_prep_unit(LAS unsigned char* lds, const Args& args, int l, int u) {
    int tid_ = threadIdx.x; asm volatile("" : "+v"(tid_));
    const int tid = tid_, lane = tid & 63, w = __builtin_amdgcn_readfirstlane(tid >> 6);
    const int b = u >> 5, blk = u & 31;
    unsigned char* ws = args.ws; asm volatile("" : "+s"(ws));
    bf16_t* MQ = (bf16_t*)(ws + WS_SEG + SEG_MQ); bf16_t* MK = (bf16_t*)(ws + WS_SEG + SEG_MK);
    const float* COS = (const float*)(ws + WS_ROPE); const float* SIN = COS + 8192 * 32;
    float* KM = (float*)(ws + WS_MISC + MISC_KM);
    LAS float* RED = (LAS float*)lds;
    const int d0 = (lane & 7) * 8;
    float gq[8], gk[8], ks[8];
#pragma unroll
    for (int k = 0; k < 8; ++k) { gq[k] = args.in[6][l * 64 + d0 + k]; gk[k] = args.in[7][l * 64 + d0 + k]; ks[k] = 0.f; }
    const bool lo = (lane & 4) == 0;
    for (int i = 0; i < 32; ++i) {
        const int t = blk * 256 + w * 32 + i; const size_t m = (size_t)b * T_ + t;
        const f32x4 c0 = *(const GAS f32x4*)(COS + t * 32 + (d0 & 31)), c1 = *(const GAS f32x4*)(COS + t * 32 + (d0 & 31) + 4);
        const f32x4 s0 = *(const GAS f32x4*)(SIN + t * 32 + (d0 & 31)), s1 = *(const GAS f32x4*)(SIN + t * 32 + (d0 & 31) + 4);
        const float cs[8] = {c0[0], c0[1], c0[2], c0[3], c1[0], c1[1], c1[2], c1[3]}, sn[8] = {s0[0], s0[1], s0[2], s0[3], s1[0], s1[1], s1[2], s1[3]};
#pragma unroll
        for (int which = 0; which < 2; ++which) {
            bf16_t* p = (which ? MK : MQ) + m * 512 + 8 * lane;
            const u32x4 raw = *(const GAS u32x4*)p;
            float x[8] = {bf_lo(raw.x), bf_hi(raw.x), bf_lo(raw.y), bf_hi(raw.y), bf_lo(raw.z), bf_hi(raw.z), bf_lo(raw.w), bf_hi(raw.w)};
            float ss = 0.f;
#pragma unroll
            for (int k = 0; k < 8; ++k) ss += x[k] * x[k];
            ss += __shfl_xor(ss, 1); ss += __shfl_xor(ss, 2); ss += __shfl_xor(ss, 4);
            const float r = rsqrtf(ss * (1.f / 64.f) + EPS_);
            float y[8];
#pragma unroll
            for (int k = 0; k < 8; ++k) { const float v = x[k] * r * (which ? gk[k] : gq[k]); const float other = __shfl_xor(v, 4);
                y[k] = lo ? (v * cs[k] - other * sn[k]) : (v * cs[k] + other * sn[k]); }
            u32x4 o; o.x = cvt_pk_bf16(y[0], y[1]); o.y = cvt_pk_bf16(y[2], y[3]); o.z = cvt_pk_bf16(y[4], y[5]); o.w = cvt_pk_bf16(y[6], y[7]);
            *(GAS u32x4*)p = o;
            if (which) {
#pragma unroll
                for (int k = 0; k < 8; ++k) ks[k] += y[k]; }
        }
    }
    __syncthreads();
#pragma unroll
    for (int k = 0; k < 8; ++k) RED[w * 512 + 8 * lane + k] = ks[k];
    __syncthreads();
    { float s = 0.f;
#pragma unroll
      for (int ww = 0; ww < 8; ++ww) s += RED[ww * 512 + tid];
      KM[((size_t)(b * 8 + (tid >> 6)) * 32 + blk) * 64 + (tid & 63)] = s * (1.f / 256.f); }
    __syncthreads();
}

__device__ __forceinline__ void mb_topk_unit(LAS unsigned char* lds, const Args& args, int u) {
    int tid_ = threadIdx.x; asm volatile("" : "+v"(tid_));
    const int tid = tid_, lane = tid & 63;
    const int b = u >> 7, i = (u >> 2) & 31, hp = u & 3;
    const int hh = tid >> 8, head = 2 * hp + hh, tq = tid & 255, w4 = (tid >> 6) & 3;
    unsigned char* ws = args.ws; asm volatile("" : "+s"(ws));
    const bf16_t* QN = (const bf16_t*)(ws + WS_SEG + SEG_MQ);
    const float* KM = (const float*)(ws + WS_MISC + MISC_KM);
    bf16_t* PAIRS = (bf16_t*)(ws + WS_MISC + MISC_PAIRS) + ((size_t)(b * 8 + head) * 32 + i) * 768;
    bf16_t* CELL = (bf16_t*)(ws + WS_MISC + MISC_CELL) + ((size_t)(b * 8 + head) * 32 + i) * 34;
    LAS float* KMS = (LAS float*)lds;
    LAS unsigned* CNT = (LAS unsigned*)(lds + 16384);
    LAS unsigned* CO = (LAS unsigned*)(lds + 16384 + 1024);
    __syncthreads();
#pragma unroll
    for (int k = 0; k < 8; ++k) { const int e = tid + 512 * k; KMS[e] = KM[(size_t)(b * 8 + 2 * hp) * 2048 + e]; }
    if (tid < 256) CNT[tid] = 0u;
    float q[64];
    { const bf16_t* qp = QN + ((size_t)b * T_ + i * 256 + tq) * 512 + head * 64;
#pragma unroll
      for (int c = 0; c < 8; ++c) { const u32x4 raw = *(const GAS u32x4*)(qp + 8 * c);
          q[8 * c] = bf_lo(raw.x); q[8 * c + 1] = bf_hi(raw.x); q[8 * c + 2] = bf_lo(raw.y); q[8 * c + 3] = bf_hi(raw.y);
          q[8 * c + 4] = bf_lo(raw.z); q[8 * c + 5] = bf_hi(raw.z); q[8 * c + 6] = bf_lo(raw.w); q[8 * c + 7] = bf_hi(raw.w); } }
    __syncthreads();
    float v0 = -INFINITY, v1 = -INFINITY, v2 = -INFINITY; int j0 = -1, j1 = -1, j2 = -1;
    for (int j = 0; j < i; ++j) {
        const LAS f32x4* kp = (const LAS f32x4*)(KMS + (hh * 32 + j) * 64); float s = 0.f;
#pragma unroll
        for (int c = 0; c < 16; ++c) { const f32x4 k4 = kp[c]; s += q[4 * c] * k4[0] + q[4 * c + 1] * k4[1] + q[4 * c + 2] * k4[2] + q[4 * c + 3] * k4[3]; }
        if (s > v2) { if (s > v1) { v2 = v1; j2 = j1; if (s > v0) { v1 = v0; j1 = j0; v0 = s; j0 = j; } else { v1 = s; j1 = j; } } else { v2 = s; j2 = j; } }
    }
    int rk0 = 0, rk1 = 0, rk2 = 0;
    for (int j = 0; j < i; ++j) {
        const bool pr = (j0 == j) || (j1 == j) || (j2 == j);
        const unsigned long long mask = __ballot(pr);
        const int rank = __popcll(mask & ((1ull << lane) - 1ull));
        if (j0 == j) rk0 = rank; if (j1 == j) rk1 = rank; if (j2 == j) rk2 = rank;
        if (lane == 0) CNT[(hh * 4 + w4) * 32 + j] = (unsigned)__popcll(mask);
    }
    __syncthreads();
    if (tid < 2) { unsigned run = 0u;
        for (int j = 0; j < 32; ++j) { CO[tid * 34 + j] = run; run += CNT[(tid * 4 + 0) * 32 + j] + CNT[(tid * 4 + 1) * 32 + j] + CNT[(tid * 4 + 2) * 32 + j] + CNT[(tid * 4 + 3) * 32 + j]; }
        CO[tid * 34 + 32] = run; }
    __syncthreads();
#define MB_EMIT(jj, rk, slot) do { if ((jj) >= 0) { unsigned pos = CO[hh * 34 + (jj)] + (rk); \
        for (int ww = 0; ww < 4; ++ww) pos += (ww < w4) ? CNT[(hh * 4 + ww) * 32 + (jj)] : 0u; \
        PAIRS[pos] = (bf16_t)(tq | ((slot) << 8)); } } while (0)
    MB_EMIT(j0, rk0, 0); MB_EMIT(j1, rk1, 1); MB_EMIT(j2, rk2, 2);
#undef MB_EMIT
    if (tq < 33) CELL[tq] = (bf16_t)CO[hh * 34 + tq];
    __syncthreads();
}

__device__ __forceinline__ void mb_attn_unit(LAS unsigned char* lds, const Args& args, int q) {
    int tid_ = threadIdx.x; asm volatile("" : "+v"(tid_));
    const int tid = tid_, lane = tid & 63, w = __builtin_amdgcn_readfirstlane(tid >> 6), lr = lane & 15, lg = lane >> 4;
    const int bh = q & 15, rr = q >> 4, b = bh >> 3, h = bh & 7;
    int j, part, np;
    if (rr < 16) { j = rr >> 2; part = rr & 3; np = 4; } else if (rr < 32) { j = 4 + ((rr - 16) >> 1); part = (rr - 16) & 1; np = 2; } else { j = 12 + (rr - 32); part = 0; np = 1; }
    unsigned char* ws = args.ws; asm volatile("" : "+s"(ws));
    const bf16_t* QN = (const bf16_t*)(ws + WS_SEG + SEG_MQ) + h * 64; const bf16_t* KN = (const bf16_t*)(ws + WS_SEG + SEG_MK) + h * 64; const bf16_t* MV = (const bf16_t*)(ws + WS_SEG + SEG_MV) + h * 64;
    const bf16_t* PAIRS = (const bf16_t*)(ws + WS_MISC + MISC_PAIRS) + (size_t)bh * 32 * 768; const bf16_t* CELL = (const bf16_t*)(ws + WS_MISC + MISC_CELL) + (size_t)bh * 32 * 34;
    bf16_t* PO = (bf16_t*)(ws + WS_PO); float* PML = (float*)(ws + WS_PML);
    LAS bf16_t* KJ = (LAS bf16_t*)(lds + MC_K); LAS bf16_t* VT = (LAS bf16_t*)(lds + MC_VT); LAS unsigned* QL = (LAS unsigned*)(lds + MC_QL); LAS unsigned* CT = (LAS unsigned*)(lds + MC_CTL);
    const size_t krow0 = (size_t)b * T_ + (size_t)j * 256;
    __syncthreads();
#pragma unroll
    for (int k = 0; k < 4; ++k) { const int id = tid + 512 * k, row = id >> 3, c8 = id & 7;
        *(LAS u32x4*)(KJ + row * MC_KP + 8 * c8) = *(const GAS u32x4*)(KN + (krow0 + row) * 512 + 8 * c8);
        const u32x4 vr = *(const GAS u32x4*)(MV + (krow0 + row) * 512 + 8 * c8);
        LAS bf16_t* vt = VT + (8 * c8) * MC_VP + row;
        vt[0 * MC_VP] = (bf16_t)(vr.x & 0xffffu); vt[1 * MC_VP] = (bf16_t)(vr.x >> 16); vt[2 * MC_VP] = (bf16_t)(vr.y & 0xffffu); vt[3 * MC_VP] = (bf16_t)(vr.y >> 16);
        vt[4 * MC_VP] = (bf16_t)(vr.z & 0xffffu); vt[5 * MC_VP] = (bf16_t)(vr.z >> 16); vt[6 * MC_VP] = (bf16_t)(vr.w & 0xffffu); vt[7 * MC_VP] = (bf16_t)(vr.w >> 16); }
    if (tid < 256) QL[tid] = (unsigned)(j * 256 + tid) | (3u << 13);
    if (tid == 0) { unsigned run = 256u;
        for (int i = j + 1; i < 32; ++i) { CT[i] = run; run += (unsigned)CELL[i * 34 + j + 1] - (unsigned)CELL[i * 34 + j]; }
        CT[32] = run; }
    __syncthreads();
    for (int i = j + 1; i < 32; ++i) { const unsigned c0 = CELL[i * 34 + j], cnt = (unsigned)CELL[i * 34 + j + 1] - c0, dst = CT[i];
        for (unsigned e = tid; e < cnt; e += NTHREADS) { const unsigned pr = PAIRS[(size_t)i * 768 + c0 + e]; QL[dst + e] = (unsigned)(i * 256 + (pr & 255u)) | ((pr >> 8) << 13); } }
    __syncthreads();
    const int n = (int)CT[32], nitems = (n + 15) >> 4;
    for (int item = part + np * w; item < nitems; item += np * 8) {
        const int eidx = item * 16 + lr; const bool valid = eidx < n;
        const unsigned ent = QL[valid ? eidx : 0];
        const int tok = (int)(ent & 8191u), slot = (int)((ent >> 13) & 3u); const bool own = slot == 3; const int qpos = tok & 255;
        const size_t m = (size_t)b * T_ + tok;
        bf16x8 qb[2];
        qb[0] = *(const GAS bf16x8*)(QN + m * 512 + 8 * lg); qb[1] = *(const GAS bf16x8*)(QN + m * 512 + 32 + 8 * lg);
        f32x4 sc[16];
#pragma unroll
        for (int kt = 0; kt < 16; ++kt) { sc[kt] = (f32x4){0.f, 0.f, 0.f, 0.f};
#pragma unroll
            for (int ks = 0; ks < 2; ++ks) sc[kt] = MFMA16(lds16(KJ + (16 * kt + lr) * MC_KP + 32 * ks + 8 * lg), qb[ks], sc[kt]); }
        float mx = -1e30f;
#pragma unroll
        for (int kt = 0; kt < 16; ++kt)
#pragma unroll
            for (int r = 0; r < 4; ++r) { float s = sc[kt][r] * 0.125f; if (own && (16 * kt + 4 * lg + r) > qpos) s = -1e30f; sc[kt][r] = s; mx = fmaxf(mx, s); }
        mx = fmaxf(mx, __shfl_xor(mx, 16)); mx = fmaxf(mx, __shfl_xor(mx, 32));
        float lsum = 0.f;
#pragma unroll
        for (int kt = 0; kt < 16; ++kt)
#pragma unroll
            for (int r = 0; r < 4; ++r) { const float p = __expf(sc[kt][r] - mx); sc[kt][r] = p; lsum += p; }
        lsum += __shfl_xor(lsum, 16); lsum += __shfl_xor(lsum, 32);
        f32x4 o[4];
#pragma unroll
        for (int dv = 0; dv < 4; ++dv) o[dv] = (f32x4){0.f, 0.f, 0.f, 0.f};
#pragma unroll
        for (int s2 = 0; s2 < 8; ++s2) { const bf16x8 pb = pack8(sc[2 * s2], sc[2 * s2 + 1]);
#pragma unroll
            for (int dv = 0; dv < 4; ++dv) { const LAS bf16_t* vp = VT + (16 * dv + lr) * MC_VP + 32 * s2 + 4 * lg; o[dv] = MFMA16(lds8x2(vp, vp + 16), pb, o[dv]); } }
        const float inv = 1.f / lsum;
        if (valid) { const size_t pbase = ((m * 8 + h) * 4 + slot);
#pragma unroll
            for (int dv = 0; dv < 4; ++dv) { u32x2 pk; pk.x = cvt_pk_bf16(o[dv][0] * inv, o[dv][1] * inv); pk.y = cvt_pk_bf16(o[dv][2] * inv, o[dv][3] * inv);
                *(GAS u32x2*)(PO + pbase * 64 + 16 * dv + 4 * lg) = pk; }
            if (lg == 0) { f32x2 ml; ml.x = mx; ml.y = lsum; *(GAS f32x2*)(PML + pbase * 2) = ml; } }
    }
    __syncthreads();
}

__device__ __forceinline__ void mb_combine(const Args& args, int gtid, int gthreads) {
    unsigned char* ws = args.ws; asm volatile("" : "+s"(ws));
    const bf16_t* PO = (const bf16_t*)(ws + WS_PO); const float* PML = (const float*)(ws + WS_PML); bf16_t* Y = (bf16_t*)(ws + WS_SEG + SEG_MQ);
    for (int idx = gtid; idx < M_ * 8 * 8; idx += gthreads) {
        const int mh = idx >> 3, c8 = idx & 7, m = mh >> 3, h = mh & 7, t = m & (T_ - 1), ib = t >> 8; const int nv = ib < 3 ? ib : 3;
        const size_t base = (size_t)mh * 4;
        float ms[4], ls[4];
#pragma unroll
        for (int s = 0; s < 4; ++s) { const bool on = (s == 3) || (s < nv); const f32x2 ml = on ? *(const GAS f32x2*)(PML + (base + s) * 2) : (f32x2){-1e30f, 0.f}; ms[s] = ml.x; ls[s] = ml.y; }
        const float Mx = fmaxf(fmaxf(ms[0], ms[1]), fmaxf(ms[2], ms[3]));
        float acc[8] = {0.f, 0.f, 0.f, 0.f, 0.f, 0.f, 0.f, 0.f}; float W = 0.f;
#pragma unroll
        for (int s = 0; s < 4; ++s) { const bool on = (s == 3) || (s < nv);
            if (on) { const float wgt = ls[s] * __expf(ms[s] - Mx); W += wgt; const u32x4 raw = *(const GAS u32x4*)(PO + (base + s) * 64 + 8 * c8);
                acc[0] += wgt * bf_lo(raw.x); acc[1] += wgt * bf_hi(raw.x); acc[2] += wgt * bf_lo(raw.y); acc[3] += wgt * bf_hi(raw.y);
                acc[4] += wgt * bf_lo(raw.z); acc[5] += wgt * bf_hi(raw.z); acc[6] += wgt * bf_lo(raw.w); acc[7] += wgt * bf_hi(raw.w); } }
        const float iw = 1.f / W;
        u32x4 o; o.x = cvt_pk_bf16(acc[0] * iw, acc[1] * iw); o.y = cvt_pk_bf16(acc[2] * iw, acc[3] * iw); o.z = cvt_pk_bf16(acc[4] * iw, acc[5] * iw); o.w = cvt_pk_bf16(acc[6] * iw, acc[7] * iw);
        *(GAS u32x4*)(Y + (size_t)m * 512 + h * 64 + 8 * c8) = o;
    }
}
}
namespace mk {
constexpr int PH_PRO = 0, PH_PER_LAYER = 9, PH_WIN = 0, PH_MIXA = 1, PH_MIXB = 2, PH_MIXC = 3, PH_MIXD = 4, PH_BRANCH = 5, PH_WOUT = 6, PH_FF1 = 7, PH_FF2 = 8;
constexpr int PH_TOTAL = 1 + PH_PER_LAYER * DEPTH_;

__global__ void __launch_bounds__(NTHREADS, 2) mk_fwd(Args args) {
    extern __shared__ __attribute__((aligned(16))) unsigned char lds_raw[];
    Frame F;
    F.lds = (LAS unsigned char*)lds_raw;
    F.MISC = (volatile LAS unsigned*)(F.lds + MISC_OFF);
    F.tid = threadIdx.x; F.lane = F.tid & 63; F.wave = __builtin_amdgcn_readfirstlane(F.tid >> 6);
    F.G = gridDim.x; { const int bx = blockIdx.x; F.vcu = (F.G % 8 == 0) ? (bx % 8) * (F.G / 8) + bx / 8 : bx; }
    F.ws = args.ws; F.ctl = (gu32*)(args.ws + WS_CTL);
    for (int u = F.tid; u < (LDS_BYTES - RING_BYTES) / 4; u += NTHREADS) ((LAS unsigned*)(F.lds + RING_BYTES))[u] = 0u;
    __syncthreads();
    XcdBarrier bar = xcd_barrier_post((unsigned*)(F.ctl + CW_BAR) + args.li * XCD_BAR_WORDS, F.MISC + 8);
    const int lo = args.ph_lo, hi = args.ph_hi;
#define IN(k) (lo <= (k) && (k) < hi)
#define SEAM(k) do { if (IN((k) + 1)) { XcdBarrier bq = bar; asm volatile("" : "+s"(bq.bar)); xcd_barrier(bq); } } while (0)
#define OPQ_WS unsigned char* wsq = args.ws; int bxq = blockIdx.x, Gq = gridDim.x, tidq = threadIdx.x; \
    asm volatile("" : "+s"(wsq), "+s"(bxq), "+s"(Gq), "+v"(tidq)); \
    const int vcuq = (Gq % 8 == 0) ? (bxq % 8) * (Gq / 8) + bxq / 8 : bxq; (void)vcuq; (void)tidq
#define WSP(T, off) ((T*)(wsq + (off)))
#define WL(T, off) ((const T*)(wsq + WS_WTS + (size_t)l * WL_STRIDE + (off)))

    if (IN(PH_PRO)) { p0_prologue(F, args, 0, DEPTH_, true); SEAM(PH_PRO); }

    for (int l = 0; l < DEPTH_; ++l) {
        const int pb = 1 + PH_PER_LAYER * l;
        if (hi <= pb || lo >= pb + PH_PER_LAYER) continue;

        if (IN(pb + PH_WIN)) { OPQ_WS;
            pg8::Gemm g{WSP(bf16_t, WS_ACT), WL(bf16_t, WL_WIN)}; pg8::StaticOrder<33> S; S.init(Gq, bxq);
            EpiWin E{WSP(bf16_t, WS_SEG), WSP(float, WS_SMALL), WSP(float, WS_SS)};
            pg8::gemm_phase<1024, EpiWin, pg8::StaticOrder<33>, true, true>(F.lds, g, S, E);
            SEAM(pb + PH_WIN);
        }
        if (IN(pb + PH_MIXA)) { OPQ_WS;
            if (args.mix & 1) for (int u = vcuq; u < 256; u += Gq) gla_unit<false>(F.lds, args, l, u);
            if (args.mix & 2) for (int u = vcuq; u < 256; u += Gq) ml_unit<false>(F.lds, args, l, u);
            if (args.mix & 4) for (int u = Gq - 1 - vcuq; u < 64; u += Gq) mb_prep_unit(F.lds, args, l, u);
            SEAM(pb + PH_MIXA); }
        if (IN(pb + PH_MIXB)) { OPQ_WS;
            if (args.mix & 1) gla_scan(args, vcuq * NTHREADS + tidq, Gq * NTHREADS);
            if (args.mix & 2) ml_scan(args, vcuq * NTHREADS + tidq, Gq * NTHREADS);
            if (args.mix & 4) for (int u = vcuq; u < 256; u += Gq) mb_topk_unit(F.lds, args, u);
            SEAM(pb + PH_MIXB); }
        if (IN(pb + PH_MIXC)) { OPQ_WS;
            if (args.mix & 1) for (int u = vcuq; u < 256; u += Gq) gla_unit<true>(F.lds, args, l, u);
            if (args.mix & 2) for (int u = vcuq; u < 256; u += Gq) ml_unit<true>(F.lds, args, l, u);
            if (args.mix & 4) {
                for (;;) {
                    if (tidq == 0) F.MISC[16] = __hip_atomic_fetch_add((unsigned*)((gu32*)wsq + CW_MBQ + 64 * l), 1u, __ATOMIC_RELAXED, __HIP_MEMORY_SCOPE_AGENT);
                    __syncthreads();
                    const int q = (int)F.MISC[16];
                    if (q >= MB_NUNITS) break;
                    mb_attn_unit(F.lds, args, q);
                }
            }
            SEAM(pb + PH_MIXC); }
        if (IN(pb + PH_MIXD)) { OPQ_WS;
            if (args.mix & 4) mb_combine(args, vcuq * NTHREADS + tidq, Gq * NTHREADS);
            SEAM(pb + PH_MIXD); }
        if (IN(pb + PH_BRANCH)) { OPQ_WS;
            static_assert(SEG_MQ - SEG_GG == 16 * MiB && SEG_LO - SEG_MQ == 16 * MiB, "y buffers equally spaced");
            typedef pg8::ZOrder<4, 3, 16 * MiB, 1 * MiB> BrOrder;
            pg8::Gemm g{WSP(bf16_t, WS_SEG + SEG_GG), WL(bf16_t, WL_WBR)}; BrOrder S; S.init(Gq, bxq);
            EpiBranch E{WSP(bf16_t, WS_SEG + SEG_BG), args.in[12] + (size_t)l * 3072, WSP(float, WS_MIXED), WSP(bf16_t, WS_MIXB)};
            pg8::gemm_phase<512, EpiBranch, BrOrder, true, true>(F.lds, g, S, E);
            SEAM(pb + PH_BRANCH);
        }
        if (IN(pb + PH_WOUT)) { OPQ_WS;
            pg8::Gemm g{WSP(bf16_t, WS_MIXB), WL(bf16_t, WL_WOUT)}; pg8::StaticOrder<4> S; S.init(Gq, bxq);
            EpiRes<false> E{l == 0 ? args.in[0] : args.out, args.out, WSP(bf16_t, WS_ACT), WSP(float, WS_SS), args.in[17] + (size_t)l * 1024};
            pg8::gemm_phase<1024, EpiRes<false>, pg8::StaticOrder<4>, false, true>(F.lds, g, S, E);
            SEAM(pb + PH_WOUT);
        }
        if (IN(pb + PH_FF1)) { OPQ_WS;
            pg8::Gemm g{WSP(bf16_t, WS_ACT), WL(bf16_t, WL_FF1)}; pg8::StaticOrder<16> S; S.init(Gq, bxq);
            EpiFf1 E{WSP(bf16_t, WS_H), WSP(float, WS_SS)};
            pg8::gemm_phase<1024, EpiFf1, pg8::StaticOrder<16>, true, true>(F.lds, g, S, E);
            SEAM(pb + PH_FF1);
        }
        if (IN(pb + PH_FF2)) { OPQ_WS;
            pg8::Gemm g{WSP(bf16_t, WS_H), WL(bf16_t, WL_FF2)}; pg8::StaticOrder<4> S; S.init(Gq, bxq);
            if (l < DEPTH_ - 1) { EpiRes<false> E{args.out, args.out, WSP(bf16_t, WS_ACT), WSP(float, WS_SS), args.in[1] + (size_t)(l + 1) * 1024};
                pg8::gemm_phase<4096, EpiRes<false>, pg8::StaticOrder<4>, false, true>(F.lds, g, S, E); }
            else { EpiRes<true> E{args.out, args.out, WSP(bf16_t, WS_ACT), WSP(float, WS_SS), args.in[1]};
                pg8::gemm_phase<4096, EpiRes<true>, pg8::StaticOrder<4>, false, true>(F.lds, g, S, E); }
            SEAM(pb + PH_FF2);
        }
    }
#undef IN
#undef SEAM
#undef WSP
#undef WL
#undef OPQ_WS
}

static int g_grid = 0;
static bool mk_setup() {
    if (g_grid) return g_grid > 0;
    int dev = 0, cus = 0;
    if (hipGetDevice(&dev) != hipSuccess || hipDeviceGetAttribute(&cus, hipDeviceAttributeMultiprocessorCount, dev) != hipSuccess) { g_grid = -1; return false; }
    if (hipFuncSetAttribute((const void*)mk_fwd, hipFuncAttributeMaxDynamicSharedMemorySize, LDS_BYTES) != hipSuccess) { fprintf(stderr, "mk: hipFuncSetAttribute failed\n"); g_grid = -1; return false; }
    (void)hipGetLastError();
    g_grid = cus;
    return true;
}
static void mk_launch(const Args& base, int lo, int hi, int li, hipStream_t st) {
    Args a = base; a.ph_lo = lo; a.ph_hi = hi; a.li = li;
    hipLaunchKernelGGL(mk_fwd, dim3(g_grid), dim3(NTHREADS), LDS_BYTES, st, a);
}
}
extern "C" void kernel_launch(void* const* d_in, const int* in_sizes, int n_in, void* d_out, int out_size, void* d_ws, size_t ws_size, hipStream_t stream) {
    using namespace mk;
    if (n_in != 20 || out_size != M_ * D_ || ws_size < WS_END) { fprintf(stderr, "kernel_launch: unexpected shapes (n_in %d out %d ws %zu)\n", n_in, out_size, ws_size); return; }
    if (!mk_setup()) return;
    unsigned char* ws = (unsigned char*)d_ws;
    (void)hipMemsetAsync(ws + WS_CTL, 0, CTL_ZERO_BYTES, stream);
    Args a{}; for (int i = 0; i < 20; ++i) a.in[i] = (const float*)d_in[i]; a.out = (float*)d_out; a.ws = ws; a.mix = 7;
    mk_launch(a, 0, PH_TOTAL, 0, stream);
}
```

```cpp
#define PROBE_MASK 0x0u
#include <hip/hip_runtime.h>
#include <cstdio>
#include <cstdint>
#include <cmath>
#define LAS __attribute__((address_space(3)))
#define GAS __attribute__((address_space(1)))
typedef unsigned short bf16_t;
typedef short bf16x8 __attribute__((ext_vector_type(8)));
typedef short bf16x4 __attribute__((ext_vector_type(4)));
typedef float f32x4 __attribute__((ext_vector_type(4)));
typedef float f32x2 __attribute__((ext_vector_type(2)));
typedef unsigned u32x4 __attribute__((ext_vector_type(4)));
typedef unsigned u32x2 __attribute__((ext_vector_type(2)));
typedef GAS unsigned gu32;
#define RLX_AGENT __ATOMIC_RELAXED, __HIP_MEMORY_SCOPE_AGENT
#define LDS_WAIT() asm volatile("s_waitcnt lgkmcnt(0)" ::: "memory")
#define VM_WAIT() asm volatile("s_waitcnt vmcnt(0)" ::: "memory")

__device__ __forceinline__ unsigned cvt_pk_bf16(float lo, float hi) { unsigned r; asm volatile("v_cvt_pk_bf16_f32 %0, %1, %2" : "=v"(r) : "v"(lo), "v"(hi)); return r; }
__device__ __forceinline__ float bf_lo(unsigned u) { return __uint_as_float(u << 16); }
__device__ __forceinline__ float bf_hi(unsigned u) { return __uint_as_float(u & 0xffff0000u); }
__device__ __forceinline__ float bf2f(bf16_t h) { return __uint_as_float(((unsigned)h) << 16); }
__device__ __forceinline__ bf16_t f2bf(float f) { return (bf16_t)(cvt_pk_bf16(f, 0.f) & 0xffffu); }
__device__ __forceinline__ float wave_sum(float v) {
#pragma unroll
    for (int o = 1; o < 64; o <<= 1) v += __shfl_xor(v, o);
    return v;
}
__device__ __forceinline__ void st16_wt(void* p, u32x4 v) { asm volatile("global_store_dwordx4 %0, %1, off sc1\n\ts_nop 1" :: "v"(p), "v"(v) : "memory"); }
__device__ __forceinline__ void st8_wt(void* p, u32x2 v) { asm volatile("global_store_dwordx2 %0, %1, off sc1\n\ts_nop 1" :: "v"(p), "v"(v) : "memory"); }
__device__ __forceinline__ float fast_sigmoid(float x) { return 1.f / (1.f + __expf(-x)); }

namespace pg8 {
constexpr int BM = 256, BK = 64, HALF = 128, HTB = HALF * BK * 2, STAGE_BYTES = 8 * HTB, NXCD = 8, WGM = 8;
__host__ __device__ __forceinline__ int lds_byte(int r, int c) { const int st = (r >> 4) * 2 + (c >> 5), rr = r & 15, cc = c & 31, ob = rr * 64 + cc * 2; return st * 1024 + (ob ^ (((ob >> 9) & 1) << 5)); }
__host__ __device__ __forceinline__ void stage_rc(int b, int& R, int& C) { const int st = b / 1024, sb = b % 1024, swz = sb ^ (((sb >> 9) & 1) << 5); R = (st >> 1) * 16 + swz / 64; C = (st & 1) * 32 + (swz % 64) / 2; }
__host__ __device__ __forceinline__ int perm32(int rho) { const int n = rho >> 4, i = rho & 15; return 8 * (i >> 2) + 4 * n + (i & 3); }

struct Unit { int pm, pn, z; };
struct Gemm { const bf16_t* A; const bf16_t* Bt; };

template <int NN> struct StaticOrder {
    static constexpr int nM = 64, nN = NN, nwg = nM * nN;
    static constexpr size_t ZSA = 0, ZSB = 0;
    int G, c;
    __device__ void init(int G_, int c_) { G = G_; c = c_; }
    __device__ bool next(int i, Unit& u) const {
        const long L = (long)i * G + c; if (L >= nwg) return false;
        int wgid = (int)L; { const int q = nwg / NXCD, r = nwg % NXCD, xcd = wgid % NXCD, off = wgid / NXCD; wgid = (xcd < r ? xcd * (q + 1) : r * (q + 1) + (xcd - r) * q) + off; }
        const int nig = WGM * nN, gid = wgid / nig, fm = gid * WGM, gsz = (nM - fm) < WGM ? (nM - fm) : WGM;
        u.pm = fm + ((wgid % nig) % gsz); u.pn = (wgid % nig) / gsz; u.z = 0; return true;
    }
};
template <int NN, int NZ, size_t ZSA_, size_t ZSB_> struct ZOrder {
    static constexpr size_t ZSA = ZSA_, ZSB = ZSB_;
    StaticOrder<NN> S;
    __device__ void init(int G_, int c_) { S.init(G_, c_); }
    __device__ bool next(int i, Unit& u) const { const bool ok = S.next(i / NZ, u); u.z = i % NZ; return ok; }
};

template <int K, class Epi, class Sched, bool ALIGN_EPI, bool SP2>
__device__ __forceinline__ void gemm_phase(LAS unsigned char* lds, const Gemm g, const Sched& S, const Epi& E) {
    int tid_ = threadIdx.x; asm volatile("" : "+v"(tid_));
    const int tid = tid_, wid = __builtin_amdgcn_readfirstlane(tid >> 6), lane = tid & 63, wr = wid >> 2, wc = wid & 3, fr = lane & 15, fq = lane >> 4;
    constexpr int nt = K / BK, lda = K;
    unsigned voffA[2], voffB[2];
#pragma unroll
    for (int i = 0; i < 2; ++i) { int R, C; stage_rc(tid * 16 + i * 8192, R, C); const int Rb = Epi::PERM ? ((R & ~31) + perm32(R & 31)) : R;
        voffA[i] = (unsigned)(R * lda + C) * 2u; voffB[i] = (unsigned)(Rb * K + C) * 2u; }
    constexpr size_t kstep = (size_t)(BK * 2);
    constexpr size_t hstepA = (size_t)HALF * lda * 2, hstepB = (size_t)HALF * K * 2;
    constexpr size_t tstepA = 2 * hstepA, tstepB = 2 * hstepB;
    const unsigned ldsw = (unsigned)wid * 1024u;
    const int aoff = lds_byte(wr * 64 + fr, fq * 8), boff = lds_byte(wc * 32 + fr, fq * 8);
#define PG8_SA(b, h) (((b) * 2 + (h)) * HTB)
#define PG8_SB(b, h) ((4 + (b) * 2 + (h)) * HTB)
#define PG8_STAGE(bufoff, gbase, voff) do { _Pragma("unroll") for (int _i = 0; _i < 2; ++_i) \
        __builtin_amdgcn_global_load_lds((const unsigned*)((const char*)(gbase) + (voff)[_i]), (LAS unsigned*)(lds + (bufoff) + ldsw + _i * 8192), 16, 0, 0); } while (0)
#define PG8_LDA(dst, b, h) do { _Pragma("unroll") for (int m = 0; m < 4; ++m) _Pragma("unroll") for (int k = 0; k < 2; ++k) dst[m][k] = *(const LAS bf16x8*)(lds + PG8_SA(b, h) + aoff + m * 2048 + k * 1024); } while (0)
#define PG8_LDB(dst, b, h) do { _Pragma("unroll") for (int n = 0; n < 2; ++n) _Pragma("unroll") for (int k = 0; k < 2; ++k) dst[n][k] = *(const LAS bf16x8*)(lds + PG8_SB(b, h) + boff + n * 2048 + k * 1024); } while (0)
#define PG8_MMA(ai, bj, At, Bt) do { __builtin_amdgcn_s_setprio(1); _Pragma("unroll") for (int m = 0; m < 4; ++m) _Pragma("unroll") for (int n = 0; n < 2; ++n) _Pragma("unroll") for (int k = 0; k < 2; ++k) \
        acc[ai][bj][m][n] = __builtin_amdgcn_mfma_f32_16x16x32_bf16(Bt[n][k], At[m][k], acc[ai][bj][m][n], 0, 0, 0); __builtin_amdgcn_s_setprio(0); } while (0)
#define PG8_WAIT_V(n) asm volatile("s_waitcnt vmcnt(" #n ")" ::: "memory")
#define PG8_WAIT_L(n) asm volatile("s_waitcnt lgkmcnt(" #n ")" ::: "memory")
#define PG8_BAR __builtin_amdgcn_s_barrier()
#define PG8_SCHED __builtin_amdgcn_sched_barrier(0)
#define PG8_ABASE(u) ((const char*)g.A + (size_t)(u).z * Sched::ZSA + (size_t)(u).pm * tstepA)
#define PG8_BBASE(u) ((const char*)g.Bt + (size_t)(u).z * Sched::ZSB + (size_t)(u).pn * tstepB)
    Unit cur, nxt; int ui = 0;
    if (!S.next(0, cur)) return;
    f32x4 acc[2][2][4][2];
#pragma unroll
    for (int a = 0; a < 2; ++a)
#pragma unroll
        for (int b = 0; b < 2; ++b)
#pragma unroll
            for (int m = 0; m < 4; ++m)
#pragma unroll
                for (int n = 0; n < 2; ++n) acc[a][b][m][n] = (f32x4){0.f, 0.f, 0.f, 0.f};
    bf16x8 At[4][2], B0[2][2], B1[2][2];
    const char* cA = PG8_ABASE(cur); const char* cB = PG8_BBASE(cur);
    if constexpr (SP2) {
        PG8_STAGE(PG8_SB(0, 0), cB, voffB); PG8_STAGE(PG8_SB(0, 1), cB + hstepB, voffB); PG8_STAGE(PG8_SA(0, 0), cA, voffA); PG8_STAGE(PG8_SA(0, 1), cA + hstepA, voffA);
        if (wr == 1) PG8_BAR;
        PG8_WAIT_V(2); PG8_BAR;
        PG8_STAGE(PG8_SB(1, 0), cB + kstep, voffB); PG8_STAGE(PG8_SA(1, 0), cA + kstep, voffA); PG8_STAGE(PG8_SB(1, 1), cB + hstepB + kstep, voffB);
        PG8_WAIT_V(6); PG8_BAR;
    } else {
        PG8_STAGE(PG8_SB(0, 0), cB, voffB); PG8_STAGE(PG8_SA(0, 0), cA, voffA); PG8_STAGE(PG8_SB(0, 1), cB + hstepB, voffB); PG8_STAGE(PG8_SA(0, 1), cA + hstepA, voffA);
        if (wr == 1) PG8_BAR;
        PG8_WAIT_V(4); PG8_BAR;
        PG8_STAGE(PG8_SB(1, 0), cB + kstep, voffB); PG8_STAGE(PG8_SA(1, 0), cA + kstep, voffA); PG8_STAGE(PG8_SB(1, 1), cB + hstepB + kstep, voffB);
        PG8_WAIT_V(6); PG8_BAR;
    }
    for (;;) {
        const bool has_next = S.next(ui + 1, nxt);
        const char* nA = has_next ? PG8_ABASE(nxt) : cA; const char* nB = has_next ? PG8_BBASE(nxt) : cB;
        for (int t = 0; t < nt; t += 2) {
            const bool last = (t == nt - 2);
            const char* a1 = cA + (size_t)(t + 1) * kstep;
            const char* a2 = last ? nA : cA + (size_t)(t + 2) * kstep; const char* b2 = last ? nB : cB + (size_t)(t + 2) * kstep;
            const char* a3 = a2 + kstep; const char* b3 = b2 + kstep;
            if constexpr (SP2) {
            PG8_LDB(B0, 0, 0); PG8_LDB(B1, 0, 1); PG8_SCHED; PG8_LDA(At, 0, 0); PG8_STAGE(PG8_SA(1, 1), a1 + hstepA, voffA);
            PG8_WAIT_V(8); PG8_WAIT_L(0); PG8_BAR; PG8_MMA(0, 0, At, B0); PG8_MMA(0, 1, At, B1); PG8_BAR; PG8_SCHED;
            PG8_LDA(At, 0, 1); PG8_STAGE(PG8_SB(0, 0), b2, voffB); PG8_STAGE(PG8_SB(0, 1), b2 + hstepB, voffB); PG8_STAGE(PG8_SA(0, 0), a2, voffA);
            PG8_WAIT_V(8); PG8_WAIT_L(0); PG8_BAR; PG8_MMA(1, 0, At, B0); PG8_MMA(1, 1, At, B1); PG8_BAR; PG8_SCHED;
            PG8_LDB(B0, 1, 0); PG8_LDB(B1, 1, 1); PG8_SCHED; PG8_LDA(At, 1, 0); PG8_STAGE(PG8_SA(0, 1), a2 + hstepA, voffA);
            PG8_WAIT_V(8); PG8_WAIT_L(0); PG8_BAR; PG8_MMA(0, 0, At, B0); PG8_MMA(0, 1, At, B1); PG8_BAR; PG8_SCHED;
            PG8_LDA(At, 1, 1); PG8_STAGE(PG8_SB(1, 0), b3, voffB); PG8_STAGE(PG8_SB(1, 1), b3 + hstepB, voffB); PG8_STAGE(PG8_SA(1, 0), a3, voffA);
            PG8_WAIT_V(8); PG8_WAIT_L(0); PG8_BAR; PG8_MMA(1, 0, At, B0); PG8_MMA(1, 1, At, B1); PG8_BAR; PG8_SCHED;
            } else {
            PG8_LDB(B0, 0, 0); PG8_SCHED; PG8_LDA(At, 0, 0); PG8_STAGE(PG8_SA(1, 1), a1 + hstepA, voffA);
            PG8_WAIT_L(8); PG8_BAR; PG8_WAIT_L(0); PG8_MMA(0, 0, At, B0); PG8_BAR; PG8_SCHED;
            PG8_LDB(B1, 0, 1); PG8_STAGE(PG8_SB(0, 0), b2, voffB);
            PG8_BAR; PG8_WAIT_L(0); PG8_MMA(0, 1, At, B1); PG8_BAR;
            PG8_LDA(At, 0, 1); PG8_STAGE(PG8_SA(0, 0), a2, voffA);
            PG8_BAR; PG8_WAIT_L(0); PG8_MMA(1, 0, At, B0); PG8_BAR; PG8_SCHED;
            PG8_STAGE(PG8_SB(0, 1), b2 + hstepB, voffB);
            PG8_WAIT_V(6); PG8_BAR; PG8_MMA(1, 1, At, B1); PG8_BAR;
            PG8_LDB(B0, 1, 0); PG8_SCHED; PG8_LDA(At, 1, 0); PG8_STAGE(PG8_SA(0, 1), a2 + hstepA, voffA);
            PG8_WAIT_L(8); PG8_BAR; PG8_WAIT_L(0); PG8_MMA(0, 0, At, B0); PG8_BAR; PG8_SCHED;
            PG8_LDB(B1, 1, 1); PG8_STAGE(PG8_SB(1, 0), b3, voffB);
            PG8_BAR; PG8_WAIT_L(0); PG8_MMA(0, 1, At, B1); PG8_BAR;
            PG8_LDA(At, 1, 1); PG8_STAGE(PG8_SA(1, 0), a3, voffA);
            PG8_BAR; PG8_WAIT_L(0); PG8_MMA(1, 0, At, B0); PG8_BAR; PG8_SCHED;
            PG8_STAGE(PG8_SB(1, 1), b3 + hstepB, voffB);
            PG8_WAIT_V(6); PG8_BAR; PG8_MMA(1, 1, At, B1); PG8_BAR;
            }
        }
        if constexpr (ALIGN_EPI) { if (wr == 0) PG8_BAR; }
        { int tz = threadIdx.x; asm volatile("" : "+v"(tz)); const int l2 = tz & 63; E(acc, cur, wr, wc, l2 & 15, l2 >> 4); }
        if (!has_next) break;
        if (!E.keep_acc(cur)) {
#pragma unroll
        for (int a = 0; a < 2; ++a)
#pragma unroll
            for (int b = 0; b < 2; ++b)
#pragma unroll
                for (int m = 0; m < 4; ++m)
#pragma unroll
                    for (int n = 0; n < 2; ++n) acc[a][b][m][n] = (f32x4){0.f, 0.f, 0.f, 0.f};
        }
        cur = nxt; cA = nA; cB = nB; ++ui;
        if constexpr (ALIGN_EPI) { if (wr == 1) PG8_BAR; }
    }
    PG8_WAIT_V(0);
    if constexpr (!ALIGN_EPI) { if (wr == 0) PG8_BAR; }
    PG8_BAR;
#undef PG8_SA
#undef PG8_SB
#undef PG8_STAGE
#undef PG8_LDA
#undef PG8_LDB
#undef PG8_MMA
#undef PG8_WAIT_V
#undef PG8_WAIT_L
#undef PG8_BAR
#undef PG8_SCHED
#undef PG8_ABASE
#undef PG8_BBASE
}
}

#define XB_TMO      128
#define XB_XCNT(j)  (256  + 64 * (j))
#define XB_XSUB(j)  (1280 + 64 * (j))
#define XB_XGEN(j)  (2304 + 64 * (j))
#define XB_TOP      3328
#define XB_TOPGEN   3392
#define XCD_BAR_WORDS 3456
#define XB_SPIN_CAP (1u << 18)
__device__ __forceinline__ unsigned xb_ld(unsigned* p)              { return __hip_atomic_load(p, __ATOMIC_RELAXED, __HIP_MEMORY_SCOPE_AGENT); }
__device__ __forceinline__ unsigned xb_add(unsigned* p, unsigned v) { return __hip_atomic_fetch_add(p, v, __ATOMIC_RELAXED, __HIP_MEMORY_SCOPE_AGENT); }
__device__ __forceinline__ unsigned xb_xcc_id() { return (unsigned)__builtin_amdgcn_s_getreg((3 << 11) | 20) & 0xFu; }
#define XB_SPIN(cond, bar) do { unsigned _sp = 0; while (cond) { __builtin_amdgcn_s_sleep(1); \
    if ((++_sp & 255u) == 0u) { if (xb_ld(&(bar)[XB_TMO])) break; if (_sp > XB_SPIN_CAP) { atomicAdd(&(bar)[XB_TMO], 1u); break; } } } } while (0)
struct XcdBarrier { unsigned* bar; unsigned x; volatile LAS unsigned* st; };
__device__ __forceinline__ XcdBarrier xcd_barrier_post(unsigned* bar, volatile LAS unsigned* st) {
    XcdBarrier b; b.bar = bar; b.x = xb_xcc_id(); b.st = st;
    if (threadIdx.x == 0) (void)xb_add(&bar[XB_XCNT(b.x)], 1u);
    return b;
}
__device__ __forceinline__ void xcd_barrier_complete(unsigned* bar, unsigned x, unsigned& nloc, unsigned& nx) {
    const unsigned G = gridDim.x * gridDim.y * gridDim.z;
    unsigned sum, cnt, mine, sp = 0u;
    for (;;) {
        sum = 0u; cnt = 0u; mine = 0u;
#pragma unroll
        for (unsigned j = 0; j < 16; ++j) { const unsigned c = xb_ld(&bar[XB_XCNT(j)]); sum += c; cnt += (c > 0u) ? 1u : 0u; mine = (j == x) ? c : mine; }
        if (sum == G) break;
        __builtin_amdgcn_s_sleep(1);
        if ((++sp & 255u) == 0u) { if (xb_ld(&bar[XB_TMO])) break; if (sp > XB_SPIN_CAP) { atomicAdd(&bar[XB_TMO], 1u); break; } }
    }
    nloc = mine > 0u ? mine : 1u; nx = cnt > 0u ? cnt : 1u;
}
__device__ __forceinline__ void xcd_barrier(const XcdBarrier& b) {
    asm volatile("s_waitcnt vmcnt(0)" ::: "memory");
    __syncthreads();
    if (threadIdx.x == 0) {
        unsigned* bar = b.bar;
        __builtin_amdgcn_s_waitcnt(0);
        unsigned nloc = b.st[0], nx = b.st[1];
        if (nloc == 0u) { xcd_barrier_complete(bar, b.x, nloc, nx); b.st[0] = nloc; b.st[1] = nx; }
        const unsigned old = xb_add(&bar[XB_XSUB(b.x)], 1u);
        const unsigned gen = old / nloc;
        if (old + 1u == (gen + 1u) * nloc) {
            __builtin_amdgcn_fence(__ATOMIC_RELEASE, "agent");
            asm volatile("s_waitcnt vmcnt(0)" ::: "memory");
            const unsigned og = xb_add(&bar[XB_TOP], 1u);
            const unsigned tg = og / nx;
            if (og + 1u == (tg + 1u) * nx) xb_add(&bar[XB_TOPGEN], 1u);
            else XB_SPIN(xb_ld(&bar[XB_TOPGEN]) == tg, bar);
            __builtin_amdgcn_fence(__ATOMIC_ACQUIRE, "agent");
            xb_add(&bar[XB_XGEN(b.x)], 1u);
            asm volatile("s_waitcnt vmcnt(0)" ::: "memory");
        } else {
            XB_SPIN(xb_ld(&bar[XB_XGEN(b.x)]) == gen, bar);
            __builtin_amdgcn_fence(__ATOMIC_ACQUIRE, "agent");
            asm volatile("s_waitcnt vmcnt(0)" ::: "memory");
        }
    }
    __syncthreads();
}
namespace mk {
constexpr int NWAVES = 8, NTHREADS = 512;
constexpr int B_ = 2, T_ = 8192, D_ = 1024, M_ = B_ * T_, DEPTH_ = 4, D_IN_ = 8216, D_FF_ = 4096, NPAD_ = 8448;
constexpr int OFF_GQ = 0, OFF_GK = 512, OFF_GV = 1024, OFF_GG = 1536, OFF_GA = 2048, OFF_MQ = 2064, OFF_MK = 2576, OFF_MV = 3088,
              OFF_LQ = 3600, OFF_LK = 3856, OFF_LV = 4112, OFF_LO = 4624, OFF_LI = 5136, OFF_LF = 5140, OFF_BG = 5144;
constexpr float EPS_ = 1e-6f;
constexpr size_t MiB = 1u << 20;
constexpr size_t WS_CTL = 0, CTL_ZERO_BYTES = 1 * MiB;
constexpr size_t WS_SS = 1 * MiB;
constexpr size_t WS_SMALL = 2 * MiB;
constexpr size_t WS_ROPE = 4 * MiB;
constexpr size_t WS_MISC = 6 * MiB;
constexpr size_t WS_WTS = 8 * MiB;
constexpr size_t WL_WIN = 0, WL_WBR = 16 * MiB + MiB / 2, WL_WOUT = WL_WBR + 3 * MiB, WL_FF1 = WL_WOUT + 2 * MiB, WL_FF2 = WL_FF1 + 8 * MiB, WL_STRIDE = WL_FF2 + 8 * MiB;
static_assert(WL_STRIDE == 37 * MiB + MiB / 2, "weights per layer");
constexpr size_t WS_SEG = 158 * MiB;
constexpr size_t SEG_GQ = 0, SEG_GK = 16 * MiB, SEG_GV = 32 * MiB, SEG_MK = 48 * MiB, SEG_MV = 64 * MiB, SEG_LQ = 80 * MiB, SEG_LK = 88 * MiB, SEG_LV = 96 * MiB,
                 SEG_GG = 112 * MiB, SEG_MQ = 128 * MiB, SEG_LO = 144 * MiB, SEG_BG = 160 * MiB;
constexpr size_t WS_MIXED = WS_SEG;
constexpr size_t WS_MIXB = WS_SEG + 64 * MiB;
constexpr size_t WS_H = WS_SEG;
constexpr size_t WS_ACT = 414 * MiB;
constexpr size_t WS_SCR = 446 * MiB;
constexpr size_t WS_END = 512 * MiB;
static_assert(WS_WTS + 4 * WL_STRIDE <= WS_SEG, "weights fit");
constexpr int CW_BAR = 4096;
constexpr int N_BAR_REGIONS = 16;
constexpr int RING_BYTES = 131072, MISC_OFF = RING_BYTES + 320, LDS_BYTES = 147456;

struct Args { const float* in[20]; float* out; unsigned char* ws; int ph_lo, ph_hi, li, mix; };

struct Frame {
    LAS unsigned char* lds; volatile LAS unsigned* MISC; gu32* ctl; unsigned char* ws;
    int tid, lane, wave, G, vcu;
};

__device__ __forceinline__ int win_src(int n) {
    if (n < 512) return OFF_GQ + n;
    if (n < 1024) return OFF_GK + (n - 512);
    if (n < 1536) return OFF_GV + (n - 1024);
    if (n < 2048) return OFF_MK + (n - 1536);
    if (n < 2560) return OFF_MV + (n - 2048);
    if (n < 2816) return OFF_LQ + (n - 2560);
    if (n < 3072) return OFF_LK + (n - 2816);
    if (n < 3584) return OFF_LV + (n - 3072);
    if (n < 4096) return OFF_GG + (n - 3584);
    if (n < 4608) return OFF_MQ + (n - 4096);
    if (n < 5120) return OFF_LO + (n - 4608);
    if (n < 8192) return OFF_BG + (n - 5120);
    if (n < 8208) return OFF_GA + (n - 8192);
    if (n < 8212) return OFF_LI + (n - 8208);
    if (n < 8216) return OFF_LF + (n - 8212);
    return -1;
}
__device__ __forceinline__ void transpose_item(const float* W, int ldw, bf16_t* WT, int K, int k0, int n0, int sc, LAS float* scr, int lane) {
#pragma unroll 8
    for (int i = 0; i < 32; ++i) { const int kk = 2 * i + (lane >> 5); scr[kk * 33 + (lane & 31)] = sc >= 0 ? W[(size_t)(k0 + kk) * ldw + sc] : 0.f; }
    LDS_WAIT(); asm volatile("" ::: "memory");
    const int c = lane & 7;
#pragma unroll
    for (int j = 0; j < 4; ++j) { const int n = (lane >> 3) + 8 * j; const LAS float* s = scr + (8 * c) * 33 + n;
        u32x4 o; o.x = cvt_pk_bf16(s[0 * 33], s[1 * 33]); o.y = cvt_pk_bf16(s[2 * 33], s[3 * 33]); o.z = cvt_pk_bf16(s[4 * 33], s[5 * 33]); o.w = cvt_pk_bf16(s[6 * 33], s[7 * 33]);
        *(GAS u32x4*)(WT + (size_t)(n0 + n) * K + k0 + 8 * c) = o; }
    LDS_WAIT(); asm volatile("" ::: "memory");
}
constexpr int IT_WIN = 16 * (NPAD_ / 32), IT_BR = 8 * 32, IT_WOUT = 16 * 32, IT_FF1 = 16 * 128, IT_FF2 = 64 * 32;
constexpr int IT_LAYER = IT_WIN + 3 * IT_BR + IT_WOUT + IT_FF1 + IT_FF2;
__device__ __forceinline__ void weights_item(const Args& a, unsigned char* ws, int l, int it, LAS float* scr, int lane) {
    unsigned char* wl = ws + WS_WTS + (size_t)l * WL_STRIDE;
    int r = it;
    if (r < IT_WIN) { const int kb = r / (NPAD_ / 32), nb = r % (NPAD_ / 32); const int sc = win_src(nb * 32 + (lane & 31));
        transpose_item(a.in[2] + (size_t)l * 1024 * D_IN_, D_IN_, (bf16_t*)(wl + WL_WIN), 1024, kb * 64, nb * 32, sc, scr, lane); return; }
    r -= IT_WIN;
    if (r < 3 * IT_BR) { const int z = r / IT_BR, q = r % IT_BR, kb = q / 32, nb = q % 32;
        transpose_item((z == 0 ? a.in[13] : (z == 1 ? a.in[14] : a.in[15])) + (size_t)l * 512 * 1024, 1024, (bf16_t*)(wl + WL_WBR + (size_t)z * MiB), 512, kb * 64, nb * 32, nb * 32 + (lane & 31), scr, lane); return; }
    r -= 3 * IT_BR;
    if (r < IT_WOUT) { const int kb = r / 32, nb = r % 32;
        transpose_item(a.in[16] + (size_t)l * 1024 * 1024, 1024, (bf16_t*)(wl + WL_WOUT), 1024, kb * 64, nb * 32, nb * 32 + (lane & 31), scr, lane); return; }
    r -= IT_WOUT;
    if (r < IT_FF1) { const int kb = r / 128, nb = r % 128;
        transpose_item(a.in[18] + (size_t)l * 1024 * 4096, 4096, (bf16_t*)(wl + WL_FF1), 1024, kb * 64, nb * 32, nb * 32 + (lane & 31), scr, lane); return; }
    r -= IT_FF1;
    { const int kb = r / 32, nb = r % 32;
        transpose_item(a.in[19] + (size_t)l * 4096 * 1024, 1024, (bf16_t*)(wl + WL_FF2), 4096, kb * 64, nb * 32, nb * 32 + (lane & 31), scr, lane); }
}
__device__ __forceinline__ void prep_row(const float* xrow, const float* g, bf16_t* arow, float* ssrow, int lane) {
    const GAS f32x4* xr = (const GAS f32x4*)xrow + lane;
    f32x4 v[4]; float s = 0.f;
#pragma unroll
    for (int j = 0; j < 4; ++j) { v[j] = xr[64 * j]; s += (v[j].x * v[j].x + v[j].y * v[j].y) + (v[j].z * v[j].z + v[j].w * v[j].w); }
    s = wave_sum(s);
    GAS u32x2* o8 = (GAS u32x2*)arow + lane;
#pragma unroll
    for (int j = 0; j < 4; ++j) { const f32x4 gg = ((const GAS f32x4*)g)[lane + 64 * j]; u32x2 w; w.x = cvt_pk_bf16(v[j].x * gg.x, v[j].y * gg.y); w.y = cvt_pk_bf16(v[j].z * gg.z, v[j].w * gg.w); o8[64 * j] = w; }
    if (lane < 16) ssrow[lane] = lane == 0 ? s : 0.f;
}
__device__ __forceinline__ void p0_prologue(Frame& F, const Args& a, int l_lo, int l_hi, bool do_rows) {
    LAS float* scr = (LAS float*)(F.lds + F.wave * 16384);
    const int gw = F.vcu * NWAVES + F.wave, NGW = F.G * NWAVES;
    const int nit = (l_hi - l_lo) * IT_LAYER;
    for (int it = gw; it < nit; it += NGW) weights_item(a, F.ws, l_lo + it / IT_LAYER, it % IT_LAYER, scr, F.lane);
    if (do_rows) {
        for (int m = gw; m < M_; m += NGW) prep_row(a.in[0] + (size_t)m * D_, a.in[1], (bf16_t*)(F.ws + WS_ACT) + (size_t)m * D_, (float*)(F.ws + WS_SS) + (size_t)m * 16, F.lane);
        float* COS = (float*)(F.ws + WS_ROPE); float* SIN = COS + 8192 * 32;
        for (int idx = gw * 64 + F.lane; idx < 8192 * 32; idx += NGW * 64) { const int t = idx >> 5, i = idx & 31;
            const float inv = 1.0f / powf(10000.0f, (float)(2 * i) / 64.0f); const float ang = (float)t * inv; COS[idx] = cosf(ang); SIN[idx] = sinf(ang); }
    }
}

__device__ __forceinline__ void row_rstd(const float* ss, int row0, float (&rs)[2][4]) {
#pragma unroll
    for (int ai = 0; ai < 2; ++ai)
#pragma unroll
        for (int m = 0; m < 4; ++m) { const GAS f32x4* p = (const GAS f32x4*)(ss + (size_t)(row0 + ai * 128 + m * 16) * 16);
            const f32x4 a = p[0], b = p[1], c = p[2], d = p[3];
            const float s = ((a.x + a.y) + (a.z + a.w)) + ((b.x + b.y) + (b.z + b.w)) + ((c.x + c.y) + (c.z + c.w)) + ((d.x + d.y) + (d.z + d.w));
            rs[ai][m] = rsqrtf(s * (1.f / 1024.f) + EPS_); }
}
struct EpiWin {
    static constexpr bool PERM = true;
    __device__ __forceinline__ bool keep_acc(const pg8::Unit&) const { return false; }
    bf16_t* seg; float* small_; const float* ss;
    __device__ __forceinline__ void operator()(const f32x4 (&acc)[2][2][4][2], const pg8::Unit& u, int wr, int wc, int fr, int fq) const {
        const int row0 = u.pm * 256 + wr * 64 + fr;
        float rs[2][4]; row_rstd(ss, row0, rs);
        const int pn = u.pn;
        if (pn < 32) {
            int st, width;
            if (pn < 10) { st = pn & ~1; width = 512; } else if (pn < 12) { st = pn; width = 256; } else if (pn < 20) { st = 12 + ((pn - 12) & ~1); width = 512; } else { st = 20; width = 3072; }
            bf16_t* base = seg + (size_t)M_ * 256 * st + (pn - st) * 256 + wc * 32 + 8 * fq;
#pragma unroll
            for (int ai = 0; ai < 2; ++ai)
#pragma unroll
                for (int m = 0; m < 4; ++m) { bf16_t* rowp = base + (size_t)(row0 + ai * 128 + m * 16) * width; const float r = rs[ai][m];
#pragma unroll
                    for (int bj = 0; bj < 2; ++bj) { const f32x4 v0 = acc[ai][bj][m][0] * r, v1 = acc[ai][bj][m][1] * r;
                        u32x4 w; w.x = cvt_pk_bf16(v0[0], v0[1]); w.y = cvt_pk_bf16(v0[2], v0[3]); w.z = cvt_pk_bf16(v1[0], v1[1]); w.w = cvt_pk_bf16(v1[2], v1[3]);
                        st16_wt(rowp + bj * 128, w); } }
        } else if (wc == 0) {
#pragma unroll
            for (int ai = 0; ai < 2; ++ai)
#pragma unroll
                for (int m = 0; m < 4; ++m) { float* p = small_ + (size_t)(row0 + ai * 128 + m * 16) * 32 + 8 * fq; const float r = rs[ai][m];
                    *(GAS f32x4*)p = acc[ai][0][m][0] * r; *(GAS f32x4*)(p + 4) = acc[ai][0][m][1] * r; }
        }
    }
};
struct EpiFf1 {
    static constexpr bool PERM = true;
    __device__ __forceinline__ bool keep_acc(const pg8::Unit&) const { return false; }
    bf16_t* H; const float* ss;
    __device__ __forceinline__ void operator()(const f32x4 (&acc)[2][2][4][2], const pg8::Unit& u, int wr, int wc, int fr, int fq) const {
        const int row0 = u.pm * 256 + wr * 64 + fr;
        float rs[2][4]; row_rstd(ss, row0, rs);
        bf16_t* base = H + u.pn * 256 + wc * 32 + 8 * fq;
#pragma unroll
        for (int ai = 0; ai < 2; ++ai)
#pragma unroll
            for (int m = 0; m < 4; ++m) { bf16_t* rowp = base + (size_t)(row0 + ai * 128 + m * 16) * 4096; const float r = rs[ai][m];
#pragma unroll
                for (int bj = 0; bj < 2; ++bj) { f32x4 v0 = acc[ai][bj][m][0] * r, v1 = acc[ai][bj][m][1] * r;
                    v0 = __builtin_elementwise_max(v0, (f32x4){0.f, 0.f, 0.f, 0.f}); v1 = __builtin_elementwise_max(v1, (f32x4){0.f, 0.f, 0.f, 0.f}); v0 = v0 * v0; v1 = v1 * v1;
                    u32x4 w; w.x = cvt_pk_bf16(v0[0], v0[1]); w.y = cvt_pk_bf16(v0[2], v0[3]); w.z = cvt_pk_bf16(v1[0], v1[1]); w.w = cvt_pk_bf16(v1[2], v1[3]);
                    st16_wt(rowp + bj * 128, w); } }
    }
};
template <bool LAST> struct EpiRes {
    static constexpr bool PERM = false;
    __device__ __forceinline__ bool keep_acc(const pg8::Unit&) const { return false; }
    const float* xin; float* xout; bf16_t* act; float* ss; const float* g;
    __device__ __forceinline__ void operator()(const f32x4 (&acc)[2][2][4][2], const pg8::Unit& u, int wr, int wc, int fr, int fq) const {
        const int row0 = u.pm * 256 + wr * 64 + fr, col0 = u.pn * 256 + wc * 32 + 4 * fq;
        f32x4 gv[2][2];
        if (!LAST) {
#pragma unroll
            for (int bj = 0; bj < 2; ++bj)
#pragma unroll
                for (int n = 0; n < 2; ++n) gv[bj][n] = *(const GAS f32x4*)(g + col0 + bj * 128 + n * 16);
        }
#pragma unroll
        for (int ai = 0; ai < 2; ++ai)
#pragma unroll
            for (int m = 0; m < 4; ++m) { const int row = row0 + ai * 128 + m * 16; const size_t off = (size_t)row * 1024 + col0; float q = 0.f;
#pragma unroll
                for (int bj = 0; bj < 2; ++bj)
#pragma unroll
                    for (int n = 0; n < 2; ++n) { const size_t o2 = off + bj * 128 + n * 16; const f32x4 x = *(const GAS f32x4*)(xin + o2) + acc[ai][bj][m][n];
                        *(GAS f32x4*)(xout + o2) = x;
                        if (!LAST) { q += (x[0] * x[0] + x[1] * x[1]) + (x[2] * x[2] + x[3] * x[3]); const f32x4 a = x * gv[bj][n];
                            u32x2 w; w.x = cvt_pk_bf16(a[0], a[1]); w.y = cvt_pk_bf16(a[2], a[3]); *(GAS u32x2*)(act + o2) = w; } }
                if (!LAST) { q += __shfl_xor(q, 16); q += __shfl_xor(q, 32); if (fq == 0) ss[(size_t)row * 16 + u.pn * 4 + wc] = q; }
                if (m & 1) asm volatile("" ::: "memory"); }
    }
};
struct EpiBranch {
    static constexpr bool PERM = false;
    const bf16_t* bg; const float* gate_b; bf16_t* mixb;
    __device__ __forceinline__ bool keep_acc(const pg8::Unit& u) const { return u.z != 2; }
    __device__ __forceinline__ void operator()(f32x4 (&acc)[2][2][4][2], const pg8::Unit& u, int wr, int wc, int fr, int fq) const {
        const int row0 = u.pm * 256 + wr * 64 + fr, col0 = u.pn * 256 + wc * 32 + 4 * fq, z = u.z;
        const int z2 = z < 2 ? z + 1 : 2;
        f32x4 ga[2][2], gc[2][2];
#pragma unroll
        for (int bj = 0; bj < 2; ++bj)
#pragma unroll
            for (int n = 0; n < 2; ++n) { ga[bj][n] = *(const GAS f32x4*)(gate_b + z * 1024 + col0 + bj * 128 + n * 16); gc[bj][n] = *(const GAS f32x4*)(gate_b + z2 * 1024 + col0 + bj * 128 + n * 16); }
#pragma unroll
        for (int ai = 0; ai < 2; ++ai)
#pragma unroll
            for (int m = 0; m < 4; ++m) { const int row = row0 + ai * 128 + m * 16;
#pragma unroll
                for (int bj = 0; bj < 2; ++bj)
#pragma unroll
                    for (int n = 0; n < 2; ++n) { const int c = col0 + bj * 128 + n * 16;
                        const u32x2 ba = *(const GAS u32x2*)(bg + (size_t)row * 3072 + z * 1024 + c);
                        const u32x2 bc = *(const GAS u32x2*)(bg + (size_t)row * 3072 + z2 * 1024 + c);
                        const float xa[4] = {bf_lo(ba.x) + ga[bj][n][0], bf_hi(ba.x) + ga[bj][n][1], bf_lo(ba.y) + ga[bj][n][2], bf_hi(ba.y) + ga[bj][n][3]};
                        const float xc[4] = {bf_lo(bc.x) + gc[bj][n][0], bf_hi(bc.x) + gc[bj][n][1], bf_lo(bc.y) + gc[bj][n][2], bf_hi(bc.y) + gc[bj][n][3]};
                        f32x4 f;
#pragma unroll
                        for (int k = 0; k < 4; ++k) { const float ea = __expf(-fminf(fmaxf(xa[k], -30.f), 30.f));
                            if (z == 2) f[k] = __builtin_amdgcn_rcpf(1.f + ea);
                            else { const float ec = __expf(-fminf(fmaxf(xc[k], -30.f), 30.f)); f[k] = (1.f + ec) * __builtin_amdgcn_rcpf(1.f + ea); } }
                        const f32x4 v = acc[ai][bj][m][n] * f;
                        if (z == 2) { u32x2 w; w.x = cvt_pk_bf16(v[0], v[1]); w.y = cvt_pk_bf16(v[2], v[3]); *(GAS u32x2*)(mixb + (size_t)row * 1024 + c) = w; }
                        else acc[ai][bj][m][n] = v; }
                if (m & 1) asm volatile("" ::: "memory"); }
    }
};
}
namespace mk {
constexpr size_t SCR_GLA_KV = 36 * MiB;
constexpr size_t MISC_GLA_DT = 256 * 1024;
constexpr int GL_QD = 0, GL_KI = 17408, GL_KET = 34816, GL_VT = 53248, GL_ST = 71680, GL_DEC = 106496, GL_GA = 107008, GL_BC = 111104, GL_NRM = 113152, GL_END = 115200;
constexpr int P128 = 136, P64 = 72;

__device__ __forceinline__ bf16x8 lds16(const LAS bf16_t* p) { return *(const LAS bf16x8*)p; }
__device__ __forceinline__ bf16x8 lds8x2(const LAS bf16_t* p0, const LAS bf16_t* p1) {
    const bf16x4 a = *(const LAS bf16x4*)p0, b = *(const LAS bf16x4*)p1;
    return __builtin_shufflevector(a, b, 0, 1, 2, 3, 4, 5, 6, 7);
}
__device__ __forceinline__ bf16x8 pack8(const f32x4 a, const f32x4 b) {
    u32x4 w; w.x = cvt_pk_bf16(a[0], a[1]); w.y = cvt_pk_bf16(a[2], a[3]); w.z = cvt_pk_bf16(b[0], b[1]); w.w = cvt_pk_bf16(b[2], b[3]);
    return __builtin_bit_cast(bf16x8, w);
}
#define MFMA16(a, b, c) __builtin_amdgcn_mfma_f32_16x16x32_bf16((a), (b), (c), 0, 0, 0)

template <bool PASS_C>
__device__ __forceinline__ void gla_unit(LAS unsigned char* lds, const Args& args, int l, int u) {
    int tid_ = threadIdx.x; asm volatile("" : "+v"(tid_));
    const int tid = tid_, lane = tid & 63, w = __builtin_amdgcn_readfirstlane(tid >> 6), lr = lane & 15, lg = lane >> 4;
    const int bh = u >> 5, sc = u & 31, b = bh >> 2, h = bh & 3;
    const size_t mbase = (size_t)b * T_ + (size_t)sc * 256;
    unsigned char* ws = args.ws; asm volatile("" : "+s"(ws));
    const bf16_t* GQ = (const bf16_t*)(ws + WS_SEG + SEG_GQ) + h * 128; const bf16_t* GK = (const bf16_t*)(ws + WS_SEG + SEG_GK) + h * 128;
    const bf16_t* GV = (const bf16_t*)(ws + WS_SEG + SEG_GV) + h * 128; bf16_t* GG = (bf16_t*)(ws + WS_SEG + SEG_GG) + h * 128;
    const float* SMALL = (const float*)(ws + WS_SMALL);
    float* KV = (float*)(ws + WS_SCR + SCR_GLA_KV) + (size_t)u * 16384; float* DT = (float*)(ws + WS_MISC + MISC_GLA_DT) + (size_t)u * 128;
    LAS bf16_t* QD = (LAS bf16_t*)(lds + GL_QD); LAS bf16_t* KI = (LAS bf16_t*)(lds + GL_KI); LAS bf16_t* KET = (LAS bf16_t*)(lds + GL_KET);
    LAS bf16_t* VT = (LAS bf16_t*)(lds + GL_VT); LAS bf16_t* ST = (LAS bf16_t*)(lds + GL_ST);
    LAS float* DEC = (LAS float*)(lds + GL_DEC); LAS float* GA = (LAS float*)(lds + GL_GA); LAS float* BC = (LAS float*)(lds + GL_BC); LAS float* NRM = (LAS float*)(lds + GL_NRM);
    const int d = tid & 127, tq = tid >> 7;
    float aup[16];
    { const float* a_up = args.in[3] + (size_t)l * 16 * 512 + h * 128 + d;
#pragma unroll
      for (int r = 0; r < 16; ++r) aup[r] = a_up[r * 512]; }
    const float ab = args.in[4][(size_t)l * 512 + h * 128 + d];
    const float scale = 0.08838834764831845f;
    f32x4 S[8];
    if (PASS_C) {
#pragma unroll
        for (int et = 0; et < 8; ++et) {
#pragma unroll
            for (int r = 0; r < 4; ++r) S[et][r] = KV[(size_t)(16 * w + 4 * lg + r) * 128 + 16 * et + lr];
            u32x2 pk; pk.x = cvt_pk_bf16(S[et][0], S[et][1]); pk.y = cvt_pk_bf16(S[et][2], S[et][3]);
            *(LAS u32x2*)(ST + (16 * et + lr) * P128 + 16 * w + 4 * lg) = pk;
        }
    } else {
#pragma unroll
        for (int et = 0; et < 8; ++et) S[et] = (f32x4){0.f, 0.f, 0.f, 0.f};
    }
    float dsum = 0.f;
    for (int c = 0; c < 4; ++c) {
        const size_t mrow = mbase + (size_t)c * 64;
        __syncthreads();
        if (tid < 256) *(LAS f32x4*)(GA + tid * 4) = *(const GAS f32x4*)(SMALL + (mrow + (tid >> 2)) * 32 + (tid & 3) * 4);
        __syncthreads();
        float cs[16]; float run = 0.f;
#pragma unroll
        for (int i = 0; i < 16; ++i) { const LAS f32x4* gp = (const LAS f32x4*)(GA + (tq * 16 + i) * 16); float z = ab;
#pragma unroll
            for (int r4 = 0; r4 < 4; ++r4) { const f32x4 g4 = gp[r4]; z += g4[0] * aup[4 * r4] + g4[1] * aup[4 * r4 + 1] + g4[2] * aup[4 * r4 + 2] + g4[3] * aup[4 * r4 + 3]; }
            const float la = (fminf(z, 0.f) - __logf(1.f + __expf(-fabsf(z)))) * (1.f / 16.f);
            run += la; cs[i] = run; }
        BC[tq * 128 + d] = run;
        __syncthreads();
        float off = 0.f, tot = 0.f;
#pragma unroll
        for (int q = 0; q < 4; ++q) { const float v = BC[q * 128 + d]; off += (q < tq) ? v : 0.f; tot += v; }
        if (tq == 0) { DEC[d] = __expf(tot); dsum += tot; }
        {
            const bf16_t* kp = GK + (mrow + tq * 16) * 512 + d; const bf16_t* qp = GQ + (mrow + tq * 16) * 512 + d; const bf16_t* vp = GV + (mrow + tq * 16) * 512 + d;
            unsigned ke[8], vv[8];
#pragma unroll
            for (int i2 = 0; i2 < 8; ++i2) {
                float kend[2]; unsigned vraw[2];
#pragma unroll
                for (int q2 = 0; q2 < 2; ++q2) { const int i = 2 * i2 + q2; const int j = tq * 16 + i;
                    const float kf = bf2f(kp[(size_t)i * 512]); const float bc = off + cs[i];
                    kend[q2] = kf * __expf(tot - bc); vraw[q2] = vp[(size_t)i * 512];
                    if (PASS_C) { const float qf = bf2f(qp[(size_t)i * 512]);
                        QD[j * P128 + d] = f2bf(qf * scale * __expf(bc)); KI[j * P128 + d] = f2bf(kf * __expf(-bc)); } }
                ke[i2] = cvt_pk_bf16(kend[0], kend[1]); vv[i2] = vraw[0] | (vraw[1] << 16);
            }
            LAS u32x4* kd = (LAS u32x4*)(KET + d * P64 + tq * 16); kd[0] = (u32x4){ke[0], ke[1], ke[2], ke[3]}; kd[1] = (u32x4){ke[4], ke[5], ke[6], ke[7]};
            LAS u32x4* vd = (LAS u32x4*)(VT + d * P64 + tq * 16); vd[0] = (u32x4){vv[0], vv[1], vv[2], vv[3]}; vd[1] = (u32x4){vv[4], vv[5], vv[6], vv[7]};
        }
        __syncthreads();
        if (PASS_C) {
            const int it = w >> 1, eh = w & 1;
            bf16x8 qb[4];
#pragma unroll
            for (int ks = 0; ks < 4; ++ks) qb[ks] = lds16(QD + (16 * it + lr) * P128 + 32 * ks + 8 * lg);
            f32x4 P[4];
#pragma unroll
            for (int jt = 0; jt < 4; ++jt) { P[jt] = (f32x4){0.f, 0.f, 0.f, 0.f};
                if (jt <= it) {
#pragma unroll
                    for (int ks = 0; ks < 4; ++ks) P[jt] = MFMA16(lds16(KI + (16 * jt + lr) * P128 + 32 * ks + 8 * lg), qb[ks], P[jt]);
                    if (jt == it) {
#pragma unroll
                        for (int r = 0; r < 4; ++r) if (4 * lg + r > lr) P[jt][r] = 0.f; }
                } }
            bf16x8 pb[2]; pb[0] = pack8(P[0], P[1]); pb[1] = pack8(P[2], P[3]);
            f32x4 o[4];
#pragma unroll
            for (int et = 0; et < 4; ++et) { o[et] = (f32x4){0.f, 0.f, 0.f, 0.f}; const int er = 64 * eh + 16 * et + lr;
#pragma unroll
                for (int s = 0; s < 2; ++s) o[et] = MFMA16(lds8x2(VT + er * P64 + 32 * s + 4 * lg, VT + er * P64 + 32 * s + 16 + 4 * lg), pb[s], o[et]);
#pragma unroll
                for (int ks = 0; ks < 4; ++ks) o[et] = MFMA16(lds16(ST + er * P128 + 32 * ks + 8 * lg), qb[ks], o[et]); }
            float ssq = 0.f;
#pragma unroll
            for (int et = 0; et < 4; ++et) ssq += (o[et][0] * o[et][0] + o[et][1] * o[et][1]) + (o[et][2] * o[et][2] + o[et][3] * o[et][3]);
            ssq += __shfl_xor(ssq, 16); ssq += __shfl_xor(ssq, 32);
            if (lg == 0) NRM[eh * 64 + 16 * it + lr] = ssq;
            __syncthreads();
            const float rstd = rsqrtf((NRM[16 * it + lr] + NRM[64 + 16 * it + lr]) * (1.f / 128.f) + EPS_);
            const float* gn = args.in[5] + (size_t)l * 128;
#pragma unroll
            for (int et = 0; et < 4; ++et) { const int e0 = 64 * eh + 16 * et + 4 * lg; bf16_t* gp = GG + (mrow + 16 * it + lr) * 512 + e0;
                const u32x2 graw = *(const GAS u32x2*)gp; const f32x4 gnv = *(const GAS f32x4*)(gn + e0);
                const float g0 = bf_lo(graw.x), g1 = bf_hi(graw.x), g2 = bf_lo(graw.y), g3 = bf_hi(graw.y);
                const float y0 = o[et][0] * rstd * gnv[0] * (g0 * fast_sigmoid(g0)), y1 = o[et][1] * rstd * gnv[1] * (g1 * fast_sigmoid(g1));
                const float y2 = o[et][2] * rstd * gnv[2] * (g2 * fast_sigmoid(g2)), y3 = o[et][3] * rstd * gnv[3] * (g3 * fast_sigmoid(g3));
                u32x2 yo; yo.x = cvt_pk_bf16(y0, y1); yo.y = cvt_pk_bf16(y2, y3); *(GAS u32x2*)gp = yo; }
        }
        {
            f32x4 dv4;
#pragma unroll
            for (int r = 0; r < 4; ++r) dv4[r] = DEC[16 * w + 4 * lg + r];
#pragma unroll
            for (int et = 0; et < 8; ++et) S[et] = S[et] * dv4;
#pragma unroll
            for (int s = 0; s < 2; ++s) { const bf16x8 a = lds16(KET + (16 * w + lr) * P64 + 32 * s + 8 * lg);
#pragma unroll
                for (int et = 0; et < 8; ++et) S[et] = MFMA16(a, lds16(VT + (16 * et + lr) * P64 + 32 * s + 8 * lg), S[et]); }
            if (PASS_C) {
#pragma unroll
                for (int et = 0; et < 8; ++et) { u32x2 pk; pk.x = cvt_pk_bf16(S[et][0], S[et][1]); pk.y = cvt_pk_bf16(S[et][2], S[et][3]);
                    *(LAS u32x2*)(ST + (16 * et + lr) * P128 + 16 * w + 4 * lg) = pk; }
            }
        }
    }
    if (!PASS_C) {
#pragma unroll
        for (int et = 0; et < 8; ++et)
#pragma unroll
            for (int r = 0; r < 4; ++r) KV[(size_t)(16 * w + 4 * lg + r) * 128 + 16 * et + lr] = S[et][r];
        if (tq == 0) DT[d] = __expf(dsum);
    }
    __syncthreads();
}
__device__ __forceinline__ void gla_scan(const Args& args, int gtid, int gthreads) {
    float* KV = (float*)(args.ws + WS_SCR + SCR_GLA_KV); const float* DT = (const float*)(args.ws + WS_MISC + MISC_GLA_DT);
    for (int idx = gtid; idx < 8 * 16384; idx += gthreads) {
        const int bh = idx >> 14, de = idx & 16383, dd = de >> 7;
        float kv[32], dt[32];
#pragma unroll
        for (int s = 0; s < 32; ++s) { kv[s] = KV[(size_t)(bh * 32 + s) * 16384 + de]; dt[s] = DT[(bh * 32 + s) * 128 + dd]; }
        float st = 0.f;
#pragma unroll
        for (int s = 0; s < 32; ++s) { KV[(size_t)(bh * 32 + s) * 16384 + de] = st; st = dt[s] * st + kv[s]; }
    }
}
}
namespace mk {
constexpr size_t SCR_ML_KV = 52 * MiB;
constexpr size_t MISC_ML_MS = 512 * 1024;
constexpr int ML_QW = 0, ML_QR = 9216, ML_KS = 18432, ML_KWT = 27648, ML_VT = 36864, ML_ST = 57600, ML_SC = 78336, ML_NRM = 79872, ML_END = 80384;

__device__ __forceinline__ float wave_incl_sum(float x, int lane) {
#pragma unroll
    for (int o = 1; o < 64; o <<= 1) { const float v = __shfl_up(x, o); if (lane >= o) x += v; }
    return x;
}
__device__ __forceinline__ float wave_incl_max(float x, int lane) {
#pragma unroll
    for (int o = 1; o < 64; o <<= 1) { const float v = __shfl_up(x, o); if (lane >= o) x = fmaxf(x, v); }
    return x;
}

template <bool PASS_C>
__device__ __forceinline__ void ml_unit(LAS unsigned char* lds, const Args& args, int l, int u) {
    int tid_ = threadIdx.x; asm volatile("" : "+v"(tid_));
    const int tid = tid_, lane = tid & 63, w = __builtin_amdgcn_readfirstlane(tid >> 6), lr = lane & 15, lg = lane >> 4;
    const int bh = u >> 5, sc = u & 31, b = bh >> 2, h = bh & 3;
    const int t0 = sc * 256;
    const size_t mbase = (size_t)b * T_ + (size_t)t0;
    unsigned char* ws = args.ws; asm volatile("" : "+s"(ws));
    const bf16_t* LQ = (const bf16_t*)(ws + WS_SEG + SEG_LQ) + h * 64; const bf16_t* LK = (const bf16_t*)(ws + WS_SEG + SEG_LK) + h * 64;
    const bf16_t* LV = (const bf16_t*)(ws + WS_SEG + SEG_LV) + h * 128; bf16_t* LO = (bf16_t*)(ws + WS_SEG + SEG_LO) + h * 128;
    const float* SMALL = (const float*)(ws + WS_SMALL);
    float* KVM = (float*)(ws + WS_SCR + SCR_ML_KV) + (size_t)u * (64 * 144); float* MS = (float*)(ws + WS_MISC + MISC_ML_MS) + (size_t)u * 4;
    LAS bf16_t* QW = (LAS bf16_t*)(lds + ML_QW); LAS bf16_t* QR = (LAS bf16_t*)(lds + ML_QR); LAS bf16_t* KS = (LAS bf16_t*)(lds + ML_KS);
    LAS bf16_t* KWT = (LAS bf16_t*)(lds + ML_KWT); LAS bf16_t* VT = (LAS bf16_t*)(lds + ML_VT); LAS bf16_t* ST = (LAS bf16_t*)(lds + ML_ST);
    LAS float* SU = (LAS float*)(lds + ML_SC);
    LAS float* NRM = (LAS float*)(lds + ML_NRM);
    const int ch = tid & 127, tq = tid >> 7;
    float cw[4];
    { const int cidx = (ch < 64) ? (h * 64 + ch) : (256 + h * 64 + (ch - 64)); const float* cwp = args.in[8] + (size_t)l * 4 * 512 + cidx;
#pragma unroll
      for (int j = 0; j < 4; ++j) cw[j] = cwp[j * 512]; }
    const float ib = args.in[9][l * 4 + h], fb = args.in[10][l * 4 + h];
    const int dt = w & 3, eb = (w >> 2) * 4;
    f32x4 S[5];
    float m_prev;
    if (PASS_C) {
        m_prev = MS[2];
#pragma unroll
        for (int k = 0; k < 5; ++k) { const int et = (k < 4) ? (eb + k) : 8;
            if (k < 4 || w < 4) {
#pragma unroll
                for (int r = 0; r < 4; ++r) S[k][r] = KVM[(size_t)(16 * dt + 4 * lg + r) * 144 + 16 * et + lr];
                u32x2 pk; pk.x = cvt_pk_bf16(S[k][0], S[k][1]); pk.y = cvt_pk_bf16(S[k][2], S[k][3]);
                *(LAS u32x2*)(ST + (16 * et + lr) * P64 + 16 * dt + 4 * lg) = pk;
            } else S[k] = (f32x4){0.f, 0.f, 0.f, 0.f}; }
    } else {
        m_prev = -1e30f;
#pragma unroll
        for (int k = 0; k < 5; ++k) S[k] = (f32x4){0.f, 0.f, 0.f, 0.f};
    }
    for (int i = tid; i < 16 * P64; i += NTHREADS) VT[128 * P64 + i] = (i < 64) ? (bf16_t)0x3f80 : (bf16_t)0;
    float bsum = 0.f;
    for (int c = 0; c < 4; ++c) {
        const size_t mrow = mbase + (size_t)c * 64;
        const float lf = ({ const float z = SMALL[(mrow + lane) * 32 + 20 + h] + fb; fminf(z, 0.f) - __logf(1.f + __expf(-fabsf(z))); });
        const float li = SMALL[(mrow + lane) * 32 + 16 + h] + ib;
        const float bcum = wave_incl_sum(lf, lane);
        const float uj = li - bcum;
        const float pmax = wave_incl_max(uj, lane);
        const float b_last = __shfl(bcum, 63), pm63 = __shfl(pmax, 63);
        const float gi = fmaxf(m_prev, pmax);
        const float m_new = fmaxf(b_last + m_prev, b_last + pm63);
        const float a_scale = __expf(b_last + m_prev - m_new);
        __syncthreads();
        if (w == 0) { SU[lane] = uj; SU[64 + lane] = gi; SU[128 + lane] = __expf(m_prev - gi); SU[192 + lane] = __expf(-(bcum + gi)); SU[256 + lane] = __expf(b_last + uj - m_new); }
        __syncthreads();
        {
            const bf16_t* src = (ch < 64) ? (LQ + ch) : (LK + (ch - 64));
            float xv[19];
#pragma unroll
            for (int i = 0; i < 19; ++i) { const int tt = c * 64 + tq * 16 - 3 + i;
                xv[i] = (t0 + tt >= 0) ? bf2f(src[(ptrdiff_t)(mbase + tt) * 256]) : 0.f; }
            unsigned kw[8];
#pragma unroll
            for (int i2 = 0; i2 < 8; ++i2) { float kwv[2];
#pragma unroll
                for (int q2 = 0; q2 < 2; ++q2) { const int i = 2 * i2 + q2, j = tq * 16 + i;
                    const float cv = cw[0] * xv[i] + cw[1] * xv[i + 1] + cw[2] * xv[i + 2] + cw[3] * xv[i + 3];
                    if (ch < 64) { if (PASS_C) { QR[j * P64 + ch] = f2bf(cv); QW[j * P64 + ch] = f2bf(cv * SU[128 + j]); } kwv[q2] = 0.f; }
                    else { const float kv = cv * 0.125f; if (PASS_C) KS[j * P64 + (ch - 64)] = f2bf(kv); kwv[q2] = kv * SU[256 + j]; } }
                kw[i2] = cvt_pk_bf16(kwv[0], kwv[1]); }
            if (ch >= 64) { LAS u32x4* kd = (LAS u32x4*)(KWT + (ch - 64) * P64 + tq * 16); kd[0] = (u32x4){kw[0], kw[1], kw[2], kw[3]}; kd[1] = (u32x4){kw[4], kw[5], kw[6], kw[7]}; }
            const bf16_t* vp = LV + (mrow + tq * 16) * 512 + ch; unsigned vv[8];
#pragma unroll
            for (int i2 = 0; i2 < 8; ++i2) vv[i2] = (unsigned)vp[(size_t)(2 * i2) * 512] | ((unsigned)vp[(size_t)(2 * i2 + 1) * 512] << 16);
            LAS u32x4* vd = (LAS u32x4*)(VT + ch * P64 + tq * 16); vd[0] = (u32x4){vv[0], vv[1], vv[2], vv[3]}; vd[1] = (u32x4){vv[4], vv[5], vv[6], vv[7]};
        }
        __syncthreads();
        if (PASS_C) {
            const int it = w >> 1, eh = w & 1;
            bf16x8 qr[2], qw[2];
#pragma unroll
            for (int ks = 0; ks < 2; ++ks) { qr[ks] = lds16(QR + (16 * it + lr) * P64 + 32 * ks + 8 * lg); qw[ks] = lds16(QW + (16 * it + lr) * P64 + 32 * ks + 8 * lg); }
            const float g_i = SU[64 + 16 * it + lr];
            f32x4 P[4];
#pragma unroll
            for (int jt = 0; jt < 4; ++jt) { P[jt] = (f32x4){0.f, 0.f, 0.f, 0.f};
                if (jt <= it) {
#pragma unroll
                    for (int ks = 0; ks < 2; ++ks) P[jt] = MFMA16(lds16(KS + (16 * jt + lr) * P64 + 32 * ks + 8 * lg), qr[ks], P[jt]);
                    const f32x4 u4 = *(const LAS f32x4*)(SU + 16 * jt + 4 * lg);
#pragma unroll
                    for (int r = 0; r < 4; ++r) { const float f = __expf(u4[r] - g_i); P[jt][r] = (jt == it && 4 * lg + r > lr) ? 0.f : P[jt][r] * f; }
                } }
            bf16x8 pb[2]; pb[0] = pack8(P[0], P[1]); pb[1] = pack8(P[2], P[3]);
            f32x4 o[5];
#pragma unroll
            for (int k = 0; k < 5; ++k) { o[k] = (f32x4){0.f, 0.f, 0.f, 0.f}; const int er = (k < 4 ? 64 * eh + 16 * k : 128) + lr;
#pragma unroll
                for (int s = 0; s < 2; ++s) o[k] = MFMA16(lds8x2(VT + er * P64 + 32 * s + 4 * lg, VT + er * P64 + 32 * s + 16 + 4 * lg), pb[s], o[k]);
#pragma unroll
                for (int ks = 0; ks < 2; ++ks) o[k] = MFMA16(lds16(ST + er * P64 + 32 * ks + 8 * lg), qw[ks], o[k]); }
            const float den = __shfl(o[4][0], lr);
            const float rden = 1.f / fmaxf(fabsf(den), SU[192 + 16 * it + lr]);
            float ssq = 0.f;
#pragma unroll
            for (int k = 0; k < 4; ++k) { o[k] = o[k] * rden; ssq += (o[k][0] * o[k][0] + o[k][1] * o[k][1]) + (o[k][2] * o[k][2] + o[k][3] * o[k][3]); }
            ssq += __shfl_xor(ssq, 16); ssq += __shfl_xor(ssq, 32);
            if (lg == 0) NRM[eh * 64 + 16 * it + lr] = ssq;
            __syncthreads();
            const float rstd = rsqrtf((NRM[16 * it + lr] + NRM[64 + 16 * it + lr]) * (1.f / 128.f) + EPS_);
            const float* gn = args.in[11] + (size_t)l * 128;
#pragma unroll
            for (int k = 0; k < 4; ++k) { const int e0 = 64 * eh + 16 * k + 4 * lg; bf16_t* gp = LO + (mrow + 16 * it + lr) * 512 + e0;
                const u32x2 graw = *(const GAS u32x2*)gp; const f32x4 gnv = *(const GAS f32x4*)(gn + e0);
                const float y0 = o[k][0] * rstd * gnv[0] * fast_sigmoid(bf_lo(graw.x)), y1 = o[k][1] * rstd * gnv[1] * fast_sigmoid(bf_hi(graw.x));
                const float y2 = o[k][2] * rstd * gnv[2] * fast_sigmoid(bf_lo(graw.y)), y3 = o[k][3] * rstd * gnv[3] * fast_sigmoid(bf_hi(graw.y));
                u32x2 yo; yo.x = cvt_pk_bf16(y0, y1); yo.y = cvt_pk_bf16(y2, y3); *(GAS u32x2*)gp = yo; }
        }
        {
#pragma unroll
            for (int k = 0; k < 5; ++k) S[k] = S[k] * a_scale;
#pragma unroll
            for (int s = 0; s < 2; ++s) { const bf16x8 a = lds16(KWT + (16 * dt + lr) * P64 + 32 * s + 8 * lg);
#pragma unroll
                for (int k = 0; k < 5; ++k) { const int et = (k < 4) ? (eb + k) : 8; if (k < 4 || w < 4) S[k] = MFMA16(a, lds16(VT + (16 * et + lr) * P64 + 32 * s + 8 * lg), S[k]); } }
            if (PASS_C) {
#pragma unroll
                for (int k = 0; k < 5; ++k) { const int et = (k < 4) ? (eb + k) : 8;
                    if (k < 4 || w < 4) { u32x2 pk; pk.x = cvt_pk_bf16(S[k][0], S[k][1]); pk.y = cvt_pk_bf16(S[k][2], S[k][3]);
                        *(LAS u32x2*)(ST + (16 * et + lr) * P64 + 16 * dt + 4 * lg) = pk; } }
            }
        }
        m_prev = m_new; bsum += b_last;
    }
    if (!PASS_C) {
#pragma unroll
        for (int k = 0; k < 5; ++k) { const int et = (k < 4) ? (eb + k) : 8;
            if (k < 4 || w < 4) {
#pragma unroll
                for (int r = 0; r < 4; ++r) KVM[(size_t)(16 * dt + 4 * lg + r) * 144 + 16 * et + lr] = S[k][r]; } }
        if (tid == 0) { MS[0] = m_prev; MS[1] = bsum; }
    }
    __syncthreads();
}
__device__ __forceinline__ void ml_scan(const Args& args, int gtid, int gthreads) {
    float* KVM = (float*)(args.ws + WS_SCR + SCR_ML_KV); float* MS = (float*)(args.ws + WS_MISC + MISC_ML_MS);
    for (int idx = gtid; idx < 8 * 9216; idx += gthreads) {
        const int bh = idx / 9216, de = idx % 9216;
        float kv[32], ml[32], Bv[32];
#pragma unroll
        for (int s = 0; s < 32; ++s) { const int u = bh * 32 + s; kv[s] = KVM[(size_t)u * 9216 + de]; ml[s] = MS[u * 4 + 0]; Bv[s] = MS[u * 4 + 1]; }
        float st = 0.f, m = 0.f;
#pragma unroll
        for (int s = 0; s < 32; ++s) { const int u = bh * 32 + s;
            KVM[(size_t)u * 9216 + de] = st; if (de == 0) MS[u * 4 + 2] = m;
            const float mn = fmaxf(Bv[s] + m, ml[s]);
            st = __expf(Bv[s] + m - mn) * st + __expf(ml[s] - mn) * kv[s]; m = mn; }
    }
}
}
namespace mk {
constexpr size_t WS_PO = WS_ACT;
constexpr size_t WS_PML = WS_ACT + 64 * MiB;
constexpr size_t CTL_KMP = 512 * 1024;
constexpr size_t MISC_PAIRS = 1 * MiB;
constexpr size_t MISC_CELL = 1 * MiB + 800 * 1024;
constexpr int CW_MBQ = 1024;
static_assert(WS_PML + 4 * MiB <= WS_SCR + SCR_GLA_KV, "MoBA partials end below the GLA state buffer");
constexpr int MB_NUNITS = 16 * 52;
constexpr int MC_K = 0, MC_KP = 72, MC_VT = 36864, MC_VP = 264, MC_QL = 36864 + 33792, MC_CTL = MC_QL + 32768, MC_END = MC_CTL + 512;

__device__ __forceinline__ void mb_prep_unit(LAS unsigned char* lds, const Args& args, int l, int u) {
    int tid_ = threadIdx.x; asm volatile("" : "+v"(tid_));
    const int tid = tid_, lane = tid & 63, w = __builtin_amdgcn_readfirstlane(tid >> 6);
    const int b = u >> 7, blk = (u >> 2) & 31, qr = u & 3;
    unsigned char* ws = args.ws; asm volatile("" : "+s"(ws));
    bf16_t* MQ = (bf16_t*)(ws + WS_SEG + SEG_MQ); bf16_t* MK = (bf16_t*)(ws + WS_SEG + SEG_MK);
    const float* COS = (const float*)(ws + WS_ROPE); const float* SIN = COS + 8192 * 32;
    float* KMP = (float*)(ws + WS_CTL + CTL_KMP);
    LAS float* RED = (LAS float*)lds;
    const int d0 = (lane & 7) * 8;
    float gq[8], gk[8], ks[8];
#pragma unroll
    for (int k = 0; k < 8; ++k) { gq[k] = args.in[6][l * 64 + d0 + k]; gk[k] = args.in[7][l * 64 + d0 + k]; ks[k] = 0.f; }
    const bool lo = (lane & 4) == 0;
    for (int i = 0; i < 8; ++i) {
        const int t = blk * 256 + qr * 64 + w * 8 + i; const size_t m = (size_t)b * T_ + t;
        const f32x4 c0 = *(const GAS f32x4*)(COS + t * 32 + (d0 & 31)), c1 = *(const GAS f32x4*)(COS + t * 32 + (d0 & 31) + 4);
        const f32x4 s0 = *(const GAS f32x4*)(SIN + t * 32 + (d0 & 31)), s1 = *(const GAS f32x4*)(SIN + t * 32 + (d0 & 31) + 4);
        const float cs[8] = {c0[0], c0[1], c0[2], c0[3], c1[0], c1[1], c1[2], c1[3]}, sn[8] = {s0[0], s0[1], s0[2], s0[3], s1[0], s1[1], s1[2], s1[3]};
#pragma unroll
        for (int which = 0; which < 2; ++which) {
            bf16_t* p = (which ? MK : MQ) + m * 512 + 8 * lane;
            const u32x4 raw = *(const GAS u32x4*)p;
            float x[8] = {bf_lo(raw.x), bf_hi(raw.x), bf_lo(raw.y), bf_hi(raw.y), bf_lo(raw.z), bf_hi(raw.z), bf_lo(raw.w), bf_hi(raw.w)};
            float ss = 0.f;
#pragma unroll
            for (int k = 0; k < 8; ++k) ss += x[k] * x[k];
            ss += __shfl_xor(ss, 1); ss += __shfl_xor(ss, 2); ss += __shfl_xor(ss, 4);
            const float r = rsqrtf(ss * (1.f / 64.f) + EPS_);
            float y[8];
#pragma unroll
            for (int k = 0; k < 8; ++k) { const float v = x[k] * r * (which ? gk[k] : gq[k]); const float other = __shfl_xor(v, 4);
                y[k] = lo ? (v * cs[k] - other * sn[k]) : (v * cs[k] + other * sn[k]); }
            u32x4 o; o.x = cvt_pk_bf16(y[0], y[1]); o.y = cvt_pk_bf16(y[2], y[3]); o.z = cvt_pk_bf16(y[4], y[5]); o.w = cvt_pk_bf16(y[6], y[7]);
            *(GAS u32x4*)p = o;
            if (which) {
#pragma unroll
                for (int k = 0; k < 8; ++k) ks[k] += y[k]; }
        }
    }
    __syncthreads();
#pragma unroll
    for (int k = 0; k < 8; ++k) RED[w * 512 + 8 * lane + k] = ks[k];
    __syncthreads();
    { float s = 0.f;
#pragma unroll
      for (int ww = 0; ww < 8; ++ww) s += RED[ww * 512 + tid];
      KMP[((size_t)(b * 32 + blk) * 4 + qr) * 512 + tid] = s; }
    __syncthreads();
}

__device__ __forceinline__ void mb_topk_unit(LAS unsigned char* lds, const Args& args, int u) {
    int tid_ = threadIdx.x; asm volatile("" : "+v"(tid_));
    const int tid = tid_, lane = tid & 63;
    const int b = u >> 7, i = (u >> 2) & 31, hp = u & 3;
    const int hh = tid >> 8, head = 2 * hp + hh, tq = tid & 255, w4 = (tid >> 6) & 3;
    unsigned char* ws = args.ws; asm volatile("" : "+s"(ws));
    const bf16_t* QN = (const bf16_t*)(ws + WS_SEG + SEG_MQ);
    const float* KMP = (const float*)(ws + WS_CTL + CTL_KMP);
    bf16_t* PAIRS = (bf16_t*)(ws + WS_MISC + MISC_PAIRS) + ((size_t)(b * 8 + head) * 32 + i) * 768;
    bf16_t* CELL = (bf16_t*)(ws + WS_MISC + MISC_CELL) + ((size_t)(b * 8 + head) * 32 + i) * 34;
    LAS float* KMS = (LAS float*)lds;
    LAS unsigned* CNT = (LAS unsigned*)(lds + 16384);
    LAS unsigned* CO = (LAS unsigned*)(lds + 16384 + 1024);
    __syncthreads();
#pragma unroll
    for (int k = 0; k < 8; ++k) { const int e = tid + 512 * k, hx = e >> 11, jj = (e >> 6) & 31, dd = e & 63;
        const float* kp = KMP + (size_t)(b * 32 + jj) * 2048 + (2 * hp + hx) * 64 + dd;
        KMS[e] = ((kp[0] + kp[512]) + (kp[1024] + kp[1536])) * (1.f / 256.f); }
    if (tid < 256) CNT[tid] = 0u;
    float q[64];
    { const bf16_t* qp = QN + ((size_t)b * T_ + i * 256 + tq) * 512 + head * 64;
#pragma unroll
      for (int c = 0; c < 8; ++c) { const u32x4 raw = *(const GAS u32x4*)(qp + 8 * c);
          q[8 * c] = bf_lo(raw.x); q[8 * c + 1] = bf_hi(raw.x); q[8 * c + 2] = bf_lo(raw.y); q[8 * c + 3] = bf_hi(raw.y);
          q[8 * c + 4] = bf_lo(raw.z); q[8 * c + 5] = bf_hi(raw.z); q[8 * c + 6] = bf_lo(raw.w); q[8 * c + 7] = bf_hi(raw.w); } }
    __syncthreads();
    float v0 = -INFINITY, v1 = -INFINITY, v2 = -INFINITY; int j0 = -1, j1 = -1, j2 = -1;
    for (int j = 0; j < i; ++j) {
        const LAS f32x4* kp = (const LAS f32x4*)(KMS + (hh * 32 + j) * 64); float s = 0.f;
#pragma unroll
        for (int c = 0; c < 16; ++c) { const f32x4 k4 = kp[c]; s += q[4 * c] * k4[0] + q[4 * c + 1] * k4[1] + q[4 * c + 2] * k4[2] + q[4 * c + 3] * k4[3]; }
        if (s > v2) { if (s > v1) { v2 = v1; j2 = j1; if (s > v0) { v1 = v0; j1 = j0; v0 = s; j0 = j; } else { v1 = s; j1 = j; } } else { v2 = s; j2 = j; } }
    }
    int rk0 = 0, rk1 = 0, rk2 = 0;
    for (int j = 0; j < i; ++j) {
        const bool pr = (j0 == j) || (j1 == j) || (j2 == j);
        const unsigned long long mask = __ballot(pr);
        const int rank = __popcll(mask & ((1ull << lane) - 1ull));
        if (j0 == j) rk0 = rank; if (j1 == j) rk1 = rank; if (j2 == j) rk2 = rank;
        if (lane == 0) CNT[(hh * 4 + w4) * 32 + j] = (unsigned)__popcll(mask);
    }
    __syncthreads();
    if (tid < 2) { unsigned run = 0u;
        for (int j = 0; j < 32; ++j) { CO[tid * 34 + j] = run; run += CNT[(tid * 4 + 0) * 32 + j] + CNT[(tid * 4 + 1) * 32 + j] + CNT[(tid * 4 + 2) * 32 + j] + CNT[(tid * 4 + 3) * 32 + j]; }
        CO[tid * 34 + 32] = run; }
    __syncthreads();
#define MB_EMIT(jj, rk, slot) do { if ((jj) >= 0) { unsigned pos = CO[hh * 34 + (jj)] + (rk); \
        for (int ww = 0; ww < 4; ++ww) pos += (ww < w4) ? CNT[(hh * 4 + ww) * 32 + (jj)] : 0u; \
        PAIRS[pos] = (bf16_t)(tq | ((slot) << 8)); } } while (0)
    MB_EMIT(j0, rk0, 0); MB_EMIT(j1, rk1, 1); MB_EMIT(j2, rk2, 2);
#undef MB_EMIT
    if (tq < 33) CELL[tq] = (bf16_t)CO[hh * 34 + tq];
    __syncthreads();
}

__device__ __forceinline__ void mb_attn_unit(LAS unsigned char* lds, const Args& args, int q) {
    int tid_ = threadIdx.x; asm volatile("" : "+v"(tid_));
    const int tid = tid_, lane = tid & 63, w = __builtin_amdgcn_readfirstlane(tid >> 6), lr = lane & 15, lg = lane >> 4;
    const int bh = q & 15, rr = q >> 4, b = bh >> 3, h = bh & 7;
    int j, part, np;
    if (rr < 16) { j = rr >> 2; part = rr & 3; np = 4; } else if (rr < 32) { j = 4 + ((rr - 16) >> 1); part = (rr - 16) & 1; np = 2; } else { j = 12 + (rr - 32); part = 0; np = 1; }
    unsigned char* ws = args.ws; asm volatile("" : "+s"(ws));
    const bf16_t* QN = (const bf16_t*)(ws + WS_SEG + SEG_MQ) + h * 64; const bf16_t* KN = (const bf16_t*)(ws + WS_SEG + SEG_MK) + h * 64; const bf16_t* MV = (const bf16_t*)(ws + WS_SEG + SEG_MV) + h * 64;
    const bf16_t* PAIRS = (const bf16_t*)(ws + WS_MISC + MISC_PAIRS) + (size_t)bh * 32 * 768; const bf16_t* CELL = (const bf16_t*)(ws + WS_MISC + MISC_CELL) + (size_t)bh * 32 * 34;
    bf16_t* PO = (bf16_t*)(ws + WS_PO); float* PML = (float*)(ws + WS_PML);
    LAS bf16_t* KJ = (LAS bf16_t*)(lds + MC_K); LAS bf16_t* VT = (LAS bf16_t*)(lds + MC_VT); LAS unsigned* QL = (LAS unsigned*)(lds + MC_QL); LAS unsigned* CT = (LAS unsigned*)(lds + MC_CTL);
    const size_t krow0 = (size_t)b * T_ + (size_t)j * 256;
    __syncthreads();
#pragma unroll
    for (int k = 0; k < 4; ++k) { const int id = tid + 512 * k, row = id >> 3, c8 = id & 7;
        *(LAS u32x4*)(KJ + row * MC_KP + 8 * c8) = *(const GAS u32x4*)(KN + (krow0 + row) * 512 + 8 * c8);
        const u32x4 vr = *(const GAS u32x4*)(MV + (krow0 + row) * 512 + 8 * c8);
        LAS bf16_t* vt = VT + (8 * c8) * MC_VP + row;
        vt[0 * MC_VP] = (bf16_t)(vr.x & 0xffffu); vt[1 * MC_VP] = (bf16_t)(vr.x >> 16); vt[2 * MC_VP] = (bf16_t)(vr.y & 0xffffu); vt[3 * MC_VP] = (bf16_t)(vr.y >> 16);
        vt[4 * MC_VP] = (bf16_t)(vr.z & 0xffffu); vt[5 * MC_VP] = (bf16_t)(vr.z >> 16); vt[6 * MC_VP] = (bf16_t)(vr.w & 0xffffu); vt[7 * MC_VP] = (bf16_t)(vr.w >> 16); }
    if (tid < 256) QL[tid] = (unsigned)(j * 256 + tid) | (3u << 13);
    if (tid < 64) { const int i = tid & 31; unsigned c0 = 0u, cnt = 0u;
        if (i > j) { c0 = CELL[i * 34 + j]; cnt = (unsigned)CELL[i * 34 + j + 1] - c0; }
        unsigned inc = cnt;
#pragma unroll
        for (int o = 1; o < 32; o <<= 1) { const unsigned v = __shfl_up(inc, o); if ((tid & 31) >= o) inc += v; }
        if (tid < 32) { CT[i] = 256u + inc - cnt; CT[33 + i] = c0; CT[66 + i] = cnt; if (i == 31) CT[32] = 256u + inc; } }
    __syncthreads();
    for (int i = j + 1 + w; i < 32; i += 8) { const unsigned c0 = CT[33 + i], cnt = CT[66 + i], dst = CT[i];
        for (unsigned e = lane; e < cnt; e += 64) { const unsigned pr = PAIRS[(size_t)i * 768 + c0 + e]; QL[dst + e] = (unsigned)(i * 256 + (pr & 255u)) | ((pr >> 8) << 13); } }
    __syncthreads();
    const int n = (int)CT[32], nitems = (n + 15) >> 4;
    unsigned ent_n = 0u; bf16x8 qn0 = {0, 0, 0, 0, 0, 0, 0, 0}, qn1 = {0, 0, 0, 0, 0, 0, 0, 0}; bool valid_n = false;
    { const int item0 = part + np * w; if (item0 < nitems) { const int e0 = item0 * 16 + lr; valid_n = e0 < n; ent_n = QL[valid_n ? e0 : 0];
        const bf16_t* qp = QN + ((size_t)b * T_ + (ent_n & 8191u)) * 512 + 8 * lg; qn0 = *(const GAS bf16x8*)qp; qn1 = *(const GAS bf16x8*)(qp + 32); } }
    for (int item = part + np * w; item < nitems; item += np * 8) {
        const bool valid = valid_n; const unsigned ent = ent_n;
        const int tok = (int)(ent & 8191u), slot = (int)((ent >> 13) & 3u); const bool own = slot == 3; const int qpos = tok & 255;
        const size_t m = (size_t)b * T_ + tok;
        bf16x8 qb[2]; qb[0] = qn0; qb[1] = qn1;
        { const int itn = item + np * 8; if (itn < nitems) { const int e1 = itn * 16 + lr; valid_n = e1 < n; ent_n = QL[valid_n ? e1 : 0];
            const bf16_t* qp = QN + ((size_t)b * T_ + (ent_n & 8191u)) * 512 + 8 * lg; qn0 = *(const GAS bf16x8*)qp; qn1 = *(const GAS bf16x8*)(qp + 32); } }
        f32x4 sc[16];
#pragma unroll
        for (int kt = 0; kt < 16; ++kt) { sc[kt] = (f32x4){0.f, 0.f, 0.f, 0.f};
#pragma unroll
            for (int ks = 0; ks < 2; ++ks) sc[kt] = MFMA16(lds16(KJ + (16 * kt + lr) * MC_KP + 32 * ks + 8 * lg), qb[ks], sc[kt]); }
        if (own) {
#pragma unroll
            for (int kt = 0; kt < 16; ++kt)
#pragma unroll
                for (int r = 0; r < 4; ++r) if ((16 * kt + 4 * lg + r) > qpos) sc[kt][r] = -1e30f; }
        float mx = -1e30f;
#pragma unroll
        for (int kt = 0; kt < 16; ++kt) mx = fmaxf(fmaxf(mx, fmaxf(sc[kt][0], sc[kt][1])), fmaxf(sc[kt][2], sc[kt][3]));
        mx = fmaxf(mx, __shfl_xor(mx, 16)); mx = fmaxf(mx, __shfl_xor(mx, 32));
        const float cexp = 0.18033688011112042f, mneg = -mx * cexp;
        float lsum = 0.f;
#pragma unroll
        for (int kt = 0; kt < 16; ++kt)
#pragma unroll
            for (int r = 0; r < 4; ++r) { const float p = __builtin_amdgcn_exp2f(fmaf(sc[kt][r], cexp, mneg)); sc[kt][r] = p; lsum += p; }
        lsum += __shfl_xor(lsum, 16); lsum += __shfl_xor(lsum, 32);
        mx *= 0.125f;
        f32x4 o[4];
#pragma unroll
        for (int dv = 0; dv < 4; ++dv) o[dv] = (f32x4){0.f, 0.f, 0.f, 0.f};
#pragma unroll
        for (int s2 = 0; s2 < 8; ++s2) { const bf16x8 pb = pack8(sc[2 * s2], sc[2 * s2 + 1]);
#pragma unroll
            for (int dv = 0; dv < 4; ++dv) { const LAS bf16_t* vp = VT + (16 * dv + lr) * MC_VP + 32 * s2 + 4 * lg; o[dv] = MFMA16(lds8x2(vp, vp + 16), pb, o[dv]); } }
        const float inv = 1.f / lsum;
        if (valid) { const size_t pbase = ((m * 8 + h) * 4 + slot);
#pragma unroll
            for (int dv = 0; dv < 4; ++dv) { u32x2 pk; pk.x = cvt_pk_bf16(o[dv][0] * inv, o[dv][1] * inv); pk.y = cvt_pk_bf16(o[dv][2] * inv, o[dv][3] * inv);
                *(GAS u32x2*)(PO + pbase * 64 + 16 * dv + 4 * lg) = pk; }
            if (lg == 0) { f32x2 ml; ml.x = mx; ml.y = lsum; *(GAS f32x2*)(PML + pbase * 2) = ml; } }
    }
    __syncthreads();
}

__device__ __forceinline__ void mb_combine(const Args& args, int gtid, int gthreads) {
    unsigned char* ws = args.ws; asm volatile("" : "+s"(ws));
    const bf16_t* PO = (const bf16_t*)(ws + WS_PO); const float* PML = (const float*)(ws + WS_PML); bf16_t* Y = (bf16_t*)(ws + WS_SEG + SEG_MQ);
    for (int idx = gtid; idx < M_ * 8 * 8; idx += gthreads) {
        const int mh = idx >> 3, c8 = idx & 7, m = mh >> 3, h = mh & 7, t = m & (T_ - 1), ib = t >> 8; const int nv = ib < 3 ? ib : 3;
        const size_t base = (size_t)mh * 4;
        float ms[4], ls[4];
#pragma unroll
        for (int s = 0; s < 4; ++s) { const bool on = (s == 3) || (s < nv); const f32x2 ml = on ? *(const GAS f32x2*)(PML + (base + s) * 2) : (f32x2){-1e30f, 0.f}; ms[s] = ml.x; ls[s] = ml.y; }
        const float Mx = fmaxf(fmaxf(ms[0], ms[1]), fmaxf(ms[2], ms[3]));
        float acc[8] = {0.f, 0.f, 0.f, 0.f, 0.f, 0.f, 0.f, 0.f}; float W = 0.f;
#pragma unroll
        for (int s = 0; s < 4; ++s) { const bool on = (s == 3) || (s < nv);
            if (on) { const float wgt = ls[s] * __expf(ms[s] - Mx); W += wgt; const u32x4 raw = *(const GAS u32x4*)(PO + (base + s) * 64 + 8 * c8);
                acc[0] += wgt * bf_lo(raw.x); acc[1] += wgt * bf_hi(raw.x); acc[2] += wgt * bf_lo(raw.y); acc[3] += wgt * bf_hi(raw.y);
                acc[4] += wgt * bf_lo(raw.z); acc[5] += wgt * bf_hi(raw.z); acc[6] += wgt * bf_lo(raw.w); acc[7] += wgt * bf_hi(raw.w); } }
        const float iw = 1.f / W;
        u32x4 o; o.x = cvt_pk_bf16(acc[0] * iw, acc[1] * iw); o.y = cvt_pk_bf16(acc[2] * iw, acc[3] * iw); o.z = cvt_pk_bf16(acc[4] * iw, acc[5] * iw); o.w = cvt_pk_bf16(acc[6] * iw, acc[7] * iw);
        *(GAS u32x4*)(Y + (size_t)m * 512 + h * 64 + 8 * c8) = o;
    }
}
}
namespace mk {
constexpr int PH_PRO = 0, PH_PER_LAYER = 9, PH_WIN = 0, PH_MIXA = 1, PH_MIXB = 2, PH_MIXC = 3, PH_MIXD = 4, PH_BRANCH = 5, PH_WOUT = 6, PH_FF1 = 7, PH_FF2 = 8;
constexpr int PH_TOTAL = 1 + PH_PER_LAYER * DEPTH_;

#ifndef PROBE_MASK
#define PROBE_MASK 0u
#endif
#ifndef PROBE_K
#define PROBE_K 2
#endif
#define PB_BEGIN(x) unsigned long long pb_t0_##x = 0ull; if ((PROBE_MASK >> (x)) & 1u) pb_t0_##x = __builtin_amdgcn_s_memrealtime()
#define PB_END(x) do { if ((PROBE_MASK >> (x)) & 1u) { const unsigned long long t1_ = __builtin_amdgcn_s_memrealtime(); const unsigned long long until_ = t1_ + (unsigned long long)PROBE_K * (t1_ - pb_t0_##x); \
    while (__builtin_amdgcn_s_memrealtime() < until_) __builtin_amdgcn_s_sleep(8); } } while (0)
__global__ void __launch_bounds__(NTHREADS, 2) mk_fwd(Args args) {
    extern __shared__ __attribute__((aligned(16))) unsigned char lds_raw[];
    Frame F;
    F.lds = (LAS unsigned char*)lds_raw;
    F.MISC = (volatile LAS unsigned*)(F.lds + MISC_OFF);
    F.tid = threadIdx.x; F.lane = F.tid & 63; F.wave = __builtin_amdgcn_readfirstlane(F.tid >> 6);
    F.G = gridDim.x; { const int bx = blockIdx.x; F.vcu = (F.G % 8 == 0) ? (bx % 8) * (F.G / 8) + bx / 8 : bx; }
    F.ws = args.ws; F.ctl = (gu32*)(args.ws + WS_CTL);
    for (int u = F.tid; u < (LDS_BYTES - RING_BYTES) / 4; u += NTHREADS) ((LAS unsigned*)(F.lds + RING_BYTES))[u] = 0u;
    __syncthreads();
    XcdBarrier bar = xcd_barrier_post((unsigned*)(F.ctl + CW_BAR) + args.li * XCD_BAR_WORDS, F.MISC + 8);
    const int lo = args.ph_lo, hi = args.ph_hi;
#define IN(k) (lo <= (k) && (k) < hi)
#define SEAM(k) do { if (IN((k) + 1)) { XcdBarrier bq = bar; asm volatile("" : "+s"(bq.bar)); xcd_barrier(bq); } } while (0)
#define OPQ_WS unsigned char* wsq = args.ws; int bxq = blockIdx.x, Gq = gridDim.x, tidq = threadIdx.x; \
    asm volatile("" : "+s"(wsq), "+s"(bxq), "+s"(Gq), "+v"(tidq)); \
    const int vcuq = (Gq % 8 == 0) ? (bxq % 8) * (Gq / 8) + bxq / 8 : bxq; (void)vcuq; (void)tidq
#define WSP(T, off) ((T*)(wsq + (off)))
#define WL(T, off) ((const T*)(wsq + WS_WTS + (size_t)l * WL_STRIDE + (off)))

    if (IN(PH_PRO)) { PB_BEGIN(0); p0_prologue(F, args, 0, DEPTH_, true); PB_END(0); SEAM(PH_PRO); }

    for (int l = 0; l < DEPTH_; ++l) {
        const int pb = 1 + PH_PER_LAYER * l;
        if (hi <= pb || lo >= pb + PH_PER_LAYER) continue;

        if (IN(pb + PH_WIN)) { OPQ_WS; PB_BEGIN(1);
            pg8::Gemm g{WSP(bf16_t, WS_ACT), WL(bf16_t, WL_WIN)}; pg8::StaticOrder<33> S; S.init(Gq, bxq);
            EpiWin E{WSP(bf16_t, WS_SEG), WSP(float, WS_SMALL), WSP(float, WS_SS)};
            pg8::gemm_phase<1024, EpiWin, pg8::StaticOrder<33>, true, true>(F.lds, g, S, E);
            PB_END(1); SEAM(pb + PH_WIN);
        }
        if (IN(pb + PH_MIXA)) { OPQ_WS; PB_BEGIN(2);
            { PB_BEGIN(10); if (args.mix & 1) for (int u = vcuq; u < 256; u += Gq) gla_unit<false>(F.lds, args, l, u); PB_END(10); }
            { PB_BEGIN(11); if (args.mix & 2) for (int u = vcuq; u < 256; u += Gq) ml_unit<false>(F.lds, args, l, u); PB_END(11); }
            { PB_BEGIN(12); if (args.mix & 4) for (int u = vcuq; u < 256; u += Gq) mb_prep_unit(F.lds, args, l, u); PB_END(12); }
            PB_END(2); SEAM(pb + PH_MIXA); }
        if (IN(pb + PH_MIXB)) { OPQ_WS; PB_BEGIN(3);
            if (args.mix & 1) gla_scan(args, vcuq * NTHREADS + tidq, Gq * NTHREADS);
            if (args.mix & 2) ml_scan(args, vcuq * NTHREADS + tidq, Gq * NTHREADS);
            if (args.mix & 4) for (int u = vcuq; u < 256; u += Gq) mb_topk_unit(F.lds, args, u);
            PB_END(3); SEAM(pb + PH_MIXB); }
        if (IN(pb + PH_MIXC)) { OPQ_WS; PB_BEGIN(4);
            { PB_BEGIN(13); if (args.mix & 1) for (int u = vcuq; u < 256; u += Gq) gla_unit<true>(F.lds, args, l, u); PB_END(13); }
            { PB_BEGIN(14); if (args.mix & 2) for (int u = vcuq; u < 256; u += Gq) ml_unit<true>(F.lds, args, l, u); PB_END(14); }
            if (args.mix & 4) { PB_BEGIN(15);
                for (;;) {
                    if (tidq == 0) F.MISC[16] = __hip_atomic_fetch_add((unsigned*)((gu32*)wsq + CW_MBQ + 64 * l), 1u, __ATOMIC_RELAXED, __HIP_MEMORY_SCOPE_AGENT);
                    __syncthreads();
                    const int q = (int)F.MISC[16];
                    if (q >= MB_NUNITS) break;
                    mb_attn_unit(F.lds, args, q);
                }
                PB_END(15);
            }
            PB_END(4); SEAM(pb + PH_MIXC); }
        if (IN(pb + PH_MIXD)) { OPQ_WS; PB_BEGIN(5);
            if (args.mix & 4) mb_combine(args, vcuq * NTHREADS + tidq, Gq * NTHREADS);
            PB_END(5); SEAM(pb + PH_MIXD); }
        if (IN(pb + PH_BRANCH)) { OPQ_WS; PB_BEGIN(6);
            static_assert(SEG_MQ - SEG_GG == 16 * MiB && SEG_LO - SEG_MQ == 16 * MiB, "y buffers equally spaced");
            typedef pg8::ZOrder<4, 3, 16 * MiB, 1 * MiB> BrOrder;
            pg8::Gemm g{WSP(bf16_t, WS_SEG + SEG_GG), WL(bf16_t, WL_WBR)}; BrOrder S; S.init(Gq, bxq);
            EpiBranch E{WSP(bf16_t, WS_SEG + SEG_BG), args.in[12] + (size_t)l * 3072, WSP(bf16_t, WS_MIXB)};
            pg8::gemm_phase<512, EpiBranch, BrOrder, true, true>(F.lds, g, S, E);
            PB_END(6); SEAM(pb + PH_BRANCH);
        }
        if (IN(pb + PH_WOUT)) { OPQ_WS; PB_BEGIN(7);
            pg8::Gemm g{WSP(bf16_t, WS_MIXB), WL(bf16_t, WL_WOUT)}; pg8::StaticOrder<4> S; S.init(Gq, bxq);
            EpiRes<false> E{l == 0 ? args.in[0] : args.out, args.out, WSP(bf16_t, WS_ACT), WSP(float, WS_SS), args.in[17] + (size_t)l * 1024};
            pg8::gemm_phase<1024, EpiRes<false>, pg8::StaticOrder<4>, false, true>(F.lds, g, S, E);
            PB_END(7); SEAM(pb + PH_WOUT);
        }
        if (IN(pb + PH_FF1)) { OPQ_WS; PB_BEGIN(8);
            pg8::Gemm g{WSP(bf16_t, WS_ACT), WL(bf16_t, WL_FF1)}; pg8::StaticOrder<16> S; S.init(Gq, bxq);
            EpiFf1 E{WSP(bf16_t, WS_H), WSP(float, WS_SS)};
            pg8::gemm_phase<1024, EpiFf1, pg8::StaticOrder<16>, true, true>(F.lds, g, S, E);
            PB_END(8); SEAM(pb + PH_FF1);
        }
        if (IN(pb + PH_FF2)) { OPQ_WS; PB_BEGIN(9);
            pg8::Gemm g{WSP(bf16_t, WS_H), WL(bf16_t, WL_FF2)}; pg8::StaticOrder<4> S; S.init(Gq, bxq);
            if (l < DEPTH_ - 1) { EpiRes<false> E{args.out, args.out, WSP(bf16_t, WS_ACT), WSP(float, WS_SS), args.in[1] + (size_t)(l + 1) * 1024};
                pg8::gemm_phase<4096, EpiRes<false>, pg8::StaticOrder<4>, false, true>(F.lds, g, S, E); }
            else { EpiRes<true> E{args.out, args.out, WSP(bf16_t, WS_ACT), WSP(float, WS_SS), args.in[1]};
                pg8::gemm_phase<4096, EpiRes<true>, pg8::StaticOrder<4>, false, true>(F.lds, g, S, E); }
            PB_END(9); SEAM(pb + PH_FF2);
        }
    }
#undef IN
#undef SEAM
#undef WSP
#undef WL
#undef OPQ_WS
}

static int g_grid = 0;
static bool mk_setup() {
    if (g_grid) return g_grid > 0;
    int dev = 0, cus = 0;
    if (hipGetDevice(&dev) != hipSuccess || hipDeviceGetAttribute(&cus, hipDeviceAttributeMultiprocessorCount, dev) != hipSuccess) { g_grid = -1; return false; }
    if (hipFuncSetAttribute((const void*)mk_fwd, hipFuncAttributeMaxDynamicSharedMemorySize, LDS_BYTES) != hipSuccess) { fprintf(stderr, "mk: hipFuncSetAttribute failed\n"); g_grid = -1; return false; }
    (void)hipGetLastError();
    g_grid = cus;
    return true;
}
static void mk_launch(const Args& base, int lo, int hi, int li, hipStream_t st) {
    Args a = base; a.ph_lo = lo; a.ph_hi = hi; a.li = li;
    hipLaunchKernelGGL(mk_fwd, dim3(g_grid), dim3(NTHREADS), LDS_BYTES, st, a);
}
}
extern "C" void kernel_launch(void* const* d_in, const int* in_sizes, int n_in, void* d_out, int out_size, void* d_ws, size_t ws_size, hipStream_t stream) {
    using namespace mk;
    if (n_in != 20 || out_size != M_ * D_ || ws_size < WS_END) { fprintf(stderr, "kernel_launch: unexpected shapes (n_in %d out %d ws %zu)\n", n_in, out_size, ws_size); return; }
    if (!mk_setup()) return;
    unsigned char* ws = (unsigned char*)d_ws;
    (void)hipMemsetAsync(ws + WS_CTL, 0, CTL_ZERO_BYTES, stream);
    Args a{}; for (int i = 0; i < 20; ++i) a.in[i] = (const float*)d_in[i]; a.out = (float*)d_out; a.ws = ws; a.mix = 7;
    mk_launch(a, 0, PH_TOTAL, 0, stream);
}
```

```cpp
#define PROBE_MASK 0x0u
#include <hip/hip_runtime.h>
#include <cstdio>
#include <cstdint>
#include <cmath>
#define LAS __attribute__((address_space(3)))
#define GAS __attribute__((address_space(1)))
typedef unsigned short bf16_t;
typedef short bf16x8 __attribute__((ext_vector_type(8)));
typedef short bf16x4 __attribute__((ext_vector_type(4)));
typedef float f32x4 __attribute__((ext_vector_type(4)));
typedef float f32x2 __attribute__((ext_vector_type(2)));
typedef unsigned u32x4 __attribute__((ext_vector_type(4)));
typedef unsigned u32x2 __attribute__((ext_vector_type(2)));
typedef GAS unsigned gu32;
#define RLX_AGENT __ATOMIC_RELAXED, __HIP_MEMORY_SCOPE_AGENT
#define LDS_WAIT() asm volatile("s_waitcnt lgkmcnt(0)" ::: "memory")
#define VM_WAIT() asm volatile("s_waitcnt vmcnt(0)" ::: "memory")

__device__ __forceinline__ unsigned cvt_pk_bf16(float lo, float hi) { unsigned r; asm volatile("v_cvt_pk_bf16_f32 %0, %1, %2" : "=v"(r) : "v"(lo), "v"(hi)); return r; }
__device__ __forceinline__ float bf_lo(unsigned u) { return __uint_as_float(u << 16); }
__device__ __forceinline__ float bf_hi(unsigned u) { return __uint_as_float(u & 0xffff0000u); }
__device__ __forceinline__ float bf2f(bf16_t h) { return __uint_as_float(((unsigned)h) << 16); }
__device__ __forceinline__ bf16_t f2bf(float f) { return (bf16_t)(cvt_pk_bf16(f, 0.f) & 0xffffu); }
__device__ __forceinline__ float wave_sum(float v) {
#pragma unroll
    for (int o = 1; o < 64; o <<= 1) v += __shfl_xor(v, o);
    return v;
}
__device__ __forceinline__ void st16_wt(void* p, u32x4 v) { asm volatile("global_store_dwordx4 %0, %1, off sc1\n\ts_nop 1" :: "v"(p), "v"(v) : "memory"); }
__device__ __forceinline__ void st8_wt(void* p, u32x2 v) { asm volatile("global_store_dwordx2 %0, %1, off sc1\n\ts_nop 1" :: "v"(p), "v"(v) : "memory"); }
__device__ __forceinline__ int lane_id() { int l; asm volatile("v_mbcnt_lo_u32_b32 %0, -1, 0\n\tv_mbcnt_hi_u32_b32 %0, -1, %0" : "=v"(l)); return l; }
__device__ __forceinline__ float fast_sigmoid(float x) { return 1.f / (1.f + __expf(-x)); }

namespace pg8 {
constexpr int BM = 256, BK = 64, HALF = 128, HTB = HALF * BK * 2, STAGE_BYTES = 8 * HTB, NXCD = 8, WGM = 8;
__host__ __device__ __forceinline__ int lds_byte(int r, int c) { const int st = (r >> 4) * 2 + (c >> 5), rr = r & 15, cc = c & 31, ob = rr * 64 + cc * 2; return st * 1024 + (ob ^ (((ob >> 9) & 1) << 5)); }
__host__ __device__ __forceinline__ void stage_rc(int b, int& R, int& C) { const int st = b / 1024, sb = b % 1024, swz = sb ^ (((sb >> 9) & 1) << 5); R = (st >> 1) * 16 + swz / 64; C = (st & 1) * 32 + (swz % 64) / 2; }
__host__ __device__ __forceinline__ int perm32(int rho) { const int n = rho >> 4, i = rho & 15; return 8 * (i >> 2) + 4 * n + (i & 3); }

struct Unit { int pm, pn, z; };
struct Gemm { const bf16_t* A; const bf16_t* Bt; };

template <int NN> struct StaticOrder {
    static constexpr int nM = 64, nN = NN, nwg = nM * nN;
    static constexpr size_t ZSA = 0, ZSB = 0;
    int G, c;
    __device__ void init(int G_, int c_) { G = G_; c = c_; }
    __device__ bool next(int i, Unit& u) const {
        const long L = (long)i * G + c; if (L >= nwg) return false;
        int wgid = (int)L; { const int q = nwg / NXCD, r = nwg % NXCD, xcd = wgid % NXCD, off = wgid / NXCD; wgid = (xcd < r ? xcd * (q + 1) : r * (q + 1) + (xcd - r) * q) + off; }
        const int nig = WGM * nN, gid = wgid / nig, fm = gid * WGM, gsz = (nM - fm) < WGM ? (nM - fm) : WGM;
        u.pm = fm + ((wgid % nig) % gsz); u.pn = (wgid % nig) / gsz; u.z = 0; return true;
    }
};
template <int NN, int NZ, size_t ZSA_, size_t ZSB_> struct ZOrder {
    static constexpr size_t ZSA = ZSA_, ZSB = ZSB_;
    StaticOrder<NN> S;
    __device__ void init(int G_, int c_) { S.init(G_, c_); }
    __device__ bool next(int i, Unit& u) const { const bool ok = S.next(i / NZ, u); u.z = i % NZ; return ok; }
};

template <int K, class Epi, class Sched, bool ALIGN_EPI, bool SP2>
__device__ __forceinline__ void gemm_phase(LAS unsigned char* lds, const Gemm g, const Sched& S, const Epi& E, int wv) {
    int tid_ = (wv << 6) | lane_id(); asm volatile("" : "+v"(tid_));
    const int tid = tid_, wid = __builtin_amdgcn_readfirstlane(tid >> 6), lane = tid & 63, wr = wid >> 2, wc = wid & 3, fr = lane & 15, fq = lane >> 4;
    constexpr int nt = K / BK, lda = K;
    unsigned voffA[2], voffB[2];
#pragma unroll
    for (int i = 0; i < 2; ++i) { int R, C; stage_rc(tid * 16 + i * 8192, R, C); const int Rb = Epi::PERM ? ((R & ~31) + perm32(R & 31)) : R;
        voffA[i] = (unsigned)(R * lda + C) * 2u; voffB[i] = (unsigned)(Rb * K + C) * 2u; }
    constexpr size_t kstep = (size_t)(BK * 2);
    constexpr size_t hstepA = (size_t)HALF * lda * 2, hstepB = (size_t)HALF * K * 2;
    constexpr size_t tstepA = 2 * hstepA, tstepB = 2 * hstepB;
    const unsigned ldsw = (unsigned)wid * 1024u;
    const int aoff = lds_byte(wr * 64 + fr, fq * 8), boff = lds_byte(wc * 32 + fr, fq * 8);
#define PG8_SA(b, h) (((b) * 2 + (h)) * HTB)
#define PG8_SB(b, h) ((4 + (b) * 2 + (h)) * HTB)
#define PG8_STAGE(bufoff, gbase, voff) do { _Pragma("unroll") for (int _i = 0; _i < 2; ++_i) \
        __builtin_amdgcn_global_load_lds((const unsigned*)((const char*)(gbase) + (voff)[_i]), (LAS unsigned*)(lds + (bufoff) + ldsw + _i * 8192), 16, 0, 0); } while (0)
#define PG8_LDA(dst, b, h) do { _Pragma("unroll") for (int m = 0; m < 4; ++m) _Pragma("unroll") for (int k = 0; k < 2; ++k) dst[m][k] = *(const LAS bf16x8*)(lds + PG8_SA(b, h) + aoff + m * 2048 + k * 1024); } while (0)
#define PG8_LDB(dst, b, h) do { _Pragma("unroll") for (int n = 0; n < 2; ++n) _Pragma("unroll") for (int k = 0; k < 2; ++k) dst[n][k] = *(const LAS bf16x8*)(lds + PG8_SB(b, h) + boff + n * 2048 + k * 1024); } while (0)
#define PG8_MMA(ai, bj, At, Bt) do { __builtin_amdgcn_s_setprio(1); _Pragma("unroll") for (int m = 0; m < 4; ++m) _Pragma("unroll") for (int n = 0; n < 2; ++n) _Pragma("unroll") for (int k = 0; k < 2; ++k) \
        acc[ai][bj][m][n] = __builtin_amdgcn_mfma_f32_16x16x32_bf16(Bt[n][k], At[m][k], acc[ai][bj][m][n], 0, 0, 0); __builtin_amdgcn_s_setprio(0); } while (0)
#define PG8_WAIT_V(n) asm volatile("s_waitcnt vmcnt(" #n ")" ::: "memory")
#define PG8_WAIT_L(n) asm volatile("s_waitcnt lgkmcnt(" #n ")" ::: "memory")
#define PG8_BAR __builtin_amdgcn_s_barrier()
#define PG8_SCHED __builtin_amdgcn_sched_barrier(0)
#define PG8_ABASE(u) ((const char*)g.A + (size_t)(u).z * Sched::ZSA + (size_t)(u).pm * tstepA)
#define PG8_BBASE(u) ((const char*)g.Bt + (size_t)(u).z * Sched::ZSB + (size_t)(u).pn * tstepB)
    Unit cur, nxt; int ui = 0;
    if (!S.next(0, cur)) return;
    f32x4 acc[2][2][4][2];
#pragma unroll
    for (int a = 0; a < 2; ++a)
#pragma unroll
        for (int b = 0; b < 2; ++b)
#pragma unroll
            for (int m = 0; m < 4; ++m)
#pragma unroll
                for (int n = 0; n < 2; ++n) acc[a][b][m][n] = (f32x4){0.f, 0.f, 0.f, 0.f};
    bf16x8 At[4][2], B0[2][2], B1[2][2];
    const char* cA = PG8_ABASE(cur); const char* cB = PG8_BBASE(cur);
    if constexpr (SP2) {
        PG8_STAGE(PG8_SB(0, 0), cB, voffB); PG8_STAGE(PG8_SB(0, 1), cB + hstepB, voffB); PG8_STAGE(PG8_SA(0, 0), cA, voffA); PG8_STAGE(PG8_SA(0, 1), cA + hstepA, voffA);
        if (wr == 1) PG8_BAR;
        PG8_WAIT_V(2); PG8_BAR;
        PG8_STAGE(PG8_SB(1, 0), cB + kstep, voffB); PG8_STAGE(PG8_SA(1, 0), cA + kstep, voffA); PG8_STAGE(PG8_SB(1, 1), cB + hstepB + kstep, voffB);
        PG8_WAIT_V(6); PG8_BAR;
    } else {
        PG8_STAGE(PG8_SB(0, 0), cB, voffB); PG8_STAGE(PG8_SA(0, 0), cA, voffA); PG8_STAGE(PG8_SB(0, 1), cB + hstepB, voffB); PG8_STAGE(PG8_SA(0, 1), cA + hstepA, voffA);
        if (wr == 1) PG8_BAR;
        PG8_WAIT_V(4); PG8_BAR;
        PG8_STAGE(PG8_SB(1, 0), cB + kstep, voffB); PG8_STAGE(PG8_SA(1, 0), cA + kstep, voffA); PG8_STAGE(PG8_SB(1, 1), cB + hstepB + kstep, voffB);
        PG8_WAIT_V(6); PG8_BAR;
    }
    for (;;) {
        const bool has_next = S.next(ui + 1, nxt);
        const char* nA = has_next ? PG8_ABASE(nxt) : cA; const char* nB = has_next ? PG8_BBASE(nxt) : cB;
        for (int t = 0; t < nt; t += 2) {
            const bool last = (t == nt - 2);
            const char* a1 = cA + (size_t)(t + 1) * kstep;
            const char* a2 = last ? nA : cA + (size_t)(t + 2) * kstep; const char* b2 = last ? nB : cB + (size_t)(t + 2) * kstep;
            const char* a3 = a2 + kstep; const char* b3 = b2 + kstep;
            if constexpr (SP2) {
            PG8_LDB(B0, 0, 0); PG8_LDB(B1, 0, 1); PG8_SCHED; PG8_LDA(At, 0, 0); PG8_STAGE(PG8_SA(1, 1), a1 + hstepA, voffA);
            PG8_WAIT_V(8); PG8_WAIT_L(0); PG8_BAR; PG8_MMA(0, 0, At, B0); PG8_MMA(0, 1, At, B1); PG8_BAR; PG8_SCHED;
            PG8_LDA(At, 0, 1); PG8_STAGE(PG8_SB(0, 0), b2, voffB); PG8_STAGE(PG8_SB(0, 1), b2 + hstepB, voffB); PG8_STAGE(PG8_SA(0, 0), a2, voffA);
            PG8_WAIT_V(8); PG8_WAIT_L(0); PG8_BAR; PG8_MMA(1, 0, At, B0); PG8_MMA(1, 1, At, B1); PG8_BAR; PG8_SCHED;
            PG8_LDB(B0, 1, 0); PG8_LDB(B1, 1, 1); PG8_SCHED; PG8_LDA(At, 1, 0); PG8_STAGE(PG8_SA(0, 1), a2 + hstepA, voffA);
            PG8_WAIT_V(8); PG8_WAIT_L(0); PG8_BAR; PG8_MMA(0, 0, At, B0); PG8_MMA(0, 1, At, B1); PG8_BAR; PG8_SCHED;
            PG8_LDA(At, 1, 1); PG8_STAGE(PG8_SB(1, 0), b3, voffB); PG8_STAGE(PG8_SB(1, 1), b3 + hstepB, voffB); PG8_STAGE(PG8_SA(1, 0), a3, voffA);
            PG8_WAIT_V(8); PG8_WAIT_L(0); PG8_BAR; PG8_MMA(1, 0, At, B0); PG8_MMA(1, 1, At, B1); PG8_BAR; PG8_SCHED;
            } else {
            PG8_LDB(B0, 0, 0); PG8_SCHED; PG8_LDA(At, 0, 0); PG8_STAGE(PG8_SA(1, 1), a1 + hstepA, voffA);
            PG8_WAIT_L(8); PG8_BAR; PG8_WAIT_L(0); PG8_MMA(0, 0, At, B0); PG8_BAR; PG8_SCHED;
            PG8_LDB(B1, 0, 1); PG8_STAGE(PG8_SB(0, 0), b2, voffB);
            PG8_BAR; PG8_WAIT_L(0); PG8_MMA(0, 1, At, B1); PG8_BAR;
            PG8_LDA(At, 0, 1); PG8_STAGE(PG8_SA(0, 0), a2, voffA);
            PG8_BAR; PG8_WAIT_L(0); PG8_MMA(1, 0, At, B0); PG8_BAR; PG8_SCHED;
            PG8_STAGE(PG8_SB(0, 1), b2 + hstepB, voffB);
            PG8_WAIT_V(6); PG8_BAR; PG8_MMA(1, 1, At, B1); PG8_BAR;
            PG8_LDB(B0, 1, 0); PG8_SCHED; PG8_LDA(At, 1, 0); PG8_STAGE(PG8_SA(0, 1), a2 + hstepA, voffA);
            PG8_WAIT_L(8); PG8_BAR; PG8_WAIT_L(0); PG8_MMA(0, 0, At, B0); PG8_BAR; PG8_SCHED;
            PG8_LDB(B1, 1, 1); PG8_STAGE(PG8_SB(1, 0), b3, voffB);
            PG8_BAR; PG8_WAIT_L(0); PG8_MMA(0, 1, At, B1); PG8_BAR;
            PG8_LDA(At, 1, 1); PG8_STAGE(PG8_SA(1, 0), a3, voffA);
            PG8_BAR; PG8_WAIT_L(0); PG8_MMA(1, 0, At, B0); PG8_BAR; PG8_SCHED;
            PG8_STAGE(PG8_SB(1, 1), b3 + hstepB, voffB);
            PG8_WAIT_V(6); PG8_BAR; PG8_MMA(1, 1, At, B1); PG8_BAR;
            }
        }
        if constexpr (ALIGN_EPI) { if (wr == 0) PG8_BAR; }
        { int tz = lane_id(); asm volatile("" : "+v"(tz)); const int l2 = tz & 63; E(acc, cur, wr, wc, l2 & 15, l2 >> 4); }
        if (!has_next) break;
        if (!E.keep_acc(cur)) {
#pragma unroll
        for (int a = 0; a < 2; ++a)
#pragma unroll
            for (int b = 0; b < 2; ++b)
#pragma unroll
                for (int m = 0; m < 4; ++m)
#pragma unroll
                    for (int n = 0; n < 2; ++n) acc[a][b][m][n] = (f32x4){0.f, 0.f, 0.f, 0.f};
        }
        cur = nxt; cA = nA; cB = nB; ++ui;
        if constexpr (ALIGN_EPI) { if (wr == 1) PG8_BAR; }
    }
    PG8_WAIT_V(0);
    if constexpr (!ALIGN_EPI) { if (wr == 0) PG8_BAR; }
    PG8_BAR;
#undef PG8_SA
#undef PG8_SB
#undef PG8_STAGE
#undef PG8_LDA
#undef PG8_LDB
#undef PG8_MMA
#undef PG8_WAIT_V
#undef PG8_WAIT_L
#undef PG8_BAR
#undef PG8_SCHED
#undef PG8_ABASE
#undef PG8_BBASE
}
}

#define XB_TMO      128
#define XB_XCNT(j)  (256  + 64 * (j))
#define XB_XSUB(j)  (1280 + 64 * (j))
#define XB_XGEN(j)  (2304 + 64 * (j))
#define XB_TOP      3328
#define XB_TOPGEN   3392
#define XCD_BAR_WORDS 3456
#define XB_SPIN_CAP (1u << 18)
__device__ __forceinline__ unsigned xb_ld(unsigned* p)              { return __hip_atomic_load(p, __ATOMIC_RELAXED, __HIP_MEMORY_SCOPE_AGENT); }
__device__ __forceinline__ unsigned xb_add(unsigned* p, unsigned v) { return __hip_atomic_fetch_add(p, v, __ATOMIC_RELAXED, __HIP_MEMORY_SCOPE_AGENT); }
__device__ __forceinline__ unsigned xb_xcc_id() { return (unsigned)__builtin_amdgcn_s_getreg((3 << 11) | 20) & 0xFu; }
#define XB_SPIN(cond, bar) do { unsigned _sp = 0; while (cond) { __builtin_amdgcn_s_sleep(1); \
    if ((++_sp & 255u) == 0u) { if (xb_ld(&(bar)[XB_TMO])) break; if (_sp > XB_SPIN_CAP) { atomicAdd(&(bar)[XB_TMO], 1u); break; } } } } while (0)
struct XcdBarrier { unsigned* bar; unsigned x; volatile LAS unsigned* st; };
__device__ __forceinline__ XcdBarrier xcd_barrier_post(unsigned* bar, volatile LAS unsigned* st) {
    XcdBarrier b; b.bar = bar; b.x = xb_xcc_id(); b.st = st;
    if (threadIdx.x == 0) (void)xb_add(&bar[XB_XCNT(b.x)], 1u);
    return b;
}
__device__ __forceinline__ void xcd_barrier_complete(unsigned* bar, unsigned x, unsigned& nloc, unsigned& nx) {
    const unsigned G = gridDim.x * gridDim.y * gridDim.z;
    unsigned sum, cnt, mine, sp = 0u;
    for (;;) {
        sum = 0u; cnt = 0u; mine = 0u;
#pragma unroll
        for (unsigned j = 0; j < 16; ++j) { const unsigned c = xb_ld(&bar[XB_XCNT(j)]); sum += c; cnt += (c > 0u) ? 1u : 0u; mine = (j == x) ? c : mine; }
        if (sum == G) break;
        __builtin_amdgcn_s_sleep(1);
        if ((++sp & 255u) == 0u) { if (xb_ld(&bar[XB_TMO])) break; if (sp > XB_SPIN_CAP) { atomicAdd(&bar[XB_TMO], 1u); break; } }
    }
    nloc = mine > 0u ? mine : 1u; nx = cnt > 0u ? cnt : 1u;
}
__device__ __forceinline__ void xcd_barrier(const XcdBarrier& b, bool leader  ) {
    asm volatile("s_waitcnt vmcnt(0)" ::: "memory");
    __syncthreads();
    if (leader) {
        unsigned* bar = b.bar;
        __builtin_amdgcn_s_waitcnt(0);
        unsigned nloc = b.st[0], nx = b.st[1];
        if (nloc == 0u) { xcd_barrier_complete(bar, b.x, nloc, nx); b.st[0] = nloc; b.st[1] = nx; }
        const unsigned old = xb_add(&bar[XB_XSUB(b.x)], 1u);
        const unsigned gen = old / nloc;
        if (old + 1u == (gen + 1u) * nloc) {
            __builtin_amdgcn_fence(__ATOMIC_RELEASE, "agent");
            asm volatile("s_waitcnt vmcnt(0)" ::: "memory");
            const unsigned og = xb_add(&bar[XB_TOP], 1u);
            const unsigned tg = og / nx;
            if (og + 1u == (tg + 1u) * nx) xb_add(&bar[XB_TOPGEN], 1u);
            else XB_SPIN(xb_ld(&bar[XB_TOPGEN]) == tg, bar);
            __builtin_amdgcn_fence(__ATOMIC_ACQUIRE, "agent");
            xb_add(&bar[XB_XGEN(b.x)], 1u);
            asm volatile("s_waitcnt vmcnt(0)" ::: "memory");
        } else {
            XB_SPIN(xb_ld(&bar[XB_XGEN(b.x)]) == gen, bar);
            __builtin_amdgcn_fence(__ATOMIC_ACQUIRE, "agent");
            asm volatile("s_waitcnt vmcnt(0)" ::: "memory");
        }
    }
    __syncthreads();
}
namespace mk {
constexpr int NWAVES = 8, NTHREADS = 512;
constexpr int B_ = 2, T_ = 8192, D_ = 1024, M_ = B_ * T_, DEPTH_ = 4, D_IN_ = 8216, D_FF_ = 4096, NPAD_ = 8448;
constexpr int OFF_GQ = 0, OFF_GK = 512, OFF_GV = 1024, OFF_GG = 1536, OFF_GA = 2048, OFF_MQ = 2064, OFF_MK = 2576, OFF_MV = 3088,
              OFF_LQ = 3600, OFF_LK = 3856, OFF_LV = 4112, OFF_LO = 4624, OFF_LI = 5136, OFF_LF = 5140, OFF_BG = 5144;
constexpr float EPS_ = 1e-6f;
constexpr size_t MiB = 1u << 20;
constexpr size_t WS_CTL = 0, CTL_ZERO_BYTES = 1 * MiB;
constexpr size_t WS_SS = 1 * MiB;
constexpr size_t WS_SMALL = 2 * MiB;
constexpr size_t WS_ROPE = 4 * MiB;
constexpr size_t WS_MISC = 6 * MiB;
constexpr size_t WS_WTS = 8 * MiB;
constexpr size_t WL_WIN = 0, WL_WBR = 16 * MiB + MiB / 2, WL_WOUT = WL_WBR + 3 * MiB, WL_FF1 = WL_WOUT + 2 * MiB, WL_FF2 = WL_FF1 + 8 * MiB, WL_STRIDE = WL_FF2 + 8 * MiB;
static_assert(WL_STRIDE == 37 * MiB + MiB / 2, "weights per layer");
constexpr size_t WS_SEG = 158 * MiB;
constexpr size_t SEG_GQ = 0, SEG_GK = 16 * MiB, SEG_GV = 32 * MiB, SEG_MK = 48 * MiB, SEG_MV = 64 * MiB, SEG_LQ = 80 * MiB, SEG_LK = 88 * MiB, SEG_LV = 96 * MiB,
                 SEG_GG = 112 * MiB, SEG_MQ = 128 * MiB, SEG_LO = 144 * MiB, SEG_BG = 160 * MiB;
constexpr size_t WS_MIXED = WS_SEG;
constexpr size_t WS_MIXB = WS_SEG + 64 * MiB;
constexpr size_t WS_H = WS_SEG;
constexpr size_t WS_ACT = 414 * MiB;
constexpr size_t WS_SCR = 446 * MiB;
constexpr size_t WS_END = 512 * MiB;
static_assert(WS_WTS + 4 * WL_STRIDE <= WS_SEG, "weights fit");
constexpr int CW_BAR = 4096;
constexpr int N_BAR_REGIONS = 16;
constexpr int RING_BYTES = 131072, MISC_OFF = RING_BYTES + 320, LDS_BYTES = 147456;

struct Args { const float* in[20]; float* out; unsigned char* ws; int ph_lo, ph_hi, li, mix; };

struct Frame {
    LAS unsigned char* lds; volatile LAS unsigned* MISC; gu32* ctl; unsigned char* ws;
    int tid, lane, wave, G, vcu;
};

__device__ __forceinline__ int win_src(int n) {
    if (n < 512) return OFF_GQ + n;
    if (n < 1024) return OFF_GK + (n - 512);
    if (n < 1536) return OFF_GV + (n - 1024);
    if (n < 2048) return OFF_MK + (n - 1536);
    if (n < 2560) return OFF_MV + (n - 2048);
    if (n < 2816) return OFF_LQ + (n - 2560);
    if (n < 3072) return OFF_LK + (n - 2816);
    if (n < 3584) return OFF_LV + (n - 3072);
    if (n < 4096) return OFF_GG + (n - 3584);
    if (n < 4608) return OFF_MQ + (n - 4096);
    if (n < 5120) return OFF_LO + (n - 4608);
    if (n < 8192) return OFF_BG + (n - 5120);
    if (n < 8208) return OFF_GA + (n - 8192);
    if (n < 8212) return OFF_LI + (n - 8208);
    if (n < 8216) return OFF_LF + (n - 8212);
    return -1;
}
__device__ __forceinline__ void transpose_item(const float* W, int ldw, bf16_t* WT, int K, int k0, int n0, int sc, LAS float* scr, int lane) {
#pragma unroll 8
    for (int i = 0; i < 32; ++i) { const int kk = 2 * i + (lane >> 5); scr[kk * 33 + (lane & 31)] = sc >= 0 ? W[(size_t)(k0 + kk) * ldw + sc] : 0.f; }
    LDS_WAIT(); asm volatile("" ::: "memory");
    const int c = lane & 7;
#pragma unroll
    for (int j = 0; j < 4; ++j) { const int n = (lane >> 3) + 8 * j; const LAS float* s = scr + (8 * c) * 33 + n;
        u32x4 o; o.x = cvt_pk_bf16(s[0 * 33], s[1 * 33]); o.y = cvt_pk_bf16(s[2 * 33], s[3 * 33]); o.z = cvt_pk_bf16(s[4 * 33], s[5 * 33]); o.w = cvt_pk_bf16(s[6 * 33], s[7 * 33]);
        *(GAS u32x4*)(WT + (size_t)(n0 + n) * K + k0 + 8 * c) = o; }
    LDS_WAIT(); asm volatile("" ::: "memory");
}
constexpr int IT_WIN = 16 * (NPAD_ / 32), IT_BR = 8 * 32, IT_WOUT = 16 * 32, IT_FF1 = 16 * 128, IT_FF2 = 64 * 32;
constexpr int IT_LAYER = IT_WIN + 3 * IT_BR + IT_WOUT + IT_FF1 + IT_FF2;
__device__ __forceinline__ void weights_item(const Args& a, unsigned char* ws, int l, int it, LAS float* scr, int lane) {
    unsigned char* wl = ws + WS_WTS + (size_t)l * WL_STRIDE;
    int r = it;
    if (r < IT_WIN) { const int kb = r / (NPAD_ / 32), nb = r % (NPAD_ / 32); const int sc = win_src(nb * 32 + (lane & 31));
        transpose_item(a.in[2] + (size_t)l * 1024 * D_IN_, D_IN_, (bf16_t*)(wl + WL_WIN), 1024, kb * 64, nb * 32, sc, scr, lane); return; }
    r -= IT_WIN;
    if (r < 3 * IT_BR) { const int z = r / IT_BR, q = r % IT_BR, kb = q / 32, nb = q % 32;
        transpose_item((z == 0 ? a.in[13] : (z == 1 ? a.in[14] : a.in[15])) + (size_t)l * 512 * 1024, 1024, (bf16_t*)(wl + WL_WBR + (size_t)z * MiB), 512, kb * 64, nb * 32, nb * 32 + (lane & 31), scr, lane); return; }
    r -= 3 * IT_BR;
    if (r < IT_WOUT) { const int kb = r / 32, nb = r % 32;
        transpose_item(a.in[16] + (size_t)l * 1024 * 1024, 1024, (bf16_t*)(wl + WL_WOUT), 1024, kb * 64, nb * 32, nb * 32 + (lane & 31), scr, lane); return; }
    r -= IT_WOUT;
    if (r < IT_FF1) { const int kb = r / 128, nb = r % 128;
        transpose_item(a.in[18] + (size_t)l * 1024 * 4096, 4096, (bf16_t*)(wl + WL_FF1), 1024, kb * 64, nb * 32, nb * 32 + (lane & 31), scr, lane); return; }
    r -= IT_FF1;
    { const int kb = r / 32, nb = r % 32;
        transpose_item(a.in[19] + (size_t)l * 4096 * 1024, 1024, (bf16_t*)(wl + WL_FF2), 4096, kb * 64, nb * 32, nb * 32 + (lane & 31), scr, lane); }
}
__device__ __forceinline__ void prep_row(const float* xrow, const float* g, bf16_t* arow, float* ssrow, int lane) {
    const GAS f32x4* xr = (const GAS f32x4*)xrow + lane;
    f32x4 v[4]; float s = 0.f;
#pragma unroll
    for (int j = 0; j < 4; ++j) { v[j] = xr[64 * j]; s += (v[j].x * v[j].x + v[j].y * v[j].y) + (v[j].z * v[j].z + v[j].w * v[j].w); }
    s = wave_sum(s);
    GAS u32x2* o8 = (GAS u32x2*)arow + lane;
#pragma unroll
    for (int j = 0; j < 4; ++j) { const f32x4 gg = ((const GAS f32x4*)g)[lane + 64 * j]; u32x2 w; w.x = cvt_pk_bf16(v[j].x * gg.x, v[j].y * gg.y); w.y = cvt_pk_bf16(v[j].z * gg.z, v[j].w * gg.w); o8[64 * j] = w; }
    if (lane < 16) ssrow[lane] = lane == 0 ? s : 0.f;
}
__device__ __forceinline__ void p0_prologue(Frame& F, const Args& a, int l_lo, int l_hi, bool do_rows) {
    LAS float* scr = (LAS float*)(F.lds + F.wave * 16384);
    const int gw = F.vcu * NWAVES + F.wave, NGW = F.G * NWAVES;
    const int nit = (l_hi - l_lo) * IT_LAYER;
    for (int it = gw; it < nit; it += NGW) weights_item(a, F.ws, l_lo + it / IT_LAYER, it % IT_LAYER, scr, F.lane);
    if (do_rows) {
        for (int m = gw; m < M_; m += NGW) prep_row(a.in[0] + (size_t)m * D_, a.in[1], (bf16_t*)(F.ws + WS_ACT) + (size_t)m * D_, (float*)(F.ws + WS_SS) + (size_t)m * 16, F.lane);
        float* COS = (float*)(F.ws + WS_ROPE); float* SIN = COS + 8192 * 32;
        for (int idx = gw * 64 + F.lane; idx < 8192 * 32; idx += NGW * 64) { const int t = idx >> 5, i = idx & 31;
            const float inv = 1.0f / powf(10000.0f, (float)(2 * i) / 64.0f); const float ang = (float)t * inv; COS[idx] = cosf(ang); SIN[idx] = sinf(ang); }
    }
}

__device__ __forceinline__ void row_rstd(const float* ss, int row0, float (&rs)[2][4]) {
#pragma unroll
    for (int ai = 0; ai < 2; ++ai)
#pragma unroll
        for (int m = 0; m < 4; ++m) { const GAS f32x4* p = (const GAS f32x4*)(ss + (size_t)(row0 + ai * 128 + m * 16) * 16);
            const f32x4 a = p[0], b = p[1], c = p[2], d = p[3];
            const float s = ((a.x + a.y) + (a.z + a.w)) + ((b.x + b.y) + (b.z + b.w)) + ((c.x + c.y) + (c.z + c.w)) + ((d.x + d.y) + (d.z + d.w));
            rs[ai][m] = rsqrtf(s * (1.f / 1024.f) + EPS_); }
}
struct EpiWin {
    static constexpr bool PERM = true;
    __device__ __forceinline__ bool keep_acc(const pg8::Unit&) const { return false; }
    bf16_t* seg; float* small_; const float* ss;
    __device__ __forceinline__ void operator()(const f32x4 (&acc)[2][2][4][2], const pg8::Unit& u, int wr, int wc, int fr, int fq) const {
        const int row0 = u.pm * 256 + wr * 64 + fr;
        float rs[2][4]; row_rstd(ss, row0, rs);
        const int pn = u.pn;
        if (pn < 32) {
            int st, width;
            if (pn < 10) { st = pn & ~1; width = 512; } else if (pn < 12) { st = pn; width = 256; } else if (pn < 20) { st = 12 + ((pn - 12) & ~1); width = 512; } else { st = 20; width = 3072; }
            bf16_t* base = seg + (size_t)M_ * 256 * st + (pn - st) * 256 + wc * 32 + 8 * fq;
#pragma unroll
            for (int ai = 0; ai < 2; ++ai)
#pragma unroll
                for (int m = 0; m < 4; ++m) { bf16_t* rowp = base + (size_t)(row0 + ai * 128 + m * 16) * width; const float r = rs[ai][m];
#pragma unroll
                    for (int bj = 0; bj < 2; ++bj) { const f32x4 v0 = acc[ai][bj][m][0] * r, v1 = acc[ai][bj][m][1] * r;
                        u32x4 w; w.x = cvt_pk_bf16(v0[0], v0[1]); w.y = cvt_pk_bf16(v0[2], v0[3]); w.z = cvt_pk_bf16(v1[0], v1[1]); w.w = cvt_pk_bf16(v1[2], v1[3]);
                        st16_wt(rowp + bj * 128, w); } }
        } else if (wc == 0) {
#pragma unroll
            for (int ai = 0; ai < 2; ++ai)
#pragma unroll
                for (int m = 0; m < 4; ++m) { float* p = small_ + (size_t)(row0 + ai * 128 + m * 16) * 32 + 8 * fq; const float r = rs[ai][m];
                    *(GAS f32x4*)p = acc[ai][0][m][0] * r; *(GAS f32x4*)(p + 4) = acc[ai][0][m][1] * r; }
        }
    }
};
struct EpiFf1 {
    static constexpr bool PERM = true;
    __device__ __forceinline__ bool keep_acc(const pg8::Unit&) const { return false; }
    bf16_t* H; const float* ss;
    __device__ __forceinline__ void operator()(const f32x4 (&acc)[2][2][4][2], const pg8::Unit& u, int wr, int wc, int fr, int fq) const {
        const int row0 = u.pm * 256 + wr * 64 + fr;
        float rs[2][4]; row_rstd(ss, row0, rs);
        bf16_t* base = H + u.pn * 256 + wc * 32 + 8 * fq;
#pragma unroll
        for (int ai = 0; ai < 2; ++ai)
#pragma unroll
            for (int m = 0; m < 4; ++m) { bf16_t* rowp = base + (size_t)(row0 + ai * 128 + m * 16) * 4096; const float r = rs[ai][m];
#pragma unroll
                for (int bj = 0; bj < 2; ++bj) { f32x4 v0 = acc[ai][bj][m][0] * r, v1 = acc[ai][bj][m][1] * r;
                    v0 = __builtin_elementwise_max(v0, (f32x4){0.f, 0.f, 0.f, 0.f}); v1 = __builtin_elementwise_max(v1, (f32x4){0.f, 0.f, 0.f, 0.f}); v0 = v0 * v0; v1 = v1 * v1;
                    u32x4 w; w.x = cvt_pk_bf16(v0[0], v0[1]); w.y = cvt_pk_bf16(v0[2], v0[3]); w.z = cvt_pk_bf16(v1[0], v1[1]); w.w = cvt_pk_bf16(v1[2], v1[3]);
                    st16_wt(rowp + bj * 128, w); } }
    }
};
template <bool LAST> struct EpiRes {
    static constexpr bool PERM = false;
    __device__ __forceinline__ bool keep_acc(const pg8::Unit&) const { return false; }
    const float* xin; float* xout; bf16_t* act; float* ss; const float* g;
    __device__ __forceinline__ void operator()(const f32x4 (&acc)[2][2][4][2], const pg8::Unit& u, int wr, int wc, int fr, int fq) const {
        const int row0 = u.pm * 256 + wr * 64 + fr, col0 = u.pn * 256 + wc * 32 + 4 * fq;
        f32x4 gv[2][2];
        if (!LAST) {
#pragma unroll
            for (int bj = 0; bj < 2; ++bj)
#pragma unroll
                for (int n = 0; n < 2; ++n) gv[bj][n] = *(const GAS f32x4*)(g + col0 + bj * 128 + n * 16);
        }
#pragma unroll
        for (int ai = 0; ai < 2; ++ai)
#pragma unroll
            for (int m = 0; m < 4; ++m) { const int row = row0 + ai * 128 + m * 16; const size_t off = (size_t)row * 1024 + col0; float q = 0.f;
#pragma unroll
                for (int bj = 0; bj < 2; ++bj)
#pragma unroll
                    for (int n = 0; n < 2; ++n) { const size_t o2 = off + bj * 128 + n * 16; const f32x4 x = *(const GAS f32x4*)(xin + o2) + acc[ai][bj][m][n];
                        *(GAS f32x4*)(xout + o2) = x;
                        if (!LAST) { q += (x[0] * x[0] + x[1] * x[1]) + (x[2] * x[2] + x[3] * x[3]); const f32x4 a = x * gv[bj][n];
                            u32x2 w; w.x = cvt_pk_bf16(a[0], a[1]); w.y = cvt_pk_bf16(a[2], a[3]); *(GAS u32x2*)(act + o2) = w; } }
                if (!LAST) { q += __shfl_xor(q, 16); q += __shfl_xor(q, 32); if (fq == 0) ss[(size_t)row * 16 + u.pn * 4 + wc] = q; }
                if (m & 1) asm volatile("" ::: "memory"); }
    }
};
struct EpiBranch {
    static constexpr bool PERM = false;
    const bf16_t* bg; const float* gate_b; bf16_t* mixb;
    __device__ __forceinline__ bool keep_acc(const pg8::Unit& u) const { return u.z != 2; }
    __device__ __forceinline__ void operator()(f32x4 (&acc)[2][2][4][2], const pg8::Unit& u, int wr, int wc, int fr, int fq) const {
        const int row0 = u.pm * 256 + wr * 64 + fr, col0 = u.pn * 256 + wc * 32 + 4 * fq, z = u.z;
        const int z2 = z < 2 ? z + 1 : 2;
        f32x4 ga[2][2], gc[2][2];
#pragma unroll
        for (int bj = 0; bj < 2; ++bj)
#pragma unroll
            for (int n = 0; n < 2; ++n) { ga[bj][n] = *(const GAS f32x4*)(gate_b + z * 1024 + col0 + bj * 128 + n * 16); gc[bj][n] = *(const GAS f32x4*)(gate_b + z2 * 1024 + col0 + bj * 128 + n * 16); }
#pragma unroll
        for (int ai = 0; ai < 2; ++ai)
#pragma unroll
            for (int m = 0; m < 4; ++m) { const int row = row0 + ai * 128 + m * 16;
#pragma unroll
                for (int bj = 0; bj < 2; ++bj)
#pragma unroll
                    for (int n = 0; n < 2; ++n) { const int c = col0 + bj * 128 + n * 16;
                        const u32x2 ba = *(const GAS u32x2*)(bg + (size_t)row * 3072 + z * 1024 + c);
                        const u32x2 bc = *(const GAS u32x2*)(bg + (size_t)row * 3072 + z2 * 1024 + c);
                        const float xa[4] = {bf_lo(ba.x) + ga[bj][n][0], bf_hi(ba.x) + ga[bj][n][1], bf_lo(ba.y) + ga[bj][n][2], bf_hi(ba.y) + ga[bj][n][3]};
                        const float xc[4] = {bf_lo(bc.x) + gc[bj][n][0], bf_hi(bc.x) + gc[bj][n][1], bf_lo(bc.y) + gc[bj][n][2], bf_hi(bc.y) + gc[bj][n][3]};
                        f32x4 f;
#pragma unroll
                        for (int k = 0; k < 4; ++k) { const float ea = __expf(-fminf(fmaxf(xa[k], -30.f), 30.f));
                            if (z == 2) f[k] = __builtin_amdgcn_rcpf(1.f + ea);
                            else { const float ec = __expf(-fminf(fmaxf(xc[k], -30.f), 30.f)); f[k] = (1.f + ec) * __builtin_amdgcn_rcpf(1.f + ea); } }
                        const f32x4 v = acc[ai][bj][m][n] * f;
                        if (z == 2) { u32x2 w; w.x = cvt_pk_bf16(v[0], v[1]); w.y = cvt_pk_bf16(v[2], v[3]); *(GAS u32x2*)(mixb + (size_t)row * 1024 + c) = w; }
                        else acc[ai][bj][m][n] = v; }
                if (m & 1) asm volatile("" ::: "memory"); }
    }
};
}
namespace mk {
constexpr size_t SCR_GLA_KV = 36 * MiB;
constexpr size_t MISC_GLA_DT = 256 * 1024;
constexpr int GL_QD = 0, GL_KI = 17408, GL_KET = 34816, GL_VT = 53248, GL_ST = 71680, GL_DEC = 106496, GL_GA = 107008, GL_BC = 111104, GL_NRM = 113152, GL_END = 115200;
constexpr int P128 = 136, P64 = 72;

__device__ __forceinline__ bf16x8 lds16(const LAS bf16_t* p) { return *(const LAS bf16x8*)p; }
__device__ __forceinline__ bf16x8 lds8x2(const LAS bf16_t* p0, const LAS bf16_t* p1) {
    const bf16x4 a = *(const LAS bf16x4*)p0, b = *(const LAS bf16x4*)p1;
    return __builtin_shufflevector(a, b, 0, 1, 2, 3, 4, 5, 6, 7);
}
__device__ __forceinline__ bf16x8 pack8(const f32x4 a, const f32x4 b) {
    u32x4 w; w.x = cvt_pk_bf16(a[0], a[1]); w.y = cvt_pk_bf16(a[2], a[3]); w.z = cvt_pk_bf16(b[0], b[1]); w.w = cvt_pk_bf16(b[2], b[3]);
    return __builtin_bit_cast(bf16x8, w);
}
#define MFMA16(a, b, c) __builtin_amdgcn_mfma_f32_16x16x32_bf16((a), (b), (c), 0, 0, 0)

template <bool PASS_C>
__device__ __forceinline__ void gla_unit(LAS unsigned char* lds, const Args& args, int l, int u, int wv) {
    int tid_ = (wv << 6) | lane_id(); asm volatile("" : "+v"(tid_));
    const int tid = tid_, lane = tid & 63, w = __builtin_amdgcn_readfirstlane(tid >> 6), lr = lane & 15, lg = lane >> 4;
    const int bh = u >> 5, sc = u & 31, b = bh >> 2, h = bh & 3;
    const size_t mbase = (size_t)b * T_ + (size_t)sc * 256;
    GAS unsigned char* ws = (GAS unsigned char*)args.ws; asm volatile("" : "+s"(ws));
    const GAS bf16_t* GQ = (const GAS bf16_t*)(ws + WS_SEG + SEG_GQ) + h * 128; const GAS bf16_t* GK = (const GAS bf16_t*)(ws + WS_SEG + SEG_GK) + h * 128;
    const GAS bf16_t* GV = (const GAS bf16_t*)(ws + WS_SEG + SEG_GV) + h * 128; GAS bf16_t* GG = (GAS bf16_t*)(ws + WS_SEG + SEG_GG) + h * 128;
    const GAS float* SMALL = (const GAS float*)(ws + WS_SMALL);
    GAS float* KV = (GAS float*)(ws + WS_SCR + SCR_GLA_KV) + (size_t)u * 16384; GAS float* DT = (GAS float*)(ws + WS_MISC + MISC_GLA_DT) + (size_t)u * 128;
    LAS bf16_t* QD = (LAS bf16_t*)(lds + GL_QD); LAS bf16_t* KI = (LAS bf16_t*)(lds + GL_KI); LAS bf16_t* KET = (LAS bf16_t*)(lds + GL_KET);
    LAS bf16_t* VT = (LAS bf16_t*)(lds + GL_VT); LAS bf16_t* ST = (LAS bf16_t*)(lds + GL_ST);
    LAS float* DEC = (LAS float*)(lds + GL_DEC); LAS float* GA = (LAS float*)(lds + GL_GA); LAS float* BC = (LAS float*)(lds + GL_BC); LAS float* NRM = (LAS float*)(lds + GL_NRM);
    const int d = tid & 127, tq = tid >> 7;
    float aup[16];
    { const float* a_up = args.in[3] + (size_t)l * 16 * 512 + h * 128 + d;
#pragma unroll
      for (int r = 0; r < 16; ++r) aup[r] = a_up[r * 512]; }
    const float ab = args.in[4][(size_t)l * 512 + h * 128 + d];
    const float scale = 0.08838834764831845f;
    f32x4 S[8];
    if (PASS_C) {
#pragma unroll
        for (int et = 0; et < 8; ++et) {
#pragma unroll
            for (int r = 0; r < 4; ++r) S[et][r] = KV[(size_t)(16 * w + 4 * lg + r) * 128 + 16 * et + lr];
            u32x2 pk; pk.x = cvt_pk_bf16(S[et][0], S[et][1]); pk.y = cvt_pk_bf16(S[et][2], S[et][3]);
            *(LAS u32x2*)(ST + (16 * et + lr) * P128 + 16 * w + 4 * lg) = pk;
        }
    } else {
#pragma unroll
        for (int et = 0; et < 8; ++et) S[et] = (f32x4){0.f, 0.f, 0.f, 0.f};
    }
    float dsum = 0.f;
    bf16_t kr[16], qr[16], vr[16];
#define GLA_FETCH(cn) do { const size_t mr_ = mbase + (size_t)(cn) * 64; \
        const GAS bf16_t* kp_ = GK + (mr_ + tq * 16) * 512 + d; const GAS bf16_t* qp_ = GQ + (mr_ + tq * 16) * 512 + d; const GAS bf16_t* vp_ = GV + (mr_ + tq * 16) * 512 + d; \
        _Pragma("unroll") for (int i_ = 0; i_ < 16; ++i_) { kr[i_] = kp_[(size_t)i_ * 512]; vr[i_] = vp_[(size_t)i_ * 512]; if (PASS_C) qr[i_] = qp_[(size_t)i_ * 512]; } \
        } while (0)
    GLA_FETCH(0);
    for (int c = 0; c < 4; ++c) {
        const size_t mrow = mbase + (size_t)c * 64;
        __syncthreads();
        if (tid < 256) *(LAS f32x4*)(GA + tid * 4) = *(const GAS f32x4*)(SMALL + (mrow + (tid >> 2)) * 32 + (tid & 3) * 4);
        __syncthreads();
        float cs[16]; float run = 0.f;
#pragma unroll
        for (int i = 0; i < 16; ++i) { const LAS f32x4* gp = (const LAS f32x4*)(GA + (tq * 16 + i) * 16); float z = ab;
#pragma unroll
            for (int r4 = 0; r4 < 4; ++r4) { const f32x4 g4 = gp[r4]; z += g4[0] * aup[4 * r4] + g4[1] * aup[4 * r4 + 1] + g4[2] * aup[4 * r4 + 2] + g4[3] * aup[4 * r4 + 3]; }
            const float la = (fminf(z, 0.f) - __logf(1.f + __expf(-fabsf(z)))) * (1.f / 16.f);
            run += la; cs[i] = run; }
        BC[tq * 128 + d] = run;
        __syncthreads();
        float off = 0.f, tot = 0.f;
#pragma unroll
        for (int q = 0; q < 4; ++q) { const float v = BC[q * 128 + d]; off += (q < tq) ? v : 0.f; tot += v; }
        if (tq == 0) { DEC[d] = __expf(tot); dsum += tot; }
        {
            unsigned ke[8], vv[8];
#pragma unroll
            for (int i2 = 0; i2 < 8; ++i2) {
                float kend[2]; unsigned vraw[2];
#pragma unroll
                for (int q2 = 0; q2 < 2; ++q2) { const int i = 2 * i2 + q2; const int j = tq * 16 + i;
                    const float kf = bf2f(kr[i]); const float bc = off + cs[i];
                    kend[q2] = kf * __expf(tot - bc); vraw[q2] = vr[i];
                    if (PASS_C) { const float qf = bf2f(qr[i]);
                        QD[j * P128 + d] = f2bf(qf * scale * __expf(bc)); KI[j * P128 + d] = f2bf(kf * __expf(-bc)); } }
                ke[i2] = cvt_pk_bf16(kend[0], kend[1]); vv[i2] = vraw[0] | (vraw[1] << 16);
            }
            LAS u32x4* kd = (LAS u32x4*)(KET + d * P64 + tq * 16); kd[0] = (u32x4){ke[0], ke[1], ke[2], ke[3]}; kd[1] = (u32x4){ke[4], ke[5], ke[6], ke[7]};
            LAS u32x4* vd = (LAS u32x4*)(VT + d * P64 + tq * 16); vd[0] = (u32x4){vv[0], vv[1], vv[2], vv[3]}; vd[1] = (u32x4){vv[4], vv[5], vv[6], vv[7]};
        }
        if (!PASS_C && c < 3) GLA_FETCH(c + 1);
        u32x2 graw4[4];
        if (PASS_C) { const int it_ = w >> 1, eh_ = w & 1;
#pragma unroll
            for (int et = 0; et < 4; ++et) graw4[et] = *(const GAS u32x2*)(GG + (mrow + 16 * it_ + lr) * 512 + 64 * eh_ + 16 * et + 4 * lg); }
        __syncthreads();
        if (PASS_C) {
            const int it = w >> 1, eh = w & 1;
            bf16x8 qb[4];
#pragma unroll
            for (int ks = 0; ks < 4; ++ks) qb[ks] = lds16(QD + (16 * it + lr) * P128 + 32 * ks + 8 * lg);
            f32x4 P[4];
#pragma unroll
            for (int j2 = 0; j2 < 2; ++j2) {
                bf16x8 ka[8];
#pragma unroll
                for (int jj = 0; jj < 2; ++jj)
#pragma unroll
                    for (int ks = 0; ks < 4; ++ks) ka[4 * jj + ks] = lds16(KI + (16 * (2 * j2 + jj) + lr) * P128 + 32 * ks + 8 * lg);
                __builtin_amdgcn_sched_barrier(0);
#pragma unroll
                for (int jj = 0; jj < 2; ++jj) { const int jt = 2 * j2 + jj; P[jt] = (f32x4){0.f, 0.f, 0.f, 0.f};
                    if (jt <= it) {
#pragma unroll
                        for (int ks = 0; ks < 4; ++ks) P[jt] = MFMA16(ka[4 * jj + ks], qb[ks], P[jt]);
                        if (jt == it) {
#pragma unroll
                            for (int r = 0; r < 4; ++r) if (4 * lg + r > lr) P[jt][r] = 0.f; }
                    } }
                __builtin_amdgcn_sched_barrier(0);
            }
            bf16x8 pb[2]; pb[0] = pack8(P[0], P[1]); pb[1] = pack8(P[2], P[3]);
            f32x4 o[4];
#pragma unroll
            for (int e2 = 0; e2 < 2; ++e2) {
                bf16x8 va[4], sa[8];
#pragma unroll
                for (int ee = 0; ee < 2; ++ee) { const int er = 64 * eh + 16 * (2 * e2 + ee) + lr;
#pragma unroll
                    for (int s2 = 0; s2 < 2; ++s2) va[2 * ee + s2] = lds8x2(VT + er * P64 + 32 * s2 + 4 * lg, VT + er * P64 + 32 * s2 + 16 + 4 * lg);
#pragma unroll
                    for (int ks = 0; ks < 4; ++ks) sa[4 * ee + ks] = lds16(ST + er * P128 + 32 * ks + 8 * lg); }
                __builtin_amdgcn_sched_barrier(0);
#pragma unroll
                for (int ee = 0; ee < 2; ++ee) { f32x4 a = (f32x4){0.f, 0.f, 0.f, 0.f};
#pragma unroll
                    for (int s2 = 0; s2 < 2; ++s2) a = MFMA16(va[2 * ee + s2], pb[s2], a);
#pragma unroll
                    for (int ks = 0; ks < 4; ++ks) a = MFMA16(sa[4 * ee + ks], qb[ks], a);
                    o[2 * e2 + ee] = a; }
                __builtin_amdgcn_sched_barrier(0);
            }
            if (c < 3) GLA_FETCH(c + 1);
            float ssq = 0.f;
#pragma unroll
            for (int et = 0; et < 4; ++et) ssq += (o[et][0] * o[et][0] + o[et][1] * o[et][1]) + (o[et][2] * o[et][2] + o[et][3] * o[et][3]);
            ssq += __shfl_xor(ssq, 16); ssq += __shfl_xor(ssq, 32);
            if (lg == 0) NRM[eh * 64 + 16 * it + lr] = ssq;
            __syncthreads();
            const float rstd = rsqrtf((NRM[16 * it + lr] + NRM[64 + 16 * it + lr]) * (1.f / 128.f) + EPS_);
            const float* gn = args.in[5] + (size_t)l * 128;
#pragma unroll
            for (int et = 0; et < 4; ++et) { const int e0 = 64 * eh + 16 * et + 4 * lg; GAS bf16_t* gp = GG + (mrow + 16 * it + lr) * 512 + e0;
                const u32x2 graw = graw4[et]; const f32x4 gnv = *(const GAS f32x4*)(gn + e0);
                const float g0 = bf_lo(graw.x), g1 = bf_hi(graw.x), g2 = bf_lo(graw.y), g3 = bf_hi(graw.y);
                const float y0 = o[et][0] * rstd * gnv[0] * (g0 * fast_sigmoid(g0)), y1 = o[et][1] * rstd * gnv[1] * (g1 * fast_sigmoid(g1));
                const float y2 = o[et][2] * rstd * gnv[2] * (g2 * fast_sigmoid(g2)), y3 = o[et][3] * rstd * gnv[3] * (g3 * fast_sigmoid(g3));
                u32x2 yo; yo.x = cvt_pk_bf16(y0, y1); yo.y = cvt_pk_bf16(y2, y3); *(GAS u32x2*)gp = yo; }
        }
        {
            f32x4 dv4;
#pragma unroll
            for (int r = 0; r < 4; ++r) dv4[r] = DEC[16 * w + 4 * lg + r];
#pragma unroll
            for (int et = 0; et < 8; ++et) S[et] = S[et] * dv4;
            {
                bf16x8 ka[2], vb[16];
#pragma unroll
                for (int s2 = 0; s2 < 2; ++s2) { ka[s2] = lds16(KET + (16 * w + lr) * P64 + 32 * s2 + 8 * lg);
#pragma unroll
                    for (int et = 0; et < 8; ++et) vb[8 * s2 + et] = lds16(VT + (16 * et + lr) * P64 + 32 * s2 + 8 * lg); }
                __builtin_amdgcn_sched_barrier(0);
#pragma unroll
                for (int s2 = 0; s2 < 2; ++s2)
#pragma unroll
                    for (int et = 0; et < 8; ++et) S[et] = MFMA16(ka[s2], vb[8 * s2 + et], S[et]);
                __builtin_amdgcn_sched_barrier(0);
            }
            if (PASS_C) {
#pragma unroll
                for (int et = 0; et < 8; ++et) { u32x2 pk; pk.x = cvt_pk_bf16(S[et][0], S[et][1]); pk.y = cvt_pk_bf16(S[et][2], S[et][3]);
                    *(LAS u32x2*)(ST + (16 * et + lr) * P128 + 16 * w + 4 * lg) = pk; }
            }
        }
    }
    if (!PASS_C) {
#pragma unroll
        for (int et = 0; et < 8; ++et)
#pragma unroll
            for (int r = 0; r < 4; ++r) KV[(size_t)(16 * w + 4 * lg + r) * 128 + 16 * et + lr] = S[et][r];
        if (tq == 0) DT[d] = __expf(dsum);
    }
    __syncthreads();
}
__device__ __forceinline__ void gla_scan(const Args& args, int gtid, int gthreads) {
    GAS float* KV = (GAS float*)(args.ws + WS_SCR + SCR_GLA_KV); const GAS float* DT = (const GAS float*)(args.ws + WS_MISC + MISC_GLA_DT);
    for (int idx = gtid; idx < 8 * 16384; idx += gthreads) {
        const int bh = idx >> 14, de = idx & 16383, dd = de >> 7;
        float kv[32], dt[32];
#pragma unroll
        for (int s = 0; s < 32; ++s) { kv[s] = KV[(size_t)(bh * 32 + s) * 16384 + de]; dt[s] = DT[(bh * 32 + s) * 128 + dd]; }
        float st = 0.f;
#pragma unroll
        for (int s = 0; s < 32; ++s) { KV[(size_t)(bh * 32 + s) * 16384 + de] = st; st = dt[s] * st + kv[s]; }
    }
}
}
namespace mk {
constexpr size_t SCR_ML_KV = 52 * MiB;
constexpr size_t MISC_ML_MS = 512 * 1024;
constexpr int ML_QW = 0, ML_QR = 9216, ML_KS = 18432, ML_KWT = 27648, ML_VT = 36864, ML_ST = 57600, ML_SC = 78336, ML_NRM = 79872, ML_END = 80384;

__device__ __forceinline__ float wave_incl_sum(float x, int lane) {
#pragma unroll
    for (int o = 1; o < 64; o <<= 1) { const float v = __shfl_up(x, o); if (lane >= o) x += v; }
    return x;
}
__device__ __forceinline__ float wave_incl_max(float x, int lane) {
#pragma unroll
    for (int o = 1; o < 64; o <<= 1) { const float v = __shfl_up(x, o); if (lane >= o) x = fmaxf(x, v); }
    return x;
}

template <bool PASS_C>
__device__ __forceinline__ void ml_unit(LAS unsigned char* lds, const Args& args, int l, int u, int wv) {
    int tid_ = (wv << 6) | lane_id(); asm volatile("" : "+v"(tid_));
    const int tid = tid_, lane = tid & 63, w = __builtin_amdgcn_readfirstlane(tid >> 6), lr = lane & 15, lg = lane >> 4;
    const int bh = u >> 5, sc = u & 31, b = bh >> 2, h = bh & 3;
    const int t0 = sc * 256;
    const size_t mbase = (size_t)b * T_ + (size_t)t0;
    GAS unsigned char* ws = (GAS unsigned char*)args.ws; asm volatile("" : "+s"(ws));
    const GAS bf16_t* LQ = (const GAS bf16_t*)(ws + WS_SEG + SEG_LQ) + h * 64; const GAS bf16_t* LK = (const GAS bf16_t*)(ws + WS_SEG + SEG_LK) + h * 64;
    const GAS bf16_t* LV = (const GAS bf16_t*)(ws + WS_SEG + SEG_LV) + h * 128; GAS bf16_t* LO = (GAS bf16_t*)(ws + WS_SEG + SEG_LO) + h * 128;
    const GAS float* SMALL = (const GAS float*)(ws + WS_SMALL);
    GAS float* KVM = (GAS float*)(ws + WS_SCR + SCR_ML_KV) + (size_t)u * (64 * 144); GAS float* MS = (GAS float*)(ws + WS_MISC + MISC_ML_MS) + (size_t)u * 4;
    LAS bf16_t* QW = (LAS bf16_t*)(lds + ML_QW); LAS bf16_t* QR = (LAS bf16_t*)(lds + ML_QR); LAS bf16_t* KS = (LAS bf16_t*)(lds + ML_KS);
    LAS bf16_t* KWT = (LAS bf16_t*)(lds + ML_KWT); LAS bf16_t* VT = (LAS bf16_t*)(lds + ML_VT); LAS bf16_t* ST = (LAS bf16_t*)(lds + ML_ST);
    LAS float* SU = (LAS float*)(lds + ML_SC);
    LAS float* NRM = (LAS float*)(lds + ML_NRM);
    const int ch = tid & 127, tq = tid >> 7;
    float cw[4];
    { const int cidx = (ch < 64) ? (h * 64 + ch) : (256 + h * 64 + (ch - 64)); const float* cwp = args.in[8] + (size_t)l * 4 * 512 + cidx;
#pragma unroll
      for (int j = 0; j < 4; ++j) cw[j] = cwp[j * 512]; }
    const float ib = args.in[9][l * 4 + h], fb = args.in[10][l * 4 + h];
    const int dt = w & 3, eb = (w >> 2) * 4;
    f32x4 S[5];
    float m_prev;
    if (PASS_C) {
        m_prev = MS[2];
#pragma unroll
        for (int k = 0; k < 5; ++k) { const int et = (k < 4) ? (eb + k) : 8;
            if (k < 4 || w < 4) {
#pragma unroll
                for (int r = 0; r < 4; ++r) S[k][r] = KVM[(size_t)(16 * dt + 4 * lg + r) * 144 + 16 * et + lr];
                u32x2 pk; pk.x = cvt_pk_bf16(S[k][0], S[k][1]); pk.y = cvt_pk_bf16(S[k][2], S[k][3]);
                *(LAS u32x2*)(ST + (16 * et + lr) * P64 + 16 * dt + 4 * lg) = pk;
            } else S[k] = (f32x4){0.f, 0.f, 0.f, 0.f}; }
    } else {
        m_prev = -1e30f;
#pragma unroll
        for (int k = 0; k < 5; ++k) S[k] = (f32x4){0.f, 0.f, 0.f, 0.f};
    }
    for (int i = tid; i < 16 * P64; i += NTHREADS) VT[128 * P64 + i] = (i < 64) ? (bf16_t)0x3f80 : (bf16_t)0;
    float bsum = 0.f;
    bf16_t xr[19], vr[16]; float lfr = 0.f, lir = 0.f;
    const GAS bf16_t* srcp = (ch < 64) ? (LQ + ch) : (LK + (ch - 64));
#define ML_FETCH(cn) do { const size_t mr_ = mbase + (size_t)(cn) * 64; \
        _Pragma("unroll") for (int i_ = 0; i_ < 19; ++i_) { const int tt_ = (cn) * 64 + tq * 16 - 3 + i_; xr[i_] = (t0 + tt_ >= 0) ? srcp[(ptrdiff_t)(mbase + tt_) * 256] : (bf16_t)0; } \
        const GAS bf16_t* vp_ = LV + (mr_ + tq * 16) * 512 + ch; \
        _Pragma("unroll") for (int i_ = 0; i_ < 16; ++i_) vr[i_] = vp_[(size_t)i_ * 512]; \
        lfr = SMALL[(mr_ + lane) * 32 + 20 + h]; lir = SMALL[(mr_ + lane) * 32 + 16 + h]; } while (0)
    ML_FETCH(0);
    for (int c = 0; c < 4; ++c) {
        const size_t mrow = mbase + (size_t)c * 64;
        const float lf = ({ const float z = lfr + fb; fminf(z, 0.f) - __logf(1.f + __expf(-fabsf(z))); });
        const float li = lir + ib;
        const float bcum = wave_incl_sum(lf, lane);
        const float uj = li - bcum;
        const float pmax = wave_incl_max(uj, lane);
        const float b_last = __shfl(bcum, 63), pm63 = __shfl(pmax, 63);
        const float gi = fmaxf(m_prev, pmax);
        const float m_new = fmaxf(b_last + m_prev, b_last + pm63);
        const float a_scale = __expf(b_last + m_prev - m_new);
        __syncthreads();
        if (w == 0) { SU[lane] = uj; SU[64 + lane] = gi; SU[128 + lane] = __expf(m_prev - gi); SU[192 + lane] = __expf(-(bcum + gi)); SU[256 + lane] = __expf(b_last + uj - m_new); }
        __syncthreads();
        {
            float xv[19];
#pragma unroll
            for (int i = 0; i < 19; ++i) xv[i] = bf2f(xr[i]);
            unsigned kw[8];
#pragma unroll
            for (int i2 = 0; i2 < 8; ++i2) { float kwv[2];
#pragma unroll
                for (int q2 = 0; q2 < 2; ++q2) { const int i = 2 * i2 + q2, j = tq * 16 + i;
                    const float cv = cw[0] * xv[i] + cw[1] * xv[i + 1] + cw[2] * xv[i + 2] + cw[3] * xv[i + 3];
                    if (ch < 64) { if (PASS_C) { QR[j * P64 + ch] = f2bf(cv); QW[j * P64 + ch] = f2bf(cv * SU[128 + j]); } kwv[q2] = 0.f; }
                    else { const float kv = cv * 0.125f; if (PASS_C) KS[j * P64 + (ch - 64)] = f2bf(kv); kwv[q2] = kv * SU[256 + j]; } }
                kw[i2] = cvt_pk_bf16(kwv[0], kwv[1]); }
            if (ch >= 64) { LAS u32x4* kd = (LAS u32x4*)(KWT + (ch - 64) * P64 + tq * 16); kd[0] = (u32x4){kw[0], kw[1], kw[2], kw[3]}; kd[1] = (u32x4){kw[4], kw[5], kw[6], kw[7]}; }
            unsigned vv[8];
#pragma unroll
            for (int i2 = 0; i2 < 8; ++i2) vv[i2] = (unsigned)vr[2 * i2] | ((unsigned)vr[2 * i2 + 1] << 16);
            LAS u32x4* vd = (LAS u32x4*)(VT + ch * P64 + tq * 16); vd[0] = (u32x4){vv[0], vv[1], vv[2], vv[3]}; vd[1] = (u32x4){vv[4], vv[5], vv[6], vv[7]};
        }
        if (!PASS_C && c < 3) ML_FETCH(c + 1);
        u32x2 graw4[4];
        if (PASS_C) { const int it_ = w >> 1, eh_ = w & 1;
#pragma unroll
            for (int k = 0; k < 4; ++k) graw4[k] = *(const GAS u32x2*)(LO + (mrow + 16 * it_ + lr) * 512 + 64 * eh_ + 16 * k + 4 * lg); }
        __syncthreads();
        if (PASS_C) {
            const int it = w >> 1, eh = w & 1;
            bf16x8 qr[2], qw[2];
#pragma unroll
            for (int ks = 0; ks < 2; ++ks) { qr[ks] = lds16(QR + (16 * it + lr) * P64 + 32 * ks + 8 * lg); qw[ks] = lds16(QW + (16 * it + lr) * P64 + 32 * ks + 8 * lg); }
            const float g_i = SU[64 + 16 * it + lr];
            f32x4 P[4];
            {
                bf16x8 ka[8]; f32x4 u4[4];
#pragma unroll
                for (int jt = 0; jt < 4; ++jt) { u4[jt] = *(const LAS f32x4*)(SU + 16 * jt + 4 * lg);
#pragma unroll
                    for (int ks = 0; ks < 2; ++ks) ka[2 * jt + ks] = lds16(KS + (16 * jt + lr) * P64 + 32 * ks + 8 * lg); }
                __builtin_amdgcn_sched_barrier(0);
#pragma unroll
                for (int jt = 0; jt < 4; ++jt) { P[jt] = (f32x4){0.f, 0.f, 0.f, 0.f};
                    if (jt <= it) {
#pragma unroll
                        for (int ks = 0; ks < 2; ++ks) P[jt] = MFMA16(ka[2 * jt + ks], qr[ks], P[jt]);
#pragma unroll
                        for (int r = 0; r < 4; ++r) { const float f = __expf(u4[jt][r] - g_i); P[jt][r] = (jt == it && 4 * lg + r > lr) ? 0.f : P[jt][r] * f; }
                    } }
            }
            bf16x8 pb[2]; pb[0] = pack8(P[0], P[1]); pb[1] = pack8(P[2], P[3]);
            f32x4 o[5];
            {
                bf16x8 va[10], sa[10];
#pragma unroll
                for (int k = 0; k < 5; ++k) { const int er = (k < 4 ? 64 * eh + 16 * k : 128) + lr;
#pragma unroll
                    for (int s2 = 0; s2 < 2; ++s2) { va[2 * k + s2] = lds8x2(VT + er * P64 + 32 * s2 + 4 * lg, VT + er * P64 + 32 * s2 + 16 + 4 * lg); sa[2 * k + s2] = lds16(ST + er * P64 + 32 * s2 + 8 * lg); } }
                __builtin_amdgcn_sched_barrier(0);
#pragma unroll
                for (int k = 0; k < 5; ++k) { f32x4 a = (f32x4){0.f, 0.f, 0.f, 0.f};
#pragma unroll
                    for (int s2 = 0; s2 < 2; ++s2) a = MFMA16(va[2 * k + s2], pb[s2], a);
#pragma unroll
                    for (int s2 = 0; s2 < 2; ++s2) a = MFMA16(sa[2 * k + s2], qw[s2], a);
                    o[k] = a; }
                __builtin_amdgcn_sched_barrier(0);
            }
            if (c < 3) ML_FETCH(c + 1);
            const float den = __shfl(o[4][0], lr);
            const float rden = 1.f / fmaxf(fabsf(den), SU[192 + 16 * it + lr]);
            float ssq = 0.f;
#pragma unroll
            for (int k = 0; k < 4; ++k) { o[k] = o[k] * rden; ssq += (o[k][0] * o[k][0] + o[k][1] * o[k][1]) + (o[k][2] * o[k][2] + o[k][3] * o[k][3]); }
            ssq += __shfl_xor(ssq, 16); ssq += __shfl_xor(ssq, 32);
            if (lg == 0) NRM[eh * 64 + 16 * it + lr] = ssq;
            __syncthreads();
            const float rstd = rsqrtf((NRM[16 * it + lr] + NRM[64 + 16 * it + lr]) * (1.f / 128.f) + EPS_);
            const float* gn = args.in[11] + (size_t)l * 128;
#pragma unroll
            for (int k = 0; k < 4; ++k) { const int e0 = 64 * eh + 16 * k + 4 * lg; GAS bf16_t* gp = LO + (mrow + 16 * it + lr) * 512 + e0;
                const u32x2 graw = graw4[k]; const f32x4 gnv = *(const GAS f32x4*)(gn + e0);
                const float y0 = o[k][0] * rstd * gnv[0] * fast_sigmoid(bf_lo(graw.x)), y1 = o[k][1] * rstd * gnv[1] * fast_sigmoid(bf_hi(graw.x));
                const float y2 = o[k][2] * rstd * gnv[2] * fast_sigmoid(bf_lo(graw.y)), y3 = o[k][3] * rstd * gnv[3] * fast_sigmoid(bf_hi(graw.y));
                u32x2 yo; yo.x = cvt_pk_bf16(y0, y1); yo.y = cvt_pk_bf16(y2, y3); *(GAS u32x2*)gp = yo; }
        }
        {
#pragma unroll
            for (int k = 0; k < 5; ++k) S[k] = S[k] * a_scale;
            {
                bf16x8 ka[2], vb[10];
#pragma unroll
                for (int s2 = 0; s2 < 2; ++s2) { ka[s2] = lds16(KWT + (16 * dt + lr) * P64 + 32 * s2 + 8 * lg);
#pragma unroll
                    for (int k = 0; k < 5; ++k) { const int et = (k < 4) ? (eb + k) : 8; vb[5 * s2 + k] = lds16(VT + (16 * et + lr) * P64 + 32 * s2 + 8 * lg); } }
                __builtin_amdgcn_sched_barrier(0);
#pragma unroll
                for (int s2 = 0; s2 < 2; ++s2)
#pragma unroll
                    for (int k = 0; k < 5; ++k) if (k < 4 || w < 4) S[k] = MFMA16(ka[s2], vb[5 * s2 + k], S[k]);
                __builtin_amdgcn_sched_barrier(0);
            }
            if (PASS_C) {
#pragma unroll
                for (int k = 0; k < 5; ++k) { const int et = (k < 4) ? (eb + k) : 8;
                    if (k < 4 || w < 4) { u32x2 pk; pk.x = cvt_pk_bf16(S[k][0], S[k][1]); pk.y = cvt_pk_bf16(S[k][2], S[k][3]);
                        *(LAS u32x2*)(ST + (16 * et + lr) * P64 + 16 * dt + 4 * lg) = pk; } }
            }
        }
        m_prev = m_new; bsum += b_last;
    }
    if (!PASS_C) {
#pragma unroll
        for (int k = 0; k < 5; ++k) { const int et = (k < 4) ? (eb + k) : 8;
            if (k < 4 || w < 4) {
#pragma unroll
                for (int r = 0; r < 4; ++r) KVM[(size_t)(16 * dt + 4 * lg + r) * 144 + 16 * et + lr] = S[k][r]; } }
        if (tid == 0) { MS[0] = m_prev; MS[1] = bsum; }
    }
    __syncthreads();
}
__device__ __forceinline__ void ml_scan(const Args& args, int gtid, int gthreads) {
    GAS float* KVM = (GAS float*)(args.ws + WS_SCR + SCR_ML_KV); GAS float* MS = (GAS float*)(args.ws + WS_MISC + MISC_ML_MS);
    for (int idx = gtid; idx < 8 * 9216; idx += gthreads) {
        const int bh = idx / 9216, de = idx % 9216;
        float kv[32], ml[32], Bv[32];
#pragma unroll
        for (int s = 0; s < 32; ++s) { const int u = bh * 32 + s; kv[s] = KVM[(size_t)u * 9216 + de]; ml[s] = MS[u * 4 + 0]; Bv[s] = MS[u * 4 + 1]; }
        float st = 0.f, m = 0.f;
#pragma unroll
        for (int s = 0; s < 32; ++s) { const int u = bh * 32 + s;
            KVM[(size_t)u * 9216 + de] = st; if (de == 0) MS[u * 4 + 2] = m;
            const float mn = fmaxf(Bv[s] + m, ml[s]);
            st = __expf(Bv[s] + m - mn) * st + __expf(ml[s] - mn) * kv[s]; m = mn; }
    }
}
}
namespace mk {
constexpr size_t WS_PO = WS_ACT;
constexpr size_t WS_PML = WS_ACT + 64 * MiB;
constexpr size_t CTL_KMP = 512 * 1024;
constexpr size_t MISC_PAIRS = 1 * MiB;
constexpr size_t MISC_CELL = 1 * MiB + 800 * 1024;
constexpr int CW_MBQ = 1024;
static_assert(WS_PML + 4 * MiB <= WS_SCR + SCR_GLA_KV, "MoBA partials end below the GLA state buffer");
constexpr int MB_NUNITS = 16 * 52;
constexpr int MC_K = 0, MC_KP = 72, MC_VT = 36864, MC_VP = 264, MC_QL = 36864 + 33792, MC_CTL = MC_QL + 32768, MC_END = MC_CTL + 512;

__device__ __forceinline__ void mb_prep_unit(LAS unsigned char* lds, const Args& args, int l, int u, int wv) {
    int tid_ = (wv << 6) | lane_id(); asm volatile("" : "+v"(tid_));
    const int tid = tid_, lane = tid & 63, w = __builtin_amdgcn_readfirstlane(tid >> 6);
    const int b = u >> 7, blk = (u >> 2) & 31, qr = u & 3;
    GAS unsigned char* ws = (GAS unsigned char*)args.ws; asm volatile("" : "+s"(ws));
    GAS bf16_t* MQ = (GAS bf16_t*)(ws + WS_SEG + SEG_MQ); GAS bf16_t* MK = (GAS bf16_t*)(ws + WS_SEG + SEG_MK);
    const GAS float* COS = (const GAS float*)(ws + WS_ROPE); const GAS float* SIN = COS + 8192 * 32;
    GAS float* KMP = (GAS float*)(ws + WS_CTL + CTL_KMP);
    LAS float* RED = (LAS float*)lds;
    const int d0 = (lane & 7) * 8;
    float gq[8], gk[8], ks[8];
#pragma unroll
    for (int k = 0; k < 8; ++k) { gq[k] = args.in[6][l * 64 + d0 + k]; gk[k] = args.in[7][l * 64 + d0 + k]; ks[k] = 0.f; }
    const bool lo = (lane & 4) == 0;
    for (int i = 0; i < 8; ++i) {
        const int t = blk * 256 + qr * 64 + w * 8 + i; const size_t m = (size_t)b * T_ + t;
        const f32x4 c0 = *(const GAS f32x4*)(COS + t * 32 + (d0 & 31)), c1 = *(const GAS f32x4*)(COS + t * 32 + (d0 & 31) + 4);
        const f32x4 s0 = *(const GAS f32x4*)(SIN + t * 32 + (d0 & 31)), s1 = *(const GAS f32x4*)(SIN + t * 32 + (d0 & 31) + 4);
        const float cs[8] = {c0[0], c0[1], c0[2], c0[3], c1[0], c1[1], c1[2], c1[3]}, sn[8] = {s0[0], s0[1], s0[2], s0[3], s1[0], s1[1], s1[2], s1[3]};
#pragma unroll
        for (int which = 0; which < 2; ++which) {
            GAS bf16_t* p = (which ? MK : MQ) + m * 512 + 8 * lane;
            const u32x4 raw = *(const GAS u32x4*)p;
            float x[8] = {bf_lo(raw.x), bf_hi(raw.x), bf_lo(raw.y), bf_hi(raw.y), bf_lo(raw.z), bf_hi(raw.z), bf_lo(raw.w), bf_hi(raw.w)};
            float ss = 0.f;
#pragma unroll
            for (int k = 0; k < 8; ++k) ss += x[k] * x[k];
            ss += __shfl_xor(ss, 1); ss += __shfl_xor(ss, 2); ss += __shfl_xor(ss, 4);
            const float r = rsqrtf(ss * (1.f / 64.f) + EPS_);
            float y[8];
#pragma unroll
            for (int k = 0; k < 8; ++k) { const float v = x[k] * r * (which ? gk[k] : gq[k]); const float other = __shfl_xor(v, 4);
                y[k] = lo ? (v * cs[k] - other * sn[k]) : (v * cs[k] + other * sn[k]); }
            u32x4 o; o.x = cvt_pk_bf16(y[0], y[1]); o.y = cvt_pk_bf16(y[2], y[3]); o.z = cvt_pk_bf16(y[4], y[5]); o.w = cvt_pk_bf16(y[6], y[7]);
            *(GAS u32x4*)p = o;
            if (which) {
#pragma unroll
                for (int k = 0; k < 8; ++k) ks[k] += y[k]; }
        }
    }
    __syncthreads();
#pragma unroll
    for (int k = 0; k < 8; ++k) RED[w * 512 + 8 * lane + k] = ks[k];
    __syncthreads();
    { float s = 0.f;
#pragma unroll
      for (int ww = 0; ww < 8; ++ww) s += RED[ww * 512 + tid];
      KMP[((size_t)(b * 32 + blk) * 4 + qr) * 512 + tid] = s; }
    __syncthreads();
}

__device__ __forceinline__ void mb_topk_unit(LAS unsigned char* lds, const Args& args, int u, int wv) {
    int tid_ = (wv << 6) | lane_id(); asm volatile("" : "+v"(tid_));
    const int tid = tid_, lane = tid & 63;
    const int b = u >> 7, i = (u >> 2) & 31, hp = u & 3;
    const int hh = tid >> 8, head = 2 * hp + hh, tq = tid & 255, w4 = (tid >> 6) & 3;
    GAS unsigned char* ws = (GAS unsigned char*)args.ws; asm volatile("" : "+s"(ws));
    const GAS bf16_t* QN = (const GAS bf16_t*)(ws + WS_SEG + SEG_MQ);
    const GAS float* KMP = (const GAS float*)(ws + WS_CTL + CTL_KMP);
    GAS bf16_t* PAIRS = (GAS bf16_t*)(ws + WS_MISC + MISC_PAIRS) + ((size_t)(b * 8 + head) * 32 + i) * 768;
    GAS bf16_t* CELL = (GAS bf16_t*)(ws + WS_MISC + MISC_CELL) + ((size_t)(b * 8 + head) * 32 + i) * 34;
    LAS float* KMS = (LAS float*)lds;
    LAS unsigned* CNT = (LAS unsigned*)(lds + 16384);
    LAS unsigned* CO = (LAS unsigned*)(lds + 16384 + 1024);
    __syncthreads();
#pragma unroll
    for (int k = 0; k < 8; ++k) { const int e = tid + 512 * k, hx = e >> 11, jj = (e >> 6) & 31, dd = e & 63;
        const GAS float* kp = KMP + (size_t)(b * 32 + jj) * 2048 + (2 * hp + hx) * 64 + dd;
        KMS[e] = ((kp[0] + kp[512]) + (kp[1024] + kp[1536])) * (1.f / 256.f); }
    if (tid < 256) CNT[tid] = 0u;
    float q[64];
    { const GAS bf16_t* qp = QN + ((size_t)b * T_ + i * 256 + tq) * 512 + head * 64;
#pragma unroll
      for (int c = 0; c < 8; ++c) { const u32x4 raw = *(const GAS u32x4*)(qp + 8 * c);
          q[8 * c] = bf_lo(raw.x); q[8 * c + 1] = bf_hi(raw.x); q[8 * c + 2] = bf_lo(raw.y); q[8 * c + 3] = bf_hi(raw.y);
          q[8 * c + 4] = bf_lo(raw.z); q[8 * c + 5] = bf_hi(raw.z); q[8 * c + 6] = bf_lo(raw.w); q[8 * c + 7] = bf_hi(raw.w); } }
    __syncthreads();
    float v0 = -INFINITY, v1 = -INFINITY, v2 = -INFINITY; int j0 = -1, j1 = -1, j2 = -1;
    for (int j = 0; j < i; ++j) {
        const LAS f32x4* kp = (const LAS f32x4*)(KMS + (hh * 32 + j) * 64); float s = 0.f;
#pragma unroll
        for (int c = 0; c < 16; ++c) { const f32x4 k4 = kp[c]; s += q[4 * c] * k4[0] + q[4 * c + 1] * k4[1] + q[4 * c + 2] * k4[2] + q[4 * c + 3] * k4[3]; }
        if (s > v2) { if (s > v1) { v2 = v1; j2 = j1; if (s > v0) { v1 = v0; j1 = j0; v0 = s; j0 = j; } else { v1 = s; j1 = j; } } else { v2 = s; j2 = j; } }
    }
    int rk0 = 0, rk1 = 0, rk2 = 0;
    for (int j = 0; j < i; ++j) {
        const bool pr = (j0 == j) || (j1 == j) || (j2 == j);
        const unsigned long long mask = __ballot(pr);
        const int rank = __popcll(mask & ((1ull << lane) - 1ull));
        if (j0 == j) rk0 = rank; if (j1 == j) rk1 = rank; if (j2 == j) rk2 = rank;
        if (lane == 0) CNT[(hh * 4 + w4) * 32 + j] = (unsigned)__popcll(mask);
    }
    __syncthreads();
    if (tid < 2) { unsigned run = 0u;
        for (int j = 0; j < 32; ++j) { CO[tid * 34 + j] = run; run += CNT[(tid * 4 + 0) * 32 + j] + CNT[(tid * 4 + 1) * 32 + j] + CNT[(tid * 4 + 2) * 32 + j] + CNT[(tid * 4 + 3) * 32 + j]; }
        CO[tid * 34 + 32] = run; }
    __syncthreads();
#define MB_EMIT(jj, rk, slot) do { if ((jj) >= 0) { unsigned pos = CO[hh * 34 + (jj)] + (rk); \
        for (int ww = 0; ww < 4; ++ww) pos += (ww < w4) ? CNT[(hh * 4 + ww) * 32 + (jj)] : 0u; \
        PAIRS[pos] = (bf16_t)(tq | ((slot) << 8)); } } while (0)
    MB_EMIT(j0, rk0, 0); MB_EMIT(j1, rk1, 1); MB_EMIT(j2, rk2, 2);
#undef MB_EMIT
    if (tq < 33) CELL[tq] = (bf16_t)CO[hh * 34 + tq];
    __syncthreads();
}

#ifndef PROBE_MASK
#define PROBE_MASK 0u
#endif
#ifndef PROBE_K
#define PROBE_K 2
#endif
#define PBU_BEGIN(x) unsigned long long pbu_t0_##x = 0ull; if ((PROBE_MASK >> (x)) & 1u) pbu_t0_##x = __builtin_amdgcn_s_memrealtime()
#define PBU_END(x) do { if ((PROBE_MASK >> (x)) & 1u) { const unsigned long long t1_ = __builtin_amdgcn_s_memrealtime(); const unsigned long long until_ = t1_ + (unsigned long long)PROBE_K * (t1_ - pbu_t0_##x); \
    while (__builtin_amdgcn_s_memrealtime() < until_) __builtin_amdgcn_s_sleep(8); } } while (0)
__device__ __forceinline__ float vmax3(float a, float b, float c) { float r; asm("v_max3_f32 %0, %1, %2, %3" : "=v"(r) : "v"(a), "v"(b), "v"(c)); return r; }
__device__ __forceinline__ void mb_attn_unit(LAS unsigned char* lds, const Args& args, int q, int wv) {
    int tid_ = (wv << 6) | lane_id(); asm volatile("" : "+v"(tid_));
    const int tid = tid_, lane = tid & 63, w = __builtin_amdgcn_readfirstlane(tid >> 6), lr = lane & 15, lg = lane >> 4;
    const int bh = q & 15, rr = q >> 4, b = bh >> 3, h = bh & 7;
    int j, part, np;
    if (rr < 16) { j = rr >> 2; part = rr & 3; np = 4; } else if (rr < 32) { j = 4 + ((rr - 16) >> 1); part = (rr - 16) & 1; np = 2; } else { j = 12 + (rr - 32); part = 0; np = 1; }
    GAS unsigned char* ws = (GAS unsigned char*)args.ws; asm volatile("" : "+s"(ws));
    const GAS bf16_t* QN = (const GAS bf16_t*)(ws + WS_SEG + SEG_MQ) + h * 64; const GAS bf16_t* KN = (const GAS bf16_t*)(ws + WS_SEG + SEG_MK) + h * 64; const GAS bf16_t* MV = (const GAS bf16_t*)(ws + WS_SEG + SEG_MV) + h * 64;
    const GAS bf16_t* PAIRS = (const GAS bf16_t*)(ws + WS_MISC + MISC_PAIRS) + (size_t)bh * 32 * 768; const GAS bf16_t* CELL = (const GAS bf16_t*)(ws + WS_MISC + MISC_CELL) + (size_t)bh * 32 * 34;
    GAS bf16_t* PO = (GAS bf16_t*)(ws + WS_PO); GAS float* PML = (GAS float*)(ws + WS_PML);
    LAS bf16_t* KJ = (LAS bf16_t*)(lds + MC_K); LAS bf16_t* VT = (LAS bf16_t*)(lds + MC_VT); LAS unsigned* QL = (LAS unsigned*)(lds + MC_QL); LAS unsigned* CT = (LAS unsigned*)(lds + MC_CTL);
    const size_t krow0 = (size_t)b * T_ + (size_t)j * 256;
    PBU_BEGIN(16);
    __syncthreads();
#pragma unroll
    for (int k = 0; k < 4; ++k) { const int id = tid + 512 * k, row = id >> 3, c8 = id & 7;
        *(LAS u32x4*)(KJ + row * MC_KP + 8 * c8) = *(const GAS u32x4*)(KN + (krow0 + row) * 512 + 8 * c8);
        const u32x4 vr = *(const GAS u32x4*)(MV + (krow0 + row) * 512 + 8 * c8);
        LAS bf16_t* vt = VT + (8 * c8) * MC_VP + row;
        vt[0 * MC_VP] = (bf16_t)(vr.x & 0xffffu); vt[1 * MC_VP] = (bf16_t)(vr.x >> 16); vt[2 * MC_VP] = (bf16_t)(vr.y & 0xffffu); vt[3 * MC_VP] = (bf16_t)(vr.y >> 16);
        vt[4 * MC_VP] = (bf16_t)(vr.z & 0xffffu); vt[5 * MC_VP] = (bf16_t)(vr.z >> 16); vt[6 * MC_VP] = (bf16_t)(vr.w & 0xffffu); vt[7 * MC_VP] = (bf16_t)(vr.w >> 16); }
    if (tid < 256) QL[tid] = (unsigned)(j * 256 + tid) | (3u << 13);
    if (tid < 64) { const int i = tid & 31; unsigned c0 = 0u, cnt = 0u;
        if (i > j) { c0 = CELL[i * 34 + j]; cnt = (unsigned)CELL[i * 34 + j + 1] - c0; }
        unsigned inc = cnt;
#pragma unroll
        for (int o = 1; o < 32; o <<= 1) { const unsigned v = __shfl_up(inc, o); if ((tid & 31) >= o) inc += v; }
        if (tid < 32) { CT[i] = 256u + inc - cnt; CT[33 + i] = c0; CT[66 + i] = cnt; if (i == 31) CT[32] = 256u + inc; } }
    __syncthreads();
    for (int i = j + 1 + w; i < 32; i += 8) { const unsigned c0 = CT[33 + i], cnt = CT[66 + i], dst = CT[i];
        for (unsigned e = lane; e < cnt; e += 64) { const unsigned pr = PAIRS[(size_t)i * 768 + c0 + e]; QL[dst + e] = (unsigned)(i * 256 + (pr & 255u)) | ((pr >> 8) << 13); } }
    __syncthreads();
    PBU_END(16);
    PBU_BEGIN(17);
    const int n = (int)CT[32], nitems = (n + 15) >> 4;
    unsigned ent_n = 0u; bf16x8 qn0 = {0, 0, 0, 0, 0, 0, 0, 0}, qn1 = {0, 0, 0, 0, 0, 0, 0, 0}; bool valid_n = false;
    { const int item0 = part + np * w; if (item0 < nitems) { const int e0 = item0 * 16 + lr; valid_n = e0 < n; ent_n = QL[valid_n ? e0 : 0];
        const GAS bf16_t* qp = QN + ((size_t)b * T_ + (ent_n & 8191u)) * 512 + 8 * lg; qn0 = *(const GAS bf16x8*)qp; qn1 = *(const GAS bf16x8*)(qp + 32); } }
    for (int item = part + np * w; item < nitems; item += np * 8) {
        const bool valid = valid_n; const unsigned ent = ent_n;
        const int tok = (int)(ent & 8191u), slot = (int)((ent >> 13) & 3u); const bool own = slot == 3; const int qpos = tok & 255;
        const size_t m = (size_t)b * T_ + tok;
        bf16x8 qb[2]; qb[0] = qn0; qb[1] = qn1;
        { const int itn = item + np * 8; if (itn < nitems) { const int e1 = itn * 16 + lr; valid_n = e1 < n; ent_n = QL[valid_n ? e1 : 0];
            const GAS bf16_t* qp = QN + ((size_t)b * T_ + (ent_n & 8191u)) * 512 + 8 * lg; qn0 = *(const GAS bf16x8*)qp; qn1 = *(const GAS bf16x8*)(qp + 32); } }
        f32x4 sc[16];
#pragma unroll
        for (int g = 0; g < 4; ++g) {
            bf16x8 ka[8];
#pragma unroll
            for (int k4 = 0; k4 < 4; ++k4)
#pragma unroll
                for (int ks = 0; ks < 2; ++ks) ka[2 * k4 + ks] = lds16(KJ + (16 * (4 * g + k4) + lr) * MC_KP + 32 * ks + 8 * lg);
            __builtin_amdgcn_sched_barrier(0);
#pragma unroll
            for (int k4 = 0; k4 < 4; ++k4) { f32x4 a = (f32x4){0.f, 0.f, 0.f, 0.f}; a = MFMA16(ka[2 * k4], qb[0], a); sc[4 * g + k4] = MFMA16(ka[2 * k4 + 1], qb[1], a); }
            __builtin_amdgcn_sched_barrier(0);
        }
        if (item < 16) {
#pragma unroll
            for (int kt = 0; kt < 16; ++kt)
#pragma unroll
                for (int r = 0; r < 4; ++r) if ((16 * kt + 4 * lg + r) > qpos) sc[kt][r] = -1e30f; }
        float mx = -1e30f;
#pragma unroll
        for (int kt = 0; kt < 16; ++kt) { mx = vmax3(mx, sc[kt][0], sc[kt][1]); mx = vmax3(mx, sc[kt][2], sc[kt][3]); }
        mx = fmaxf(mx, __shfl_xor(mx, 16)); mx = fmaxf(mx, __shfl_xor(mx, 32));
        const float cexp = 0.18033688011112042f, mneg = -mx * cexp;
        const f32x2 c2 = {cexp, cexp}, m2 = {mneg, mneg};
        f32x2 ls2 = {0.f, 0.f};
#pragma unroll
        for (int kt = 0; kt < 16; ++kt)
#pragma unroll
            for (int hlf = 0; hlf < 2; ++hlf) { f32x2 t = {sc[kt][2 * hlf], sc[kt][2 * hlf + 1]}; t = t * c2 + m2;
                t.x = __builtin_amdgcn_exp2f(t.x); t.y = __builtin_amdgcn_exp2f(t.y); ls2 = ls2 + t; sc[kt][2 * hlf] = t.x; sc[kt][2 * hlf + 1] = t.y; }
        float lsum = ls2.x + ls2.y;
        lsum += __shfl_xor(lsum, 16); lsum += __shfl_xor(lsum, 32);
        mx *= 0.125f;
        f32x4 o[4];
#pragma unroll
        for (int dv = 0; dv < 4; ++dv) o[dv] = (f32x4){0.f, 0.f, 0.f, 0.f};
#pragma unroll
        for (int g = 0; g < 4; ++g) {
            bf16x8 va[8];
#pragma unroll
            for (int s = 0; s < 2; ++s)
#pragma unroll
                for (int dv = 0; dv < 4; ++dv) { const LAS bf16_t* vp = VT + (16 * dv + lr) * MC_VP + 32 * (2 * g + s) + 4 * lg; va[4 * s + dv] = lds8x2(vp, vp + 16); }
            const bf16x8 pb0 = pack8(sc[4 * g], sc[4 * g + 1]), pb1 = pack8(sc[4 * g + 2], sc[4 * g + 3]);
            __builtin_amdgcn_sched_barrier(0);
#pragma unroll
            for (int dv = 0; dv < 4; ++dv) { o[dv] = MFMA16(va[dv], pb0, o[dv]); o[dv] = MFMA16(va[4 + dv], pb1, o[dv]); }
            __builtin_amdgcn_sched_barrier(0);
        }
        const float inv = 1.f / lsum;
        if (valid) { const size_t pbase = ((m * 8 + h) * 4 + slot);
#pragma unroll
            for (int dv = 0; dv < 4; ++dv) { u32x2 pk; pk.x = cvt_pk_bf16(o[dv][0] * inv, o[dv][1] * inv); pk.y = cvt_pk_bf16(o[dv][2] * inv, o[dv][3] * inv);
                *(GAS u32x2*)(PO + pbase * 64 + 16 * dv + 4 * lg) = pk; }
            if (lg == 0) { f32x2 ml; ml.x = mx; ml.y = lsum; *(GAS f32x2*)(PML + pbase * 2) = ml; } }
    }
    PBU_END(17);
    __syncthreads();
}

__device__ __forceinline__ void mb_combine(const Args& args, int gtid, int gthreads) {
    GAS unsigned char* ws = (GAS unsigned char*)args.ws; asm volatile("" : "+s"(ws));
    const GAS bf16_t* PO = (const GAS bf16_t*)(ws + WS_PO); const GAS float* PML = (const GAS float*)(ws + WS_PML); GAS bf16_t* Y = (GAS bf16_t*)(ws + WS_SEG + SEG_MQ);
    for (int idx = gtid; idx < M_ * 8 * 8; idx += gthreads) {
        const int mh = idx >> 3, c8 = idx & 7, m = mh >> 3, h = mh & 7, t = m & (T_ - 1), ib = t >> 8; const int nv = ib < 3 ? ib : 3;
        const size_t base = (size_t)mh * 4;
        float ms[4], ls[4];
#pragma unroll
        for (int s = 0; s < 4; ++s) { const bool on = (s == 3) || (s < nv); const f32x2 ml = on ? *(const GAS f32x2*)(PML + (base + s) * 2) : (f32x2){-1e30f, 0.f}; ms[s] = ml.x; ls[s] = ml.y; }
        const float Mx = fmaxf(fmaxf(ms[0], ms[1]), fmaxf(ms[2], ms[3]));
        float acc[8] = {0.f, 0.f, 0.f, 0.f, 0.f, 0.f, 0.f, 0.f}; float W = 0.f;
#pragma unroll
        for (int s = 0; s < 4; ++s) { const bool on = (s == 3) || (s < nv);
            if (on) { const float wgt = ls[s] * __expf(ms[s] - Mx); W += wgt; const u32x4 raw = *(const GAS u32x4*)(PO + (base + s) * 64 + 8 * c8);
                acc[0] += wgt * bf_lo(raw.x); acc[1] += wgt * bf_hi(raw.x); acc[2] += wgt * bf_lo(raw.y); acc[3] += wgt * bf_hi(raw.y);
                acc[4] += wgt * bf_lo(raw.z); acc[5] += wgt * bf_hi(raw.z); acc[6] += wgt * bf_lo(raw.w); acc[7] += wgt * bf_hi(raw.w); } }
        const float iw = 1.f / W;
        u32x4 o; o.x = cvt_pk_bf16(acc[0] * iw, acc[1] * iw); o.y = cvt_pk_bf16(acc[2] * iw, acc[3] * iw); o.z = cvt_pk_bf16(acc[4] * iw, acc[5] * iw); o.w = cvt_pk_bf16(acc[6] * iw, acc[7] * iw);
        *(GAS u32x4*)(Y + (size_t)m * 512 + h * 64 + 8 * c8) = o;
    }
}
}
namespace mk {
constexpr int PH_PRO = 0, PH_PER_LAYER = 9, PH_WIN = 0, PH_MIXA = 1, PH_MIXB = 2, PH_MIXC = 3, PH_MIXD = 4, PH_BRANCH = 5, PH_WOUT = 6, PH_FF1 = 7, PH_FF2 = 8;
constexpr int PH_TOTAL = 1 + PH_PER_LAYER * DEPTH_;

#ifndef PROBE_MASK
#define PROBE_MASK 0u
#endif
#ifndef PROBE_K
#define PROBE_K 2
#endif
#define PB_BEGIN(x) unsigned long long pb_t0_##x = 0ull; if ((PROBE_MASK >> (x)) & 1u) pb_t0_##x = __builtin_amdgcn_s_memrealtime()
#define PB_END(x) do { if ((PROBE_MASK >> (x)) & 1u) { const unsigned long long t1_ = __builtin_amdgcn_s_memrealtime(); const unsigned long long until_ = t1_ + (unsigned long long)PROBE_K * (t1_ - pb_t0_##x); \
    while (__builtin_amdgcn_s_memrealtime() < until_) __builtin_amdgcn_s_sleep(8); } } while (0)
__global__ void __launch_bounds__(NTHREADS, 2) mk_fwd(Args args) {
    extern __shared__ __attribute__((aligned(16))) unsigned char lds_raw[];
    Frame F;
    F.lds = (LAS unsigned char*)lds_raw;
    F.MISC = (volatile LAS unsigned*)(F.lds + MISC_OFF);
    F.tid = threadIdx.x; F.lane = F.tid & 63; F.wave = __builtin_amdgcn_readfirstlane(F.tid >> 6);
    F.G = gridDim.x; { const int bx = blockIdx.x; F.vcu = (F.G % 8 == 0) ? (bx % 8) * (F.G / 8) + bx / 8 : bx; }
    F.ws = args.ws; F.ctl = (gu32*)(args.ws + WS_CTL);
    for (int u = F.tid; u < (LDS_BYTES - RING_BYTES) / 4; u += NTHREADS) ((LAS unsigned*)(F.lds + RING_BYTES))[u] = 0u;
    __syncthreads();
    XcdBarrier bar = xcd_barrier_post((unsigned*)(F.ctl + CW_BAR) + args.li * XCD_BAR_WORDS, F.MISC + 8);
    const int lo = args.ph_lo, hi = args.ph_hi;
    const int wv = F.wave;
#define IN(k) (lo <= (k) && (k) < hi)
#define SEAM(k) do { if (IN((k) + 1)) { XcdBarrier bq = bar; asm volatile("" : "+s"(bq.bar)); const bool ld_ = ((wv << 6) | lane_id()) == 0; xcd_barrier(bq, ld_); if (PROBE_MASK & 0x40000u) { xcd_barrier(bq, ld_); xcd_barrier(bq, ld_); } } } while (0)
#define OPQ_WS unsigned char* wsq = args.ws; int bxq = blockIdx.x, Gq = gridDim.x, tidq = (wv << 6) | lane_id(); \
    asm volatile("" : "+s"(wsq), "+s"(bxq), "+s"(Gq), "+v"(tidq)); \
    const int vcuq = (Gq % 8 == 0) ? (bxq % 8) * (Gq / 8) + bxq / 8 : bxq; (void)vcuq; (void)tidq
#define WSP(T, off) ((T*)(wsq + (off)))
#define WL(T, off) ((const T*)(wsq + WS_WTS + (size_t)l * WL_STRIDE + (off)))

    if (IN(PH_PRO)) { PB_BEGIN(0); p0_prologue(F, args, 0, DEPTH_, true); PB_END(0); SEAM(PH_PRO); }

    for (int l = 0; l < DEPTH_; ++l) {
        const int pb = 1 + PH_PER_LAYER * l;
        if (hi <= pb || lo >= pb + PH_PER_LAYER) continue;

        if (IN(pb + PH_WIN)) { OPQ_WS; PB_BEGIN(1);
            pg8::Gemm g{WSP(bf16_t, WS_ACT), WL(bf16_t, WL_WIN)}; pg8::StaticOrder<33> S; S.init(Gq, bxq);
            EpiWin E{WSP(bf16_t, WS_SEG), WSP(float, WS_SMALL), WSP(float, WS_SS)};
            pg8::gemm_phase<1024, EpiWin, pg8::StaticOrder<33>, true, true>(F.lds, g, S, E, wv);
            PB_END(1); SEAM(pb + PH_WIN);
        }
        if (IN(pb + PH_MIXA)) { OPQ_WS; PB_BEGIN(2);
            { PB_BEGIN(10); if (args.mix & 1) for (int u = vcuq; u < 256; u += Gq) gla_unit<false>(F.lds, args, l, u, wv); PB_END(10); }
            { PB_BEGIN(11); if (args.mix & 2) for (int u = vcuq; u < 256; u += Gq) ml_unit<false>(F.lds, args, l, u, wv); PB_END(11); }
            { PB_BEGIN(12); if (args.mix & 4) for (int u = vcuq; u < 256; u += Gq) mb_prep_unit(F.lds, args, l, u, wv); PB_END(12); }
            PB_END(2); SEAM(pb + PH_MIXA); }
        if (IN(pb + PH_MIXB)) { OPQ_WS; PB_BEGIN(3);
            if (args.mix & 1) gla_scan(args, vcuq * NTHREADS + tidq, Gq * NTHREADS);
            if (args.mix & 2) ml_scan(args, vcuq * NTHREADS + tidq, Gq * NTHREADS);
            if (args.mix & 4) for (int u = vcuq; u < 256; u += Gq) mb_topk_unit(F.lds, args, u, wv);
            PB_END(3); SEAM(pb + PH_MIXB); }
        if (IN(pb + PH_MIXC)) { OPQ_WS; PB_BEGIN(4);
            { PB_BEGIN(13); if (args.mix & 1) for (int u = vcuq; u < 256; u += Gq) gla_unit<true>(F.lds, args, l, u, wv); PB_END(13); }
            { PB_BEGIN(14); if (args.mix & 2) for (int u = vcuq; u < 256; u += Gq) ml_unit<true>(F.lds, args, l, u, wv); PB_END(14); }
            if (args.mix & 4) { PB_BEGIN(15);
                for (;;) {
                    if (tidq == 0) F.MISC[16] = __hip_atomic_fetch_add((unsigned*)((gu32*)wsq + CW_MBQ + 64 * l), 1u, __ATOMIC_RELAXED, __HIP_MEMORY_SCOPE_AGENT);
                    __syncthreads();
                    const int q = (int)F.MISC[16];
                    if (q >= MB_NUNITS) break;
                    mb_attn_unit(F.lds, args, q, wv);
                }
                PB_END(15);
            }
            PB_END(4); SEAM(pb + PH_MIXC); }
        if (IN(pb + PH_MIXD)) { OPQ_WS; PB_BEGIN(5);
            if (args.mix & 4) mb_combine(args, vcuq * NTHREADS + tidq, Gq * NTHREADS);
            PB_END(5); SEAM(pb + PH_MIXD); }
        if (IN(pb + PH_BRANCH)) { OPQ_WS; PB_BEGIN(6);
            static_assert(SEG_MQ - SEG_GG == 16 * MiB && SEG_LO - SEG_MQ == 16 * MiB, "y buffers equally spaced");
            typedef pg8::ZOrder<4, 3, 16 * MiB, 1 * MiB> BrOrder;
            pg8::Gemm g{WSP(bf16_t, WS_SEG + SEG_GG), WL(bf16_t, WL_WBR)}; BrOrder S; S.init(Gq, bxq);
            EpiBranch E{WSP(bf16_t, WS_SEG + SEG_BG), args.in[12] + (size_t)l * 3072, WSP(bf16_t, WS_MIXB)};
            pg8::gemm_phase<512, EpiBranch, BrOrder, true, true>(F.lds, g, S, E, wv);
            PB_END(6); SEAM(pb + PH_BRANCH);
        }
        if (IN(pb + PH_WOUT)) { OPQ_WS; PB_BEGIN(7);
            pg8::Gemm g{WSP(bf16_t, WS_MIXB), WL(bf16_t, WL_WOUT)}; pg8::StaticOrder<4> S; S.init(Gq, bxq);
            EpiRes<false> E{l == 0 ? args.in[0] : args.out, args.out, WSP(bf16_t, WS_ACT), WSP(float, WS_SS), args.in[17] + (size_t)l * 1024};
            pg8::gemm_phase<1024, EpiRes<false>, pg8::StaticOrder<4>, false, true>(F.lds, g, S, E, wv);
            PB_END(7); SEAM(pb + PH_WOUT);
        }
        if (IN(pb + PH_FF1)) { OPQ_WS; PB_BEGIN(8);
            pg8::Gemm g{WSP(bf16_t, WS_ACT), WL(bf16_t, WL_FF1)}; pg8::StaticOrder<16> S; S.init(Gq, bxq);
            EpiFf1 E{WSP(bf16_t, WS_H), WSP(float, WS_SS)};
            pg8::gemm_phase<1024, EpiFf1, pg8::StaticOrder<16>, true, true>(F.lds, g, S, E, wv);
            PB_END(8); SEAM(pb + PH_FF1);
        }
        if (IN(pb + PH_FF2)) { OPQ_WS; PB_BEGIN(9);
            pg8::Gemm g{WSP(bf16_t, WS_H), WL(bf16_t, WL_FF2)}; pg8::StaticOrder<4> S; S.init(Gq, bxq);
            if (l < DEPTH_ - 1) { EpiRes<false> E{args.out, args.out, WSP(bf16_t, WS_ACT), WSP(float, WS_SS), args.in[1] + (size_t)(l + 1) * 1024};
                pg8::gemm_phase<4096, EpiRes<false>, pg8::StaticOrder<4>, false, true>(F.lds, g, S, E, wv); }
            else { EpiRes<true> E{args.out, args.out, WSP(bf16_t, WS_ACT), WSP(float, WS_SS), args.in[1]};
                pg8::gemm_phase<4096, EpiRes<true>, pg8::StaticOrder<4>, false, true>(F.lds, g, S, E, wv); }
            PB_END(9); SEAM(pb + PH_FF2);
        }
    }
#undef IN
#undef SEAM
#undef WSP
#undef WL
#undef OPQ_WS
}

static int g_grid = 0;
static bool mk_setup() {
    if (g_grid) return g_grid > 0;
    int dev = 0, cus = 0;
    if (hipGetDevice(&dev) != hipSuccess || hipDeviceGetAttribute(&cus, hipDeviceAttributeMultiprocessorCount, dev) != hipSuccess) { g_grid = -1; return false; }
    if (hipFuncSetAttribute((const void*)mk_fwd, hipFuncAttributeMaxDynamicSharedMemorySize, LDS_BYTES) != hipSuccess) { fprintf(stderr, "mk: hipFuncSetAttribute failed\n"); g_grid = -1; return false; }
    (void)hipGetLastError();
    g_grid = cus;
    return true;
}
static void mk_launch(const Args& base, int lo, int hi, int li, hipStream_t st) {
    Args a = base; a.ph_lo = lo; a.ph_hi = hi; a.li = li;
    hipLaunchKernelGGL(mk_fwd, dim3(g_grid), dim3(NTHREADS), LDS_BYTES, st, a);
}
}
extern "C" void kernel_launch(void* const* d_in, const int* in_sizes, int n_in, void* d_out, int out_size, void* d_ws, size_t ws_size, hipStream_t stream) {
    using namespace mk;
    if (n_in != 20 || out_size != M_ * D_ || ws_size < WS_END) { fprintf(stderr, "kernel_launch: unexpected shapes (n_in %d out %d ws %zu)\n", n_in, out_size, ws_size); return; }
    if (!mk_setup()) return;
    unsigned char* ws = (unsigned char*)d_ws;
    (void)hipMemsetAsync(ws + WS_CTL, 0, CTL_ZERO_BYTES, stream);
    Args a{}; for (int i = 0; i < 20; ++i) a.in[i] = (const float*)d_in[i]; a.out = (float*)d_out; a.ws = ws; a.mix = 7;
    mk_launch(a, 0, PH_TOTAL, 0, stream);
}
```

```cpp
#define PROBE_MASK 0x0u
#include <hip/hip_runtime.h>
#include <cstdio>
#include <cstdint>
#include <cmath>
#define LAS __attribute__((address_space(3)))
#define GAS __attribute__((address_space(1)))
typedef unsigned short bf16_t;
typedef short bf16x8 __attribute__((ext_vector_type(8)));
typedef short bf16x4 __attribute__((ext_vector_type(4)));
typedef float f32x4 __attribute__((ext_vector_type(4)));
typedef float f32x2 __attribute__((ext_vector_type(2)));
typedef unsigned u32x4 __attribute__((ext_vector_type(4)));
typedef unsigned u32x2 __attribute__((ext_vector_type(2)));
typedef GAS unsigned gu32;
#define RLX_AGENT __ATOMIC_RELAXED, __HIP_MEMORY_SCOPE_AGENT
#define LDS_WAIT() asm volatile("s_waitcnt lgkmcnt(0)" ::: "memory")
#define VM_WAIT() asm volatile("s_waitcnt vmcnt(0)" ::: "memory")

__device__ __forceinline__ unsigned cvt_pk_bf16(float lo, float hi) { unsigned r; asm volatile("v_cvt_pk_bf16_f32 %0, %1, %2" : "=v"(r) : "v"(lo), "v"(hi)); return r; }
__device__ __forceinline__ float bf_lo(unsigned u) { return __uint_as_float(u << 16); }
__device__ __forceinline__ float bf_hi(unsigned u) { return __uint_as_float(u & 0xffff0000u); }
__device__ __forceinline__ float bf2f(bf16_t h) { return __uint_as_float(((unsigned)h) << 16); }
__device__ __forceinline__ bf16_t f2bf(float f) { return (bf16_t)(cvt_pk_bf16(f, 0.f) & 0xffffu); }
__device__ __forceinline__ float wave_sum(float v) {
#pragma unroll
    for (int o = 1; o < 64; o <<= 1) v += __shfl_xor(v, o);
    return v;
}
__device__ __forceinline__ void st16_wt(void* p, u32x4 v) { asm volatile("global_store_dwordx4 %0, %1, off sc1\n\ts_nop 1" :: "v"(p), "v"(v) : "memory"); }
__device__ __forceinline__ void st8_wt(void* p, u32x2 v) { asm volatile("global_store_dwordx2 %0, %1, off sc1\n\ts_nop 1" :: "v"(p), "v"(v) : "memory"); }
__device__ __forceinline__ int lane_id() { int l; asm volatile("v_mbcnt_lo_u32_b32 %0, -1, 0\n\tv_mbcnt_hi_u32_b32 %0, -1, %0" : "=v"(l)); return l; }
__device__ __forceinline__ float fast_sigmoid(float x) { return 1.f / (1.f + __expf(-x)); }

namespace pg8 {
constexpr int BM = 256, BK = 64, HALF = 128, HTB = HALF * BK * 2, STAGE_BYTES = 8 * HTB, NXCD = 8, WGM = 8;
__host__ __device__ __forceinline__ int lds_byte(int r, int c) { const int st = (r >> 4) * 2 + (c >> 5), rr = r & 15, cc = c & 31, ob = rr * 64 + cc * 2; return st * 1024 + (ob ^ (((ob >> 9) & 1) << 5)); }
__host__ __device__ __forceinline__ void stage_rc(int b, int& R, int& C) { const int st = b / 1024, sb = b % 1024, swz = sb ^ (((sb >> 9) & 1) << 5); R = (st >> 1) * 16 + swz / 64; C = (st & 1) * 32 + (swz % 64) / 2; }
__host__ __device__ __forceinline__ int perm32(int rho) { const int n = rho >> 4, i = rho & 15; return 8 * (i >> 2) + 4 * n + (i & 3); }

struct Unit { int pm, pn, z; };
struct Gemm { const bf16_t* A; const bf16_t* Bt; };

template <int NN> struct StaticOrder {
    static constexpr int nM = 64, nN = NN, nwg = nM * nN;
    static constexpr size_t ZSA = 0, ZSB = 0;
    int G, c;
    __device__ void init(int G_, int c_) { G = G_; c = c_; }
    __device__ bool next(int i, Unit& u) const {
        const long L = (long)i * G + c; if (L >= nwg) return false;
        int wgid = (int)L; { const int q = nwg / NXCD, r = nwg % NXCD, xcd = wgid % NXCD, off = wgid / NXCD; wgid = (xcd < r ? xcd * (q + 1) : r * (q + 1) + (xcd - r) * q) + off; }
        const int nig = WGM * nN, gid = wgid / nig, fm = gid * WGM, gsz = (nM - fm) < WGM ? (nM - fm) : WGM;
        u.pm = fm + ((wgid % nig) % gsz); u.pn = (wgid % nig) / gsz; u.z = 0; return true;
    }
};
template <int NN, int NZ, size_t ZSA_, size_t ZSB_> struct ZOrder {
    static constexpr size_t ZSA = ZSA_, ZSB = ZSB_;
    StaticOrder<NN> S;
    __device__ void init(int G_, int c_) { S.init(G_, c_); }
    __device__ bool next(int i, Unit& u) const { const bool ok = S.next(i / NZ, u); u.z = i % NZ; return ok; }
};

template <int NZ, size_t ZS> struct SplitKOrder {
    static constexpr size_t ZSA = ZS, ZSB = ZS;
    int G, c;
    __device__ void init(int G_, int c_) { G = G_; c = c_; }
    __device__ bool next(int i, Unit& u) const { const int L = i * G + c; if (L >= 64 * NZ) return false; u.pm = L / NZ; u.pn = 0; u.z = L % NZ; return true; }
};
template <int K, class Epi, class Sched, bool ALIGN_EPI, bool SP2, int LDA = K, int LDB = K>
__device__ __forceinline__ void gemm_phase(LAS unsigned char* lds, const Gemm g, const Sched& S, const Epi& E, int wv) {
    int tid_ = (wv << 6) | lane_id(); asm volatile("" : "+v"(tid_));
    const int tid = tid_, wid = __builtin_amdgcn_readfirstlane(tid >> 6), lane = tid & 63, wr = wid >> 2, wc = wid & 3, fr = lane & 15, fq = lane >> 4;
    constexpr int nt = K / BK, lda = LDA, ldb = LDB;
    unsigned voffA[2], voffB[2];
#pragma unroll
    for (int i = 0; i < 2; ++i) { int R, C; stage_rc(tid * 16 + i * 8192, R, C); const int Rb = Epi::PERM ? ((R & ~31) + perm32(R & 31)) : R;
        voffA[i] = (unsigned)(R * lda + C) * 2u; voffB[i] = (unsigned)(Rb * ldb + C) * 2u; }
    constexpr size_t kstep = (size_t)(BK * 2);
    constexpr size_t hstepA = (size_t)HALF * lda * 2, hstepB = (size_t)HALF * ldb * 2;
    constexpr size_t tstepA = 2 * hstepA, tstepB = 2 * hstepB;
    const unsigned ldsw = (unsigned)wid * 1024u;
    const int aoff = lds_byte(wr * 64 + fr, fq * 8), boff = lds_byte(wc * 32 + fr, fq * 8);
#define PG8_SA(b, h) (((b) * 2 + (h)) * HTB)
#define PG8_SB(b, h) ((4 + (b) * 2 + (h)) * HTB)
#define PG8_STAGE(bufoff, gbase, voff) do { _Pragma("unroll") for (int _i = 0; _i < 2; ++_i) \
        __builtin_amdgcn_global_load_lds((const unsigned*)((const char*)(gbase) + (voff)[_i]), (LAS unsigned*)(lds + (bufoff) + ldsw + _i * 8192), 16, 0, 0); } while (0)
#define PG8_LDA(dst, b, h) do { _Pragma("unroll") for (int m = 0; m < 4; ++m) _Pragma("unroll") for (int k = 0; k < 2; ++k) dst[m][k] = *(const LAS bf16x8*)(lds + PG8_SA(b, h) + aoff + m * 2048 + k * 1024); } while (0)
#define PG8_LDB(dst, b, h) do { _Pragma("unroll") for (int n = 0; n < 2; ++n) _Pragma("unroll") for (int k = 0; k < 2; ++k) dst[n][k] = *(const LAS bf16x8*)(lds + PG8_SB(b, h) + boff + n * 2048 + k * 1024); } while (0)
#define PG8_MMA(ai, bj, At, Bt) do { __builtin_amdgcn_s_setprio(1); _Pragma("unroll") for (int m = 0; m < 4; ++m) _Pragma("unroll") for (int n = 0; n < 2; ++n) _Pragma("unroll") for (int k = 0; k < 2; ++k) \
        acc[ai][bj][m][n] = __builtin_amdgcn_mfma_f32_16x16x32_bf16(Bt[n][k], At[m][k], acc[ai][bj][m][n], 0, 0, 0); __builtin_amdgcn_s_setprio(0); } while (0)
#define PG8_WAIT_V(n) asm volatile("s_waitcnt vmcnt(" #n ")" ::: "memory")
#define PG8_WAIT_L(n) asm volatile("s_waitcnt lgkmcnt(" #n ")" ::: "memory")
#define PG8_BAR __builtin_amdgcn_s_barrier()
#define PG8_SCHED __builtin_amdgcn_sched_barrier(0)
#define PG8_ABASE(u) ((const char*)g.A + (size_t)(u).z * Sched::ZSA + (size_t)(u).pm * tstepA)
#define PG8_BBASE(u) ((const char*)g.Bt + (size_t)(u).z * Sched::ZSB + (size_t)(u).pn * tstepB)
    Unit cur, nxt; int ui = 0;
    if (!S.next(0, cur)) return;
    f32x4 acc[2][2][4][2];
#pragma unroll
    for (int a = 0; a < 2; ++a)
#pragma unroll
        for (int b = 0; b < 2; ++b)
#pragma unroll
            for (int m = 0; m < 4; ++m)
#pragma unroll
                for (int n = 0; n < 2; ++n) acc[a][b][m][n] = (f32x4){0.f, 0.f, 0.f, 0.f};
    bf16x8 At[4][2], B0[2][2], B1[2][2];
    const char* cA = PG8_ABASE(cur); const char* cB = PG8_BBASE(cur);
    if constexpr (SP2) {
        PG8_STAGE(PG8_SB(0, 0), cB, voffB); PG8_STAGE(PG8_SB(0, 1), cB + hstepB, voffB); PG8_STAGE(PG8_SA(0, 0), cA, voffA); PG8_STAGE(PG8_SA(0, 1), cA + hstepA, voffA);
        if (wr == 1) PG8_BAR;
        PG8_WAIT_V(2); PG8_BAR;
        PG8_STAGE(PG8_SB(1, 0), cB + kstep, voffB); PG8_STAGE(PG8_SA(1, 0), cA + kstep, voffA); PG8_STAGE(PG8_SB(1, 1), cB + hstepB + kstep, voffB);
        PG8_WAIT_V(6); PG8_BAR;
    } else {
        PG8_STAGE(PG8_SB(0, 0), cB, voffB); PG8_STAGE(PG8_SA(0, 0), cA, voffA); PG8_STAGE(PG8_SB(0, 1), cB + hstepB, voffB); PG8_STAGE(PG8_SA(0, 1), cA + hstepA, voffA);
        if (wr == 1) PG8_BAR;
        PG8_WAIT_V(4); PG8_BAR;
        PG8_STAGE(PG8_SB(1, 0), cB + kstep, voffB); PG8_STAGE(PG8_SA(1, 0), cA + kstep, voffA); PG8_STAGE(PG8_SB(1, 1), cB + hstepB + kstep, voffB);
        PG8_WAIT_V(6); PG8_BAR;
    }
    for (;;) {
        const bool has_next = S.next(ui + 1, nxt);
        const char* nA = has_next ? PG8_ABASE(nxt) : cA; const char* nB = has_next ? PG8_BBASE(nxt) : cB;
        for (int t = 0; t < nt; t += 2) {
            const bool last = (t == nt - 2);
            const char* a1 = cA + (size_t)(t + 1) * kstep;
            const char* a2 = last ? nA : cA + (size_t)(t + 2) * kstep; const char* b2 = last ? nB : cB + (size_t)(t + 2) * kstep;
            const char* a3 = a2 + kstep; const char* b3 = b2 + kstep;
            if constexpr (SP2) {
            PG8_LDB(B0, 0, 0); PG8_LDB(B1, 0, 1); PG8_SCHED; PG8_LDA(At, 0, 0); PG8_STAGE(PG8_SA(1, 1), a1 + hstepA, voffA);
            PG8_WAIT_V(8); PG8_WAIT_L(0); PG8_BAR; PG8_MMA(0, 0, At, B0); PG8_MMA(0, 1, At, B1); PG8_BAR; PG8_SCHED;
            PG8_LDA(At, 0, 1); PG8_STAGE(PG8_SB(0, 0), b2, voffB); PG8_STAGE(PG8_SB(0, 1), b2 + hstepB, voffB); PG8_STAGE(PG8_SA(0, 0), a2, voffA);
            PG8_WAIT_V(8); PG8_WAIT_L(0); PG8_BAR; PG8_MMA(1, 0, At, B0); PG8_MMA(1, 1, At, B1); PG8_BAR; PG8_SCHED;
            PG8_LDB(B0, 1, 0); PG8_LDB(B1, 1, 1); PG8_SCHED; PG8_LDA(At, 1, 0); PG8_STAGE(PG8_SA(0, 1), a2 + hstepA, voffA);
            PG8_WAIT_V(8); PG8_WAIT_L(0); PG8_BAR; PG8_MMA(0, 0, At, B0); PG8_MMA(0, 1, At, B1); PG8_BAR; PG8_SCHED;
            PG8_LDA(At, 1, 1); PG8_STAGE(PG8_SB(1, 0), b3, voffB); PG8_STAGE(PG8_SB(1, 1), b3 + hstepB, voffB); PG8_STAGE(PG8_SA(1, 0), a3, voffA);
            PG8_WAIT_V(8); PG8_WAIT_L(0); PG8_BAR; PG8_MMA(1, 0, At, B0); PG8_MMA(1, 1, At, B1); PG8_BAR; PG8_SCHED;
            } else {
            PG8_LDB(B0, 0, 0); PG8_SCHED; PG8_LDA(At, 0, 0); PG8_STAGE(PG8_SA(1, 1), a1 + hstepA, voffA);
            PG8_WAIT_L(8); PG8_BAR; PG8_WAIT_L(0); PG8_MMA(0, 0, At, B0); PG8_BAR; PG8_SCHED;
            PG8_LDB(B1, 0, 1); PG8_STAGE(PG8_SB(0, 0), b2, voffB);
            PG8_BAR; PG8_WAIT_L(0); PG8_MMA(0, 1, At, B1); PG8_BAR;
            PG8_LDA(At, 0, 1); PG8_STAGE(PG8_SA(0, 0), a2, voffA);
            PG8_BAR; PG8_WAIT_L(0); PG8_MMA(1, 0, At, B0); PG8_BAR; PG8_SCHED;
            PG8_STAGE(PG8_SB(0, 1), b2 + hstepB, voffB);
            PG8_WAIT_V(6); PG8_BAR; PG8_MMA(1, 1, At, B1); PG8_BAR;
            PG8_LDB(B0, 1, 0); PG8_SCHED; PG8_LDA(At, 1, 0); PG8_STAGE(PG8_SA(0, 1), a2 + hstepA, voffA);
            PG8_WAIT_L(8); PG8_BAR; PG8_WAIT_L(0); PG8_MMA(0, 0, At, B0); PG8_BAR; PG8_SCHED;
            PG8_LDB(B1, 1, 1); PG8_STAGE(PG8_SB(1, 0), b3, voffB);
            PG8_BAR; PG8_WAIT_L(0); PG8_MMA(0, 1, At, B1); PG8_BAR;
            PG8_LDA(At, 1, 1); PG8_STAGE(PG8_SA(1, 0), a3, voffA);
            PG8_BAR; PG8_WAIT_L(0); PG8_MMA(1, 0, At, B0); PG8_BAR; PG8_SCHED;
            PG8_STAGE(PG8_SB(1, 1), b3 + hstepB, voffB);
            PG8_WAIT_V(6); PG8_BAR; PG8_MMA(1, 1, At, B1); PG8_BAR;
            }
        }
        if constexpr (ALIGN_EPI) { if (wr == 0) PG8_BAR; }
        { int tz = lane_id(); asm volatile("" : "+v"(tz)); const int l2 = tz & 63; E(acc, cur, wr, wc, l2 & 15, l2 >> 4); }
        if (!has_next) break;
        if (!E.keep_acc(cur)) {
#pragma unroll
        for (int a = 0; a < 2; ++a)
#pragma unroll
            for (int b = 0; b < 2; ++b)
#pragma unroll
                for (int m = 0; m < 4; ++m)
#pragma unroll
                    for (int n = 0; n < 2; ++n) acc[a][b][m][n] = (f32x4){0.f, 0.f, 0.f, 0.f};
        }
        cur = nxt; cA = nA; cB = nB; ++ui;
        if constexpr (ALIGN_EPI) { if (wr == 1) PG8_BAR; }
    }
    PG8_WAIT_V(0);
    if constexpr (!ALIGN_EPI) { if (wr == 0) PG8_BAR; }
    PG8_BAR;
#undef PG8_SA
#undef PG8_SB
#undef PG8_STAGE
#undef PG8_LDA
#undef PG8_LDB
#undef PG8_MMA
#undef PG8_WAIT_V
#undef PG8_WAIT_L
#undef PG8_BAR
#undef PG8_SCHED
#undef PG8_ABASE
#undef PG8_BBASE
}
}

#define XB_TMO      128
#define XB_XCNT(j)  (256  + 64 * (j))
#define XB_XSUB(j)  (1280 + 64 * (j))
#define XB_XGEN(j)  (2304 + 64 * (j))
#define XB_TOP      3328
#define XB_TOPGEN   3392
#define XCD_BAR_WORDS 3456
#define XB_SPIN_CAP (1u << 18)
__device__ __forceinline__ unsigned xb_ld(unsigned* p)              { return __hip_atomic_load(p, __ATOMIC_RELAXED, __HIP_MEMORY_SCOPE_AGENT); }
__device__ __forceinline__ unsigned xb_add(unsigned* p, unsigned v) { return __hip_atomic_fetch_add(p, v, __ATOMIC_RELAXED, __HIP_MEMORY_SCOPE_AGENT); }
__device__ __forceinline__ unsigned xb_xcc_id() { return (unsigned)__builtin_amdgcn_s_getreg((3 << 11) | 20) & 0xFu; }
#define XB_SPIN(cond, bar) do { unsigned _sp = 0; while (cond) { __builtin_amdgcn_s_sleep(1); \
    if ((++_sp & 255u) == 0u) { if (xb_ld(&(bar)[XB_TMO])) break; if (_sp > XB_SPIN_CAP) { atomicAdd(&(bar)[XB_TMO], 1u); break; } } } } while (0)
struct XcdBarrier { unsigned* bar; unsigned x; volatile LAS unsigned* st; };
__device__ __forceinline__ XcdBarrier xcd_barrier_post(unsigned* bar, volatile LAS unsigned* st) {
    XcdBarrier b; b.bar = bar; b.x = xb_xcc_id(); b.st = st;
    if (threadIdx.x == 0) (void)xb_add(&bar[XB_XCNT(b.x)], 1u);
    return b;
}
__device__ __forceinline__ void xcd_barrier_complete(unsigned* bar, unsigned x, unsigned& nloc, unsigned& nx) {
    const unsigned G = gridDim.x * gridDim.y * gridDim.z;
    unsigned sum, cnt, mine, sp = 0u;
    for (;;) {
        sum = 0u; cnt = 0u; mine = 0u;
#pragma unroll
        for (unsigned j = 0; j < 16; ++j) { const unsigned c = xb_ld(&bar[XB_XCNT(j)]); sum += c; cnt += (c > 0u) ? 1u : 0u; mine = (j == x) ? c : mine; }
        if (sum == G) break;
        __builtin_amdgcn_s_sleep(1);
        if ((++sp & 255u) == 0u) { if (xb_ld(&bar[XB_TMO])) break; if (sp > XB_SPIN_CAP) { atomicAdd(&bar[XB_TMO], 1u); break; } }
    }
    nloc = mine > 0u ? mine : 1u; nx = cnt > 0u ? cnt : 1u;
}
__device__ __forceinline__ void xcd_barrier(const XcdBarrier& b, bool leader  ) {
    asm volatile("s_waitcnt vmcnt(0)" ::: "memory");
    __syncthreads();
    if (leader) {
        unsigned* bar = b.bar;
        __builtin_amdgcn_s_waitcnt(0);
        unsigned nloc = b.st[0], nx = b.st[1];
        if (nloc == 0u) { xcd_barrier_complete(bar, b.x, nloc, nx); b.st[0] = nloc; b.st[1] = nx; }
        const unsigned old = xb_add(&bar[XB_XSUB(b.x)], 1u);
        const unsigned gen = old / nloc;
        if (old + 1u == (gen + 1u) * nloc) {
            __builtin_amdgcn_fence(__ATOMIC_RELEASE, "agent");
            asm volatile("s_waitcnt vmcnt(0)" ::: "memory");
            const unsigned og = xb_add(&bar[XB_TOP], 1u);
            const unsigned tg = og / nx;
            if (og + 1u == (tg + 1u) * nx) xb_add(&bar[XB_TOPGEN], 1u);
            else XB_SPIN(xb_ld(&bar[XB_TOPGEN]) == tg, bar);
            __builtin_amdgcn_fence(__ATOMIC_ACQUIRE, "agent");
            xb_add(&bar[XB_XGEN(b.x)], 1u);
            asm volatile("s_waitcnt vmcnt(0)" ::: "memory");
        } else {
            XB_SPIN(xb_ld(&bar[XB_XGEN(b.x)]) == gen, bar);
            __builtin_amdgcn_fence(__ATOMIC_ACQUIRE, "agent");
            asm volatile("s_waitcnt vmcnt(0)" ::: "memory");
        }
    }
    __syncthreads();
}
namespace mk {
constexpr int NWAVES = 8, NTHREADS = 512;
constexpr int B_ = 2, T_ = 8192, D_ = 1024, M_ = B_ * T_, DEPTH_ = 4, D_IN_ = 8216, D_FF_ = 4096, NPAD_ = 8448;
constexpr int OFF_GQ = 0, OFF_GK = 512, OFF_GV = 1024, OFF_GG = 1536, OFF_GA = 2048, OFF_MQ = 2064, OFF_MK = 2576, OFF_MV = 3088,
              OFF_LQ = 3600, OFF_LK = 3856, OFF_LV = 4112, OFF_LO = 4624, OFF_LI = 5136, OFF_LF = 5140, OFF_BG = 5144;
constexpr float EPS_ = 1e-6f;
constexpr size_t MiB = 1u << 20;
constexpr size_t WS_CTL = 0, CTL_ZERO_BYTES = 1 * MiB;
constexpr size_t WS_SS = 1 * MiB;
constexpr size_t WS_SMALL = 2 * MiB;
__host__ __device__ constexpr size_t small_off(int z) { return z == 0 ? 0 : (size_t)(505 + 2 * (z - 1)) * MiB; }
constexpr size_t WS_ROPE = 4 * MiB;
constexpr size_t WS_MISC = 6 * MiB;
constexpr size_t WS_WTS = 8 * MiB;
constexpr size_t WL_WIN = 0, WL_WBR = 16 * MiB + MiB / 2, WL_WOUT = WL_WBR + 3 * MiB, WL_FF1 = WL_WOUT + 2 * MiB, WL_FF2 = WL_FF1 + 8 * MiB, WL_STRIDE = WL_FF2 + 8 * MiB;
static_assert(WL_STRIDE == 37 * MiB + MiB / 2, "weights per layer");
constexpr size_t WS_SEG = 158 * MiB;
constexpr size_t SEG_GQ = 0, SEG_GK = 16 * MiB, SEG_GV = 32 * MiB, SEG_MK = 48 * MiB, SEG_MV = 64 * MiB, SEG_LQ = 80 * MiB, SEG_LK = 88 * MiB, SEG_LV = 96 * MiB,
                 SEG_GG = 112 * MiB, SEG_MQ = 128 * MiB, SEG_LO = 144 * MiB, SEG_BG = 160 * MiB;
constexpr size_t WS_MIXED = WS_SEG;
constexpr size_t WS_MIXB = WS_SEG + 64 * MiB;
constexpr size_t WS_H = WS_SEG;
constexpr size_t WS_ACT = 414 * MiB;
constexpr size_t WS_SCR = 446 * MiB;
constexpr size_t WS_END = 513 * MiB;
static_assert(WS_WTS + 4 * WL_STRIDE <= WS_SEG, "weights fit");
constexpr int CW_BAR = 4096;
constexpr int N_BAR_REGIONS = 16;
constexpr int RING_BYTES = 131072, MISC_OFF = RING_BYTES + 320, LDS_BYTES = 147456;

struct Args { const float* in[20]; float* out; unsigned char* ws; int ph_lo, ph_hi, li, mix; };

struct Frame {
    LAS unsigned char* lds; volatile LAS unsigned* MISC; gu32* ctl; unsigned char* ws;
    int tid, lane, wave, G, vcu;
};

__device__ __forceinline__ int win_src(int n) {
    if (n < 512) return OFF_GQ + n;
    if (n < 1024) return OFF_GK + (n - 512);
    if (n < 1536) return OFF_GV + (n - 1024);
    if (n < 2048) return OFF_MK + (n - 1536);
    if (n < 2560) return OFF_MV + (n - 2048);
    if (n < 2816) return OFF_LQ + (n - 2560);
    if (n < 3072) return OFF_LK + (n - 2816);
    if (n < 3584) return OFF_LV + (n - 3072);
    if (n < 4096) return OFF_GG + (n - 3584);
    if (n < 4608) return OFF_MQ + (n - 4096);
    if (n < 5120) return OFF_LO + (n - 4608);
    if (n < 8192) return OFF_BG + (n - 5120);
    if (n < 8208) return OFF_GA + (n - 8192);
    if (n < 8212) return OFF_LI + (n - 8208);
    if (n < 8216) return OFF_LF + (n - 8212);
    return -1;
}
__device__ __forceinline__ void transpose_item(const float* W, int ldw, bf16_t* WT, int K, int k0, int n0, int sc, LAS float* scr, int lane) {
    float v[32];
#pragma unroll
    for (int i = 0; i < 32; ++i) { const int kk = 2 * i + (lane >> 5); v[i] = sc >= 0 ? W[(size_t)(k0 + kk) * ldw + sc] : 0.f; }
#pragma unroll
    for (int i = 0; i < 32; ++i) { const int kk = 2 * i + (lane >> 5); scr[kk * 33 + (lane & 31)] = v[i]; }
    LDS_WAIT(); asm volatile("" ::: "memory");
    const int c = lane & 7;
#pragma unroll
    for (int j = 0; j < 4; ++j) { const int n = (lane >> 3) + 8 * j; const LAS float* s = scr + (8 * c) * 33 + n;
        u32x4 o; o.x = cvt_pk_bf16(s[0 * 33], s[1 * 33]); o.y = cvt_pk_bf16(s[2 * 33], s[3 * 33]); o.z = cvt_pk_bf16(s[4 * 33], s[5 * 33]); o.w = cvt_pk_bf16(s[6 * 33], s[7 * 33]);
        *(GAS u32x4*)(WT + (size_t)(n0 + n) * K + k0 + 8 * c) = o; }
    LDS_WAIT(); asm volatile("" ::: "memory");
}
constexpr int IT_WIN = 16 * (NPAD_ / 32), IT_BR = 8 * 32, IT_WOUT = 16 * 32, IT_FF1 = 16 * 128, IT_FF2 = 64 * 32;
constexpr int IT_LAYER = IT_WIN + 3 * IT_BR + IT_WOUT + IT_FF1 + IT_FF2;
__device__ __forceinline__ void weights_item(const Args& a, unsigned char* ws, int l, int it, LAS float* scr, int lane) {
    unsigned char* wl = ws + WS_WTS + (size_t)l * WL_STRIDE;
    int r = it;
    if (r < IT_WIN) { const int kb = r / (NPAD_ / 32), nb = r % (NPAD_ / 32); const int sc = win_src(nb * 32 + (lane & 31));
        transpose_item(a.in[2] + (size_t)l * 1024 * D_IN_, D_IN_, (bf16_t*)(wl + WL_WIN), 1024, kb * 64, nb * 32, sc, scr, lane); return; }
    r -= IT_WIN;
    if (r < 3 * IT_BR) { const int z = r / IT_BR, q = r % IT_BR, kb = q / 32, nb = q % 32;
        transpose_item((z == 0 ? a.in[13] : (z == 1 ? a.in[14] : a.in[15])) + (size_t)l * 512 * 1024, 1024, (bf16_t*)(wl + WL_WBR + (size_t)z * MiB), 512, kb * 64, nb * 32, nb * 32 + (lane & 31), scr, lane); return; }
    r -= 3 * IT_BR;
    if (r < IT_WOUT) { const int kb = r / 32, nb = r % 32;
        transpose_item(a.in[16] + (size_t)l * 1024 * 1024, 1024, (bf16_t*)(wl + WL_WOUT), 1024, kb * 64, nb * 32, nb * 32 + (lane & 31), scr, lane); return; }
    r -= IT_WOUT;
    if (r < IT_FF1) { const int kb = r / 128, nb = r % 128;
        transpose_item(a.in[18] + (size_t)l * 1024 * 4096, 4096, (bf16_t*)(wl + WL_FF1), 1024, kb * 64, nb * 32, nb * 32 + (lane & 31), scr, lane); return; }
    r -= IT_FF1;
    { const int kb = r / 32, nb = r % 32;
        transpose_item(a.in[19] + (size_t)l * 4096 * 1024, 1024, (bf16_t*)(wl + WL_FF2), 4096, kb * 64, nb * 32, nb * 32 + (lane & 31), scr, lane); }
}
__device__ __forceinline__ void prep_row(const float* xrow, const float* g, bf16_t* arow, float* ssrow, int lane) {
    const GAS f32x4* xr = (const GAS f32x4*)xrow + lane;
    f32x4 v[4]; float s = 0.f;
#pragma unroll
    for (int j = 0; j < 4; ++j) { v[j] = xr[64 * j]; s += (v[j].x * v[j].x + v[j].y * v[j].y) + (v[j].z * v[j].z + v[j].w * v[j].w); }
    s = wave_sum(s);
    GAS u32x2* o8 = (GAS u32x2*)arow + lane;
#pragma unroll
    for (int j = 0; j < 4; ++j) { const f32x4 gg = ((const GAS f32x4*)g)[lane + 64 * j]; u32x2 w; w.x = cvt_pk_bf16(v[j].x * gg.x, v[j].y * gg.y); w.y = cvt_pk_bf16(v[j].z * gg.z, v[j].w * gg.w); o8[64 * j] = w; }
    if (lane < 4) ssrow[lane] = lane == 0 ? s : 0.f;
}
__device__ __forceinline__ void p0_prologue(Frame& F, const Args& a, int l_lo, int l_hi, bool do_rows) {
    LAS float* scr = (LAS float*)(F.lds + F.wave * 16384);
    const int gw = F.vcu * NWAVES + F.wave, NGW = F.G * NWAVES;
    const int nit = (l_hi - l_lo) * IT_LAYER;
    for (int it = gw; it < nit; it += NGW) weights_item(a, F.ws, l_lo + it / IT_LAYER, it % IT_LAYER, scr, F.lane);
    if (do_rows) {
        for (int m = gw; m < M_; m += NGW) prep_row(a.in[0] + (size_t)m * D_, a.in[1], (bf16_t*)(F.ws + WS_ACT) + (size_t)m * D_, (float*)(F.ws + WS_SS) + (size_t)m * 4, F.lane);
        float* COS = (float*)(F.ws + WS_ROPE); float* SIN = COS + 8192 * 32;
        for (int idx = gw * 64 + F.lane; idx < 8192 * 32; idx += NGW * 64) { const int t = idx >> 5, i = idx & 31;
            const float inv = 1.0f / powf(10000.0f, (float)(2 * i) / 64.0f); const float ang = (float)t * inv; COS[idx] = cosf(ang); SIN[idx] = sinf(ang); }
    }
}

__device__ __forceinline__ void row_rstd(const float* ss, int row0, float (&rs)[2][4]) {
    f32x4 p[2][4];
#pragma unroll
    for (int ai = 0; ai < 2; ++ai)
#pragma unroll
        for (int m = 0; m < 4; ++m) p[ai][m] = *(const GAS f32x4*)(ss + (size_t)(row0 + ai * 128 + m * 16) * 4);
#pragma unroll
    for (int ai = 0; ai < 2; ++ai)
#pragma unroll
        for (int m = 0; m < 4; ++m) rs[ai][m] = rsqrtf(((p[ai][m].x + p[ai][m].y) + (p[ai][m].z + p[ai][m].w)) * (1.f / 1024.f) + EPS_);
}
struct EpiWin {
    static constexpr bool PERM = true;
    __device__ __forceinline__ bool keep_acc(const pg8::Unit&) const { return false; }
    bf16_t* seg; const float* ss;
    __device__ __forceinline__ void operator()(const f32x4 (&acc)[2][2][4][2], const pg8::Unit& u, int wr, int wc, int fr, int fq) const {
        const int row0 = u.pm * 256 + wr * 64 + fr;
        float rs[2][4]; row_rstd(ss, row0, rs);
        const int pn = u.pn;
        {
            int st, width;
            if (pn < 10) { st = pn & ~1; width = 512; } else if (pn < 12) { st = pn; width = 256; } else if (pn < 20) { st = 12 + ((pn - 12) & ~1); width = 512; } else { st = 20; width = 3072; }
            bf16_t* base = seg + (size_t)M_ * 256 * st + (pn - st) * 256 + wc * 32 + 8 * fq;
#pragma unroll
            for (int ai = 0; ai < 2; ++ai)
#pragma unroll
                for (int m = 0; m < 4; ++m) { bf16_t* rowp = base + (size_t)(row0 + ai * 128 + m * 16) * width; const float r = rs[ai][m];
#pragma unroll
                    for (int bj = 0; bj < 2; ++bj) { const f32x4 v0 = acc[ai][bj][m][0] * r, v1 = acc[ai][bj][m][1] * r;
                        u32x4 w; w.x = cvt_pk_bf16(v0[0], v0[1]); w.y = cvt_pk_bf16(v0[2], v0[3]); w.z = cvt_pk_bf16(v1[0], v1[1]); w.w = cvt_pk_bf16(v1[2], v1[3]);
                        st16_wt(rowp + bj * 128, w); } }
        }
    }
};
struct EpiSmall {
    static constexpr bool PERM = true;
    __device__ __forceinline__ bool keep_acc(const pg8::Unit&) const { return false; }
    float* small_; const float* ss;
    __device__ __forceinline__ void operator()(const f32x4 (&acc)[2][2][4][2], const pg8::Unit& u, int wr, int wc, int fr, int fq) const {
        const int row0 = u.pm * 256 + wr * 64 + fr;
        float rs[2][4]; row_rstd(ss, row0, rs);
        if (wc == 0) {
#pragma unroll
            for (int ai = 0; ai < 2; ++ai)
#pragma unroll
                for (int m = 0; m < 4; ++m) { float* p = (float*)((unsigned char*)small_ + (u.z == 0 ? 0 : (size_t)(505 + 2 * (u.z - 1)) * MiB)) + (size_t)(row0 + ai * 128 + m * 16) * 32 + 8 * fq; const float r = rs[ai][m];
                    *(GAS f32x4*)p = acc[ai][0][m][0] * r; *(GAS f32x4*)(p + 4) = acc[ai][0][m][1] * r; }
        }
    }
};
struct EpiFf1 {
    static constexpr bool PERM = true;
    __device__ __forceinline__ bool keep_acc(const pg8::Unit&) const { return false; }
    bf16_t* H; const float* ss;
    __device__ __forceinline__ void operator()(const f32x4 (&acc)[2][2][4][2], const pg8::Unit& u, int wr, int wc, int fr, int fq) const {
        const int row0 = u.pm * 256 + wr * 64 + fr;
        float rs[2][4]; row_rstd(ss, row0, rs);
        bf16_t* base = H + u.pn * 256 + wc * 32 + 8 * fq;
#pragma unroll
        for (int ai = 0; ai < 2; ++ai)
#pragma unroll
            for (int m = 0; m < 4; ++m) { bf16_t* rowp = base + (size_t)(row0 + ai * 128 + m * 16) * 4096; const float r = rs[ai][m];
#pragma unroll
                for (int bj = 0; bj < 2; ++bj) { f32x4 v0 = acc[ai][bj][m][0] * r, v1 = acc[ai][bj][m][1] * r;
                    v0 = __builtin_elementwise_max(v0, (f32x4){0.f, 0.f, 0.f, 0.f}); v1 = __builtin_elementwise_max(v1, (f32x4){0.f, 0.f, 0.f, 0.f}); v0 = v0 * v0; v1 = v1 * v1;
                    u32x4 w; w.x = cvt_pk_bf16(v0[0], v0[1]); w.y = cvt_pk_bf16(v0[2], v0[3]); w.z = cvt_pk_bf16(v1[0], v1[1]); w.w = cvt_pk_bf16(v1[2], v1[3]);
                    st16_wt(rowp + bj * 128, w); } }
    }
};
template <bool LAST> struct EpiRes {
    static constexpr bool PERM = false;
    __device__ __forceinline__ bool keep_acc(const pg8::Unit&) const { return false; }
    const float* xin; float* xout; bf16_t* act; float* ss; const float* g; LAS float* red;
    __device__ __forceinline__ void operator()(const f32x4 (&acc)[2][2][4][2], const pg8::Unit& u, int wr, int wc, int fr, int fq) const {
        const int row0 = u.pm * 256 + wr * 64 + fr, col0 = u.pn * 256 + wc * 32 + 4 * fq;
        f32x4 gv[2][2];
        if (!LAST) {
#pragma unroll
            for (int bj = 0; bj < 2; ++bj)
#pragma unroll
                for (int n = 0; n < 2; ++n) gv[bj][n] = *(const GAS f32x4*)(g + col0 + bj * 128 + n * 16);
        }
#pragma unroll
        for (int ai = 0; ai < 2; ++ai)
#pragma unroll
            for (int m = 0; m < 4; ++m) { const int row = row0 + ai * 128 + m * 16; const size_t off = (size_t)row * 1024 + col0; float q = 0.f;
#pragma unroll
                for (int bj = 0; bj < 2; ++bj)
#pragma unroll
                    for (int n = 0; n < 2; ++n) { const size_t o2 = off + bj * 128 + n * 16; const f32x4 x = *(const GAS f32x4*)(xin + o2) + acc[ai][bj][m][n];
                        *(GAS f32x4*)(xout + o2) = x;
                        if (!LAST) { q += (x[0] * x[0] + x[1] * x[1]) + (x[2] * x[2] + x[3] * x[3]); const f32x4 a = x * gv[bj][n];
                            u32x2 w; w.x = cvt_pk_bf16(a[0], a[1]); w.y = cvt_pk_bf16(a[2], a[3]); *(GAS u32x2*)(act + o2) = w; } }
                if (!LAST) { q += __shfl_xor(q, 16); q += __shfl_xor(q, 32); if (fq == 0) red[(ai * 128 + wr * 64 + m * 16 + fr) * 4 + wc] = q; }
                if (m & 1) asm volatile("" ::: "memory"); }
        if (!LAST) {
            asm volatile("s_waitcnt lgkmcnt(0)" ::: "memory"); __builtin_amdgcn_s_barrier(); asm volatile("" ::: "memory");
            if (wc == 0 && fq == 0) {
#pragma unroll
                for (int ai = 0; ai < 2; ++ai)
#pragma unroll
                    for (int m = 0; m < 4; ++m) { const int rl = ai * 128 + wr * 64 + m * 16 + fr; const f32x4 v = *(const LAS f32x4*)(red + rl * 4);
                        ss[(size_t)(u.pm * 256 + rl) * 4 + u.pn] = (v.x + v.y) + (v.z + v.w); } }
        }
    }
};
struct EpiBranch {
    static constexpr bool PERM = false;
    const bf16_t* bg; const float* gate_b; bf16_t* mixb;
    __device__ __forceinline__ bool keep_acc(const pg8::Unit& u) const { return u.z != 2; }
    __device__ __forceinline__ void operator()(f32x4 (&acc)[2][2][4][2], const pg8::Unit& u, int wr, int wc, int fr, int fq) const {
        const int row0 = u.pm * 256 + wr * 64 + fr, col0 = u.pn * 256 + wc * 32 + 4 * fq, z = u.z;
        const int z2 = z < 2 ? z + 1 : 2;
        f32x4 ga[2][2], gc[2][2];
#pragma unroll
        for (int bj = 0; bj < 2; ++bj)
#pragma unroll
            for (int n = 0; n < 2; ++n) { ga[bj][n] = *(const GAS f32x4*)(gate_b + z * 1024 + col0 + bj * 128 + n * 16); gc[bj][n] = *(const GAS f32x4*)(gate_b + z2 * 1024 + col0 + bj * 128 + n * 16); }
#pragma unroll
        for (int ai = 0; ai < 2; ++ai)
#pragma unroll
            for (int m = 0; m < 4; ++m) { const int row = row0 + ai * 128 + m * 16;
#pragma unroll
                for (int bj = 0; bj < 2; ++bj)
#pragma unroll
                    for (int n = 0; n < 2; ++n) { const int c = col0 + bj * 128 + n * 16;
                        const u32x2 ba = *(const GAS u32x2*)(bg + (size_t)row * 3072 + z * 1024 + c);
                        const u32x2 bc = *(const GAS u32x2*)(bg + (size_t)row * 3072 + z2 * 1024 + c);
                        const float xa[4] = {bf_lo(ba.x) + ga[bj][n][0], bf_hi(ba.x) + ga[bj][n][1], bf_lo(ba.y) + ga[bj][n][2], bf_hi(ba.y) + ga[bj][n][3]};
                        const float xc[4] = {bf_lo(bc.x) + gc[bj][n][0], bf_hi(bc.x) + gc[bj][n][1], bf_lo(bc.y) + gc[bj][n][2], bf_hi(bc.y) + gc[bj][n][3]};
                        f32x4 f;
#pragma unroll
                        for (int k = 0; k < 4; ++k) { const float ea = __expf(-fminf(fmaxf(xa[k], -30.f), 30.f));
                            if (z == 2) f[k] = __builtin_amdgcn_rcpf(1.f + ea);
                            else { const float ec = __expf(-fminf(fmaxf(xc[k], -30.f), 30.f)); f[k] = (1.f + ec) * __builtin_amdgcn_rcpf(1.f + ea); } }
                        const f32x4 v = acc[ai][bj][m][n] * f;
                        if (z == 2) { u32x2 w; w.x = cvt_pk_bf16(v[0], v[1]); w.y = cvt_pk_bf16(v[2], v[3]); *(GAS u32x2*)(mixb + (size_t)row * 1024 + c) = w; }
                        else acc[ai][bj][m][n] = v; }
                if (m & 1) asm volatile("" ::: "memory"); }
    }
};
}
namespace mk {
constexpr size_t SCR_GLA_KV = 36 * MiB;
constexpr size_t MISC_GLA_DT = 256 * 1024;
constexpr int GL_QD = 0, GL_KI = 17408, GL_KET = 34816, GL_VT = 53248, GL_ST = 71680, GL_DEC = 106496, GL_GA = 107008, GL_BC = 111104, GL_NRM = 113152, GL_END = 115200;
constexpr int P128 = 136, P64 = 72;

__device__ __forceinline__ bf16x8 lds16(const LAS bf16_t* p) { return *(const LAS bf16x8*)p; }
__device__ __forceinline__ bf16x8 lds8x2(const LAS bf16_t* p0, const LAS bf16_t* p1) {
    const bf16x4 a = *(const LAS bf16x4*)p0, b = *(const LAS bf16x4*)p1;
    return __builtin_shufflevector(a, b, 0, 1, 2, 3, 4, 5, 6, 7);
}
__device__ __forceinline__ bf16x8 pack8(const f32x4 a, const f32x4 b) {
    u32x4 w; w.x = cvt_pk_bf16(a[0], a[1]); w.y = cvt_pk_bf16(a[2], a[3]); w.z = cvt_pk_bf16(b[0], b[1]); w.w = cvt_pk_bf16(b[2], b[3]);
    return __builtin_bit_cast(bf16x8, w);
}
#define MFMA16(a, b, c) __builtin_amdgcn_mfma_f32_16x16x32_bf16((a), (b), (c), 0, 0, 0)

template <bool PASS_C>
__device__ __forceinline__ void gla_unit(LAS unsigned char* lds, const Args& args, int l, int u, int wv) {
    int tid_ = (wv << 6) | lane_id(); asm volatile("" : "+v"(tid_));
    const int tid = tid_, lane = tid & 63, w = __builtin_amdgcn_readfirstlane(tid >> 6), lr = lane & 15, lg = lane >> 4;
    const int bh = u >> 5, sc = u & 31, b = bh >> 2, h = bh & 3;
    const size_t mbase = (size_t)b * T_ + (size_t)sc * 256;
    GAS unsigned char* ws = (GAS unsigned char*)args.ws; asm volatile("" : "+s"(ws));
    const GAS bf16_t* GQ = (const GAS bf16_t*)(ws + WS_SEG + SEG_GQ) + h * 128; const GAS bf16_t* GK = (const GAS bf16_t*)(ws + WS_SEG + SEG_GK) + h * 128;
    const GAS bf16_t* GV = (const GAS bf16_t*)(ws + WS_SEG + SEG_GV) + h * 128; GAS bf16_t* GG = (GAS bf16_t*)(ws + WS_SEG + SEG_GG) + h * 128;
    const GAS float* SMALL = (const GAS float*)(ws + WS_SMALL);
    GAS float* KV = (GAS float*)(ws + WS_SCR + SCR_GLA_KV) + (size_t)u * 16384; GAS float* DT = (GAS float*)(ws + WS_MISC + MISC_GLA_DT) + (size_t)u * 128;
    LAS bf16_t* QD = (LAS bf16_t*)(lds + GL_QD); LAS bf16_t* KI = (LAS bf16_t*)(lds + GL_KI); LAS bf16_t* KET = (LAS bf16_t*)(lds + GL_KET);
    LAS bf16_t* VT = (LAS bf16_t*)(lds + GL_VT); LAS bf16_t* ST = (LAS bf16_t*)(lds + GL_ST);
    LAS float* DEC = (LAS float*)(lds + GL_DEC); LAS float* GA = (LAS float*)(lds + GL_GA); LAS float* BC = (LAS float*)(lds + GL_BC); LAS float* NRM = (LAS float*)(lds + GL_NRM);
    const int d = tid & 127, tq = tid >> 7;
    float aup[16];
    { const float* a_up = args.in[3] + (size_t)l * 16 * 512 + h * 128 + d;
#pragma unroll
      for (int r = 0; r < 16; ++r) aup[r] = a_up[r * 512]; }
    const float ab = args.in[4][(size_t)l * 512 + h * 128 + d];
    const float scale = 0.08838834764831845f;
    f32x4 S[8];
    if (PASS_C) {
#pragma unroll
        for (int et = 0; et < 8; ++et) {
#pragma unroll
            for (int r = 0; r < 4; ++r) S[et][r] = KV[(size_t)(16 * w + 4 * lg + r) * 128 + 16 * et + lr];
            u32x2 pk; pk.x = cvt_pk_bf16(S[et][0], S[et][1]); pk.y = cvt_pk_bf16(S[et][2], S[et][3]);
            *(LAS u32x2*)(ST + (16 * et + lr) * P128 + 16 * w + 4 * lg) = pk;
        }
    } else {
#pragma unroll
        for (int et = 0; et < 8; ++et) S[et] = (f32x4){0.f, 0.f, 0.f, 0.f};
    }
    float dsum = 0.f;
    bf16_t kr[16], qr[16], vr[16];
#define GLA_FETCH(cn) do { const size_t mr_ = mbase + (size_t)(cn) * 64; \
        const GAS bf16_t* kp_ = GK + (mr_ + tq * 16) * 512 + d; const GAS bf16_t* qp_ = GQ + (mr_ + tq * 16) * 512 + d; const GAS bf16_t* vp_ = GV + (mr_ + tq * 16) * 512 + d; \
        _Pragma("unroll") for (int i_ = 0; i_ < 16; ++i_) { kr[i_] = kp_[(size_t)i_ * 512]; vr[i_] = vp_[(size_t)i_ * 512]; if (PASS_C) qr[i_] = qp_[(size_t)i_ * 512]; } \
        } while (0)
    GLA_FETCH(0);
    for (int c = 0; c < 4; ++c) {
        const size_t mrow = mbase + (size_t)c * 64;
        __syncthreads();
        if (tid < 256) { const GAS f32x4* sp = (const GAS f32x4*)(SMALL + (mrow + (tid >> 2)) * 32 + (tid & 3) * 4);
            *(LAS f32x4*)(GA + tid * 4) = (sp[0] + sp[small_off(1) / 16]) + (sp[small_off(2) / 16] + sp[small_off(3) / 16]); }
        __syncthreads();
        float cs[16]; float run = 0.f;
#pragma unroll
        for (int i = 0; i < 16; ++i) { const LAS f32x4* gp = (const LAS f32x4*)(GA + (tq * 16 + i) * 16); float z = ab;
#pragma unroll
            for (int r4 = 0; r4 < 4; ++r4) { const f32x4 g4 = gp[r4]; z += g4[0] * aup[4 * r4] + g4[1] * aup[4 * r4 + 1] + g4[2] * aup[4 * r4 + 2] + g4[3] * aup[4 * r4 + 3]; }
            const float la = (fminf(z, 0.f) - __logf(1.f + __expf(-fabsf(z)))) * (1.f / 16.f);
            run += la; cs[i] = run; }
        BC[tq * 128 + d] = run;
        __syncthreads();
        float off = 0.f, tot = 0.f;
#pragma unroll
        for (int q = 0; q < 4; ++q) { const float v = BC[q * 128 + d]; off += (q < tq) ? v : 0.f; tot += v; }
        if (tq == 0) { DEC[d] = __expf(tot); dsum += tot; }
        {
            unsigned ke[8], vv[8];
#pragma unroll
            for (int i2 = 0; i2 < 8; ++i2) {
                float kend[2]; unsigned vraw[2];
#pragma unroll
                for (int q2 = 0; q2 < 2; ++q2) { const int i = 2 * i2 + q2; const int j = tq * 16 + i;
                    const float kf = bf2f(kr[i]); const float bc = off + cs[i];
                    kend[q2] = kf * __expf(tot - bc); vraw[q2] = vr[i];
                    if (PASS_C) { const float qf = bf2f(qr[i]);
                        QD[j * P128 + d] = f2bf(qf * scale * __expf(bc)); KI[j * P128 + d] = f2bf(kf * __expf(-bc)); } }
                ke[i2] = cvt_pk_bf16(kend[0], kend[1]); vv[i2] = vraw[0] | (vraw[1] << 16);
            }
            LAS u32x4* kd = (LAS u32x4*)(KET + d * P64 + tq * 16); kd[0] = (u32x4){ke[0], ke[1], ke[2], ke[3]}; kd[1] = (u32x4){ke[4], ke[5], ke[6], ke[7]};
            LAS u32x4* vd = (LAS u32x4*)(VT + d * P64 + tq * 16); vd[0] = (u32x4){vv[0], vv[1], vv[2], vv[3]}; vd[1] = (u32x4){vv[4], vv[5], vv[6], vv[7]};
        }
        if (!PASS_C && c < 3) GLA_FETCH(c + 1);
        u32x2 graw4[4];
        if (PASS_C) { const int it_ = w >> 1, eh_ = w & 1;
#pragma unroll
            for (int et = 0; et < 4; ++et) graw4[et] = *(const GAS u32x2*)(GG + (mrow + 16 * it_ + lr) * 512 + 64 * eh_ + 16 * et + 4 * lg); }
        __syncthreads();
        if (PASS_C) {
            const int it = w >> 1, eh = w & 1;
            bf16x8 qb[4];
#pragma unroll
            for (int ks = 0; ks < 4; ++ks) qb[ks] = lds16(QD + (16 * it + lr) * P128 + 32 * ks + 8 * lg);
            f32x4 P[4];
#pragma unroll
            for (int j2 = 0; j2 < 2; ++j2) {
                bf16x8 ka[8];
#pragma unroll
                for (int jj = 0; jj < 2; ++jj)
#pragma unroll
                    for (int ks = 0; ks < 4; ++ks) ka[4 * jj + ks] = lds16(KI + (16 * (2 * j2 + jj) + lr) * P128 + 32 * ks + 8 * lg);
                __builtin_amdgcn_sched_barrier(0);
#pragma unroll
                for (int jj = 0; jj < 2; ++jj) { const int jt = 2 * j2 + jj; P[jt] = (f32x4){0.f, 0.f, 0.f, 0.f};
                    if (jt <= it) {
#pragma unroll
                        for (int ks = 0; ks < 4; ++ks) P[jt] = MFMA16(ka[4 * jj + ks], qb[ks], P[jt]);
                        if (jt == it) {
#pragma unroll
                            for (int r = 0; r < 4; ++r) if (4 * lg + r > lr) P[jt][r] = 0.f; }
                    } }
                __builtin_amdgcn_sched_barrier(0);
            }
            bf16x8 pb[2]; pb[0] = pack8(P[0], P[1]); pb[1] = pack8(P[2], P[3]);
            f32x4 o[4];
#pragma unroll
            for (int e2 = 0; e2 < 2; ++e2) {
                bf16x8 va[4], sa[8];
#pragma unroll
                for (int ee = 0; ee < 2; ++ee) { const int er = 64 * eh + 16 * (2 * e2 + ee) + lr;
#pragma unroll
                    for (int s2 = 0; s2 < 2; ++s2) va[2 * ee + s2] = lds8x2(VT + er * P64 + 32 * s2 + 4 * lg, VT + er * P64 + 32 * s2 + 16 + 4 * lg);
#pragma unroll
                    for (int ks = 0; ks < 4; ++ks) sa[4 * ee + ks] = lds16(ST + er * P128 + 32 * ks + 8 * lg); }
                __builtin_amdgcn_sched_barrier(0);
#pragma unroll
                for (int ee = 0; ee < 2; ++ee) { f32x4 a = (f32x4){0.f, 0.f, 0.f, 0.f};
#pragma unroll
                    for (int s2 = 0; s2 < 2; ++s2) a = MFMA16(va[2 * ee + s2], pb[s2], a);
#pragma unroll
                    for (int ks = 0; ks < 4; ++ks) a = MFMA16(sa[4 * ee + ks], qb[ks], a);
                    o[2 * e2 + ee] = a; }
                __builtin_amdgcn_sched_barrier(0);
            }
            if (c < 3) GLA_FETCH(c + 1);
            float ssq = 0.f;
#pragma unroll
            for (int et = 0; et < 4; ++et) ssq += (o[et][0] * o[et][0] + o[et][1] * o[et][1]) + (o[et][2] * o[et][2] + o[et][3] * o[et][3]);
            ssq += __shfl_xor(ssq, 16); ssq += __shfl_xor(ssq, 32);
            if (lg == 0) NRM[eh * 64 + 16 * it + lr] = ssq;
            __syncthreads();
            const float rstd = rsqrtf((NRM[16 * it + lr] + NRM[64 + 16 * it + lr]) * (1.f / 128.f) + EPS_);
            const float* gn = args.in[5] + (size_t)l * 128;
#pragma unroll
            for (int et = 0; et < 4; ++et) { const int e0 = 64 * eh + 16 * et + 4 * lg; GAS bf16_t* gp = GG + (mrow + 16 * it + lr) * 512 + e0;
                const u32x2 graw = graw4[et]; const f32x4 gnv = *(const GAS f32x4*)(gn + e0);
                const float g0 = bf_lo(graw.x), g1 = bf_hi(graw.x), g2 = bf_lo(graw.y), g3 = bf_hi(graw.y);
                const float y0 = o[et][0] * rstd * gnv[0] * (g0 * fast_sigmoid(g0)), y1 = o[et][1] * rstd * gnv[1] * (g1 * fast_sigmoid(g1));
                const float y2 = o[et][2] * rstd * gnv[2] * (g2 * fast_sigmoid(g2)), y3 = o[et][3] * rstd * gnv[3] * (g3 * fast_sigmoid(g3));
                u32x2 yo; yo.x = cvt_pk_bf16(y0, y1); yo.y = cvt_pk_bf16(y2, y3); *(GAS u32x2*)gp = yo; }
        }
        {
            f32x4 dv4;
#pragma unroll
            for (int r = 0; r < 4; ++r) dv4[r] = DEC[16 * w + 4 * lg + r];
#pragma unroll
            for (int et = 0; et < 8; ++et) S[et] = S[et] * dv4;
            {
                bf16x8 ka[2], vb[16];
#pragma unroll
                for (int s2 = 0; s2 < 2; ++s2) { ka[s2] = lds16(KET + (16 * w + lr) * P64 + 32 * s2 + 8 * lg);
#pragma unroll
                    for (int et = 0; et < 8; ++et) vb[8 * s2 + et] = lds16(VT + (16 * et + lr) * P64 + 32 * s2 + 8 * lg); }
                __builtin_amdgcn_sched_barrier(0);
#pragma unroll
                for (int s2 = 0; s2 < 2; ++s2)
#pragma unroll
                    for (int et = 0; et < 8; ++et) S[et] = MFMA16(ka[s2], vb[8 * s2 + et], S[et]);
                __builtin_amdgcn_sched_barrier(0);
            }
            if (PASS_C) {
#pragma unroll
                for (int et = 0; et < 8; ++et) { u32x2 pk; pk.x = cvt_pk_bf16(S[et][0], S[et][1]); pk.y = cvt_pk_bf16(S[et][2], S[et][3]);
                    *(LAS u32x2*)(ST + (16 * et + lr) * P128 + 16 * w + 4 * lg) = pk; }
            }
        }
    }
    if (!PASS_C) {
#pragma unroll
        for (int et = 0; et < 8; ++et)
#pragma unroll
            for (int r = 0; r < 4; ++r) KV[(size_t)(16 * w + 4 * lg + r) * 128 + 16 * et + lr] = S[et][r];
        if (tq == 0) DT[d] = __expf(dsum);
    }
    __syncthreads();
}
__device__ __forceinline__ void gla_scan(const Args& args, int gtid, int gthreads) {
    GAS float* KV = (GAS float*)(args.ws + WS_SCR + SCR_GLA_KV); const GAS float* DT = (const GAS float*)(args.ws + WS_MISC + MISC_GLA_DT);
    for (int idx = gtid; idx < 8 * 16384; idx += gthreads) {
        const int bh = idx >> 14, de = idx & 16383, dd = de >> 7;
        float kv[32], dt[32];
#pragma unroll
        for (int s = 0; s < 32; ++s) { kv[s] = KV[(size_t)(bh * 32 + s) * 16384 + de]; dt[s] = DT[(bh * 32 + s) * 128 + dd]; }
        float st = 0.f;
#pragma unroll
        for (int s = 0; s < 32; ++s) { KV[(size_t)(bh * 32 + s) * 16384 + de] = st; st = dt[s] * st + kv[s]; }
    }
}
}
namespace mk {
constexpr size_t SCR_ML_KV = 52 * MiB;
constexpr size_t MISC_ML_MS = 512 * 1024;
constexpr int ML_QW = 0, ML_QR = 9216, ML_KS = 18432, ML_KWT = 27648, ML_VT = 36864, ML_ST = 57600, ML_SC = 78336, ML_NRM = 79872, ML_END = 80384;

__device__ __forceinline__ float wave_incl_sum(float x, int lane) {
#pragma unroll
    for (int o = 1; o < 64; o <<= 1) { const float v = __shfl_up(x, o); if (lane >= o) x += v; }
    return x;
}
__device__ __forceinline__ float wave_incl_max(float x, int lane) {
#pragma unroll
    for (int o = 1; o < 64; o <<= 1) { const float v = __shfl_up(x, o); if (lane >= o) x = fmaxf(x, v); }
    return x;
}

template <bool PASS_C>
__device__ __forceinline__ void ml_unit(LAS unsigned char* lds, const Args& args, int l, int u, int wv) {
    int tid_ = (wv << 6) | lane_id(); asm volatile("" : "+v"(tid_));
    const int tid = tid_, lane = tid & 63, w = __builtin_amdgcn_readfirstlane(tid >> 6), lr = lane & 15, lg = lane >> 4;
    const int bh = u >> 5, sc = u & 31, b = bh >> 2, h = bh & 3;
    const int t0 = sc * 256;
    const size_t mbase = (size_t)b * T_ + (size_t)t0;
    GAS unsigned char* ws = (GAS unsigned char*)args.ws; asm volatile("" : "+s"(ws));
    const GAS bf16_t* LQ = (const GAS bf16_t*)(ws + WS_SEG + SEG_LQ) + h * 64; const GAS bf16_t* LK = (const GAS bf16_t*)(ws + WS_SEG + SEG_LK) + h * 64;
    const GAS bf16_t* LV = (const GAS bf16_t*)(ws + WS_SEG + SEG_LV) + h * 128; GAS bf16_t* LO = (GAS bf16_t*)(ws + WS_SEG + SEG_LO) + h * 128;
    const GAS float* SMALL = (const GAS float*)(ws + WS_SMALL);
    GAS float* KVM = (GAS float*)(ws + WS_SCR + SCR_ML_KV) + (size_t)u * (64 * 144); GAS float* MS = (GAS float*)(ws + WS_MISC + MISC_ML_MS) + (size_t)u * 4;
    LAS bf16_t* QW = (LAS bf16_t*)(lds + ML_QW); LAS bf16_t* QR = (LAS bf16_t*)(lds + ML_QR); LAS bf16_t* KS = (LAS bf16_t*)(lds + ML_KS);
    LAS bf16_t* KWT = (LAS bf16_t*)(lds + ML_KWT); LAS bf16_t* VT = (LAS bf16_t*)(lds + ML_VT); LAS bf16_t* ST = (LAS bf16_t*)(lds + ML_ST);
    LAS float* SU = (LAS float*)(lds + ML_SC);
    LAS float* NRM = (LAS float*)(lds + ML_NRM);
    const int ch = tid & 127, tq = tid >> 7;
    float cw[4];
    { const int cidx = (ch < 64) ? (h * 64 + ch) : (256 + h * 64 + (ch - 64)); const float* cwp = args.in[8] + (size_t)l * 4 * 512 + cidx;
#pragma unroll
      for (int j = 0; j < 4; ++j) cw[j] = cwp[j * 512]; }
    const float ib = args.in[9][l * 4 + h], fb = args.in[10][l * 4 + h];
    const int dt = w & 3, eb = (w >> 2) * 4;
    f32x4 S[5];
    float m_prev;
    if (PASS_C) {
        m_prev = MS[2];
#pragma unroll
        for (int k = 0; k < 5; ++k) { const int et = (k < 4) ? (eb + k) : 8;
            if (k < 4 || w < 4) {
#pragma unroll
                for (int r = 0; r < 4; ++r) S[k][r] = KVM[(size_t)(16 * dt + 4 * lg + r) * 144 + 16 * et + lr];
                u32x2 pk; pk.x = cvt_pk_bf16(S[k][0], S[k][1]); pk.y = cvt_pk_bf16(S[k][2], S[k][3]);
                *(LAS u32x2*)(ST + (16 * et + lr) * P64 + 16 * dt + 4 * lg) = pk;
            } else S[k] = (f32x4){0.f, 0.f, 0.f, 0.f}; }
    } else {
        m_prev = -1e30f;
#pragma unroll
        for (int k = 0; k < 5; ++k) S[k] = (f32x4){0.f, 0.f, 0.f, 0.f};
    }
    for (int i = tid; i < 16 * P64; i += NTHREADS) VT[128 * P64 + i] = (i < 64) ? (bf16_t)0x3f80 : (bf16_t)0;
    float bsum = 0.f;
    bf16_t xr[19], vr[16]; float lfr = 0.f, lir = 0.f;
    const GAS bf16_t* srcp = (ch < 64) ? (LQ + ch) : (LK + (ch - 64));
#define ML_FETCH(cn) do { const size_t mr_ = mbase + (size_t)(cn) * 64; \
        _Pragma("unroll") for (int i_ = 0; i_ < 19; ++i_) { const int tt_ = (cn) * 64 + tq * 16 - 3 + i_; xr[i_] = (t0 + tt_ >= 0) ? srcp[(ptrdiff_t)(mbase + tt_) * 256] : (bf16_t)0; } \
        const GAS bf16_t* vp_ = LV + (mr_ + tq * 16) * 512 + ch; \
        _Pragma("unroll") for (int i_ = 0; i_ < 16; ++i_) vr[i_] = vp_[(size_t)i_ * 512]; \
        { const GAS float* sp_ = SMALL + (mr_ + lane) * 32 + h; \
          lfr = (sp_[20] + sp_[small_off(1) / 4 + 20]) + (sp_[small_off(2) / 4 + 20] + sp_[small_off(3) / 4 + 20]); lir = (sp_[16] + sp_[small_off(1) / 4 + 16]) + (sp_[small_off(2) / 4 + 16] + sp_[small_off(3) / 4 + 16]); } } while (0)
    ML_FETCH(0);
    for (int c = 0; c < 4; ++c) {
        const size_t mrow = mbase + (size_t)c * 64;
        const float lf = ({ const float z = lfr + fb; fminf(z, 0.f) - __logf(1.f + __expf(-fabsf(z))); });
        const float li = lir + ib;
        const float bcum = wave_incl_sum(lf, lane);
        const float uj = li - bcum;
        const float pmax = wave_incl_max(uj, lane);
        const float b_last = __shfl(bcum, 63), pm63 = __shfl(pmax, 63);
        const float gi = fmaxf(m_prev, pmax);
        const float m_new = fmaxf(b_last + m_prev, b_last + pm63);
        const float a_scale = __expf(b_last + m_prev - m_new);
        __syncthreads();
        if (w == 0) { SU[lane] = uj; SU[64 + lane] = gi; SU[128 + lane] = __expf(m_prev - gi); SU[192 + lane] = __expf(-(bcum + gi)); SU[256 + lane] = __expf(b_last + uj - m_new); }
        __syncthreads();
        {
            float xv[19];
#pragma unroll
            for (int i = 0; i < 19; ++i) xv[i] = bf2f(xr[i]);
            unsigned kw[8];
#pragma unroll
            for (int i2 = 0; i2 < 8; ++i2) { float kwv[2];
#pragma unroll
                for (int q2 = 0; q2 < 2; ++q2) { const int i = 2 * i2 + q2, j = tq * 16 + i;
                    const float cv = cw[0] * xv[i] + cw[1] * xv[i + 1] + cw[2] * xv[i + 2] + cw[3] * xv[i + 3];
                    if (ch < 64) { if (PASS_C) { QR[j * P64 + ch] = f2bf(cv); QW[j * P64 + ch] = f2bf(cv * SU[128 + j]); } kwv[q2] = 0.f; }
                    else { const float kv = cv * 0.125f; if (PASS_C) KS[j * P64 + (ch - 64)] = f2bf(kv); kwv[q2] = kv * SU[256 + j]; } }
                kw[i2] = cvt_pk_bf16(kwv[0], kwv[1]); }
            if (ch >= 64) { LAS u32x4* kd = (LAS u32x4*)(KWT + (ch - 64) * P64 + tq * 16); kd[0] = (u32x4){kw[0], kw[1], kw[2], kw[3]}; kd[1] = (u32x4){kw[4], kw[5], kw[6], kw[7]}; }
            unsigned vv[8];
#pragma unroll
            for (int i2 = 0; i2 < 8; ++i2) vv[i2] = (unsigned)vr[2 * i2] | ((unsigned)vr[2 * i2 + 1] << 16);
            LAS u32x4* vd = (LAS u32x4*)(VT + ch * P64 + tq * 16); vd[0] = (u32x4){vv[0], vv[1], vv[2], vv[3]}; vd[1] = (u32x4){vv[4], vv[5], vv[6], vv[7]};
        }
        if (!PASS_C && c < 3) ML_FETCH(c + 1);
        u32x2 graw4[4];
        if (PASS_C) { const int it_ = w >> 1, eh_ = w & 1;
#pragma unroll
            for (int k = 0; k < 4; ++k) graw4[k] = *(const GAS u32x2*)(LO + (mrow + 16 * it_ + lr) * 512 + 64 * eh_ + 16 * k + 4 * lg); }
        __syncthreads();
        if (PASS_C) {
            const int it = w >> 1, eh = w & 1;
            bf16x8 qr[2], qw[2];
#pragma unroll
            for (int ks = 0; ks < 2; ++ks) { qr[ks] = lds16(QR + (16 * it + lr) * P64 + 32 * ks + 8 * lg); qw[ks] = lds16(QW + (16 * it + lr) * P64 + 32 * ks + 8 * lg); }
            const float g_i = SU[64 + 16 * it + lr];
            f32x4 P[4];
            {
                bf16x8 ka[8]; f32x4 u4[4];
#pragma unroll
                for (int jt = 0; jt < 4; ++jt) { u4[jt] = *(const LAS f32x4*)(SU + 16 * jt + 4 * lg);
#pragma unroll
                    for (int ks = 0; ks < 2; ++ks) ka[2 * jt + ks] = lds16(KS + (16 * jt + lr) * P64 + 32 * ks + 8 * lg); }
                __builtin_amdgcn_sched_barrier(0);
#pragma unroll
                for (int jt = 0; jt < 4; ++jt) { P[jt] = (f32x4){0.f, 0.f, 0.f, 0.f};
                    if (jt <= it) {
#pragma unroll
                        for (int ks = 0; ks < 2; ++ks) P[jt] = MFMA16(ka[2 * jt + ks], qr[ks], P[jt]);
#pragma unroll
                        for (int r = 0; r < 4; ++r) { const float f = __expf(u4[jt][r] - g_i); P[jt][r] = (jt == it && 4 * lg + r > lr) ? 0.f : P[jt][r] * f; }
                    } }
            }
            bf16x8 pb[2]; pb[0] = pack8(P[0], P[1]); pb[1] = pack8(P[2], P[3]);
            f32x4 o[5];
            {
                bf16x8 va[10], sa[10];
#pragma unroll
                for (int k = 0; k < 5; ++k) { const int er = (k < 4 ? 64 * eh + 16 * k : 128) + lr;
#pragma unroll
                    for (int s2 = 0; s2 < 2; ++s2) { va[2 * k + s2] = lds8x2(VT + er * P64 + 32 * s2 + 4 * lg, VT + er * P64 + 32 * s2 + 16 + 4 * lg); sa[2 * k + s2] = lds16(ST + er * P64 + 32 * s2 + 8 * lg); } }
                __builtin_amdgcn_sched_barrier(0);
#pragma unroll
                for (int k = 0; k < 5; ++k) { f32x4 a = (f32x4){0.f, 0.f, 0.f, 0.f};
#pragma unroll
                    for (int s2 = 0; s2 < 2; ++s2) a = MFMA16(va[2 * k + s2], pb[s2], a);
#pragma unroll
                    for (int s2 = 0; s2 < 2; ++s2) a = MFMA16(sa[2 * k + s2], qw[s2], a);
                    o[k] = a; }
                __builtin_amdgcn_sched_barrier(0);
            }
            if (c < 3) ML_FETCH(c + 1);
            const float den = __shfl(o[4][0], lr);
            const float rden = 1.f / fmaxf(fabsf(den), SU[192 + 16 * it + lr]);
            float ssq = 0.f;
#pragma unroll
            for (int k = 0; k < 4; ++k) { o[k] = o[k] * rden; ssq += (o[k][0] * o[k][0] + o[k][1] * o[k][1]) + (o[k][2] * o[k][2] + o[k][3] * o[k][3]); }
            ssq += __shfl_xor(ssq, 16); ssq += __shfl_xor(ssq, 32);
            if (lg == 0) NRM[eh * 64 + 16 * it + lr] = ssq;
            __syncthreads();
            const float rstd = rsqrtf((NRM[16 * it + lr] + NRM[64 + 16 * it + lr]) * (1.f / 128.f) + EPS_);
            const float* gn = args.in[11] + (size_t)l * 128;
#pragma unroll
            for (int k = 0; k < 4; ++k) { const int e0 = 64 * eh + 16 * k + 4 * lg; GAS bf16_t* gp = LO + (mrow + 16 * it + lr) * 512 + e0;
                const u32x2 graw = graw4[k]; const f32x4 gnv = *(const GAS f32x4*)(gn + e0);
                const float y0 = o[k][0] * rstd * gnv[0] * fast_sigmoid(bf_lo(graw.x)), y1 = o[k][1] * rstd * gnv[1] * fast_sigmoid(bf_hi(graw.x));
                const float y2 = o[k][2] * rstd * gnv[2] * fast_sigmoid(bf_lo(graw.y)), y3 = o[k][3] * rstd * gnv[3] * fast_sigmoid(bf_hi(graw.y));
                u32x2 yo; yo.x = cvt_pk_bf16(y0, y1); yo.y = cvt_pk_bf16(y2, y3); *(GAS u32x2*)gp = yo; }
        }
        {
#pragma unroll
            for (int k = 0; k < 5; ++k) S[k] = S[k] * a_scale;
            {
                bf16x8 ka[2], vb[10];
#pragma unroll
                for (int s2 = 0; s2 < 2; ++s2) { ka[s2] = lds16(KWT + (16 * dt + lr) * P64 + 32 * s2 + 8 * lg);
#pragma unroll
                    for (int k = 0; k < 5; ++k) { const int et = (k < 4) ? (eb + k) : 8; vb[5 * s2 + k] = lds16(VT + (16 * et + lr) * P64 + 32 * s2 + 8 * lg); } }
                __builtin_amdgcn_sched_barrier(0);
#pragma unroll
                for (int s2 = 0; s2 < 2; ++s2)
#pragma unroll
                    for (int k = 0; k < 5; ++k) if (k < 4 || w < 4) S[k] = MFMA16(ka[s2], vb[5 * s2 + k], S[k]);
                __builtin_amdgcn_sched_barrier(0);
            }
            if (PASS_C) {
#pragma unroll
                for (int k = 0; k < 5; ++k) { const int et = (k < 4) ? (eb + k) : 8;
                    if (k < 4 || w < 4) { u32x2 pk; pk.x = cvt_pk_bf16(S[k][0], S[k][1]); pk.y = cvt_pk_bf16(S[k][2], S[k][3]);
                        *(LAS u32x2*)(ST + (16 * et + lr) * P64 + 16 * dt + 4 * lg) = pk; } }
            }
        }
        m_prev = m_new; bsum += b_last;
    }
    if (!PASS_C) {
#pragma unroll
        for (int k = 0; k < 5; ++k) { const int et = (k < 4) ? (eb + k) : 8;
            if (k < 4 || w < 4) {
#pragma unroll
                for (int r = 0; r < 4; ++r) KVM[(size_t)(16 * dt + 4 * lg + r) * 144 + 16 * et + lr] = S[k][r]; } }
        if (tid == 0) { MS[0] = m_prev; MS[1] = bsum; }
    }
    __syncthreads();
}
__device__ __forceinline__ void ml_scan(const Args& args, int gtid, int gthreads) {
    GAS float* KVM = (GAS float*)(args.ws + WS_SCR + SCR_ML_KV); GAS float* MS = (GAS float*)(args.ws + WS_MISC + MISC_ML_MS);
    for (int idx = gtid; idx < 8 * 9216; idx += gthreads) {
        const int bh = idx / 9216, de = idx % 9216;
        float kv[32], ml[32], Bv[32];
#pragma unroll
        for (int s = 0; s < 32; ++s) { const int u = bh * 32 + s; kv[s] = KVM[(size_t)u * 9216 + de]; ml[s] = MS[u * 4 + 0]; Bv[s] = MS[u * 4 + 1]; }
        float st = 0.f, m = 0.f;
#pragma unroll
        for (int s = 0; s < 32; ++s) { const int u = bh * 32 + s;
            KVM[(size_t)u * 9216 + de] = st; if (de == 0) MS[u * 4 + 2] = m;
            const float mn = fmaxf(Bv[s] + m, ml[s]);
            st = __expf(Bv[s] + m - mn) * st + __expf(ml[s] - mn) * kv[s]; m = mn; }
    }
}
}
namespace mk {
constexpr size_t WS_PO = WS_ACT;
constexpr size_t WS_PML = WS_ACT + 64 * MiB;
constexpr size_t CTL_KMP = 512 * 1024;
constexpr size_t MISC_PAIRS = 1 * MiB;
constexpr size_t MISC_CELL = 1 * MiB + 800 * 1024;
constexpr int CW_MBQ = 1024;
static_assert(WS_PML + 4 * MiB <= WS_SCR + SCR_GLA_KV, "MoBA partials end below the GLA state buffer");
constexpr int MB_NUNITS = 16 * 52;
constexpr int MC_K = 0, MC_KP = 72, MC_VT = 36864, MC_VP = 264, MC_QL = 36864 + 33792, MC_CTL = MC_QL + 32768, MC_END = MC_CTL + 512;

__device__ __forceinline__ void mb_prep_unit(LAS unsigned char* lds, const Args& args, int l, int u, int wv) {
    int tid_ = (wv << 6) | lane_id(); asm volatile("" : "+v"(tid_));
    const int tid = tid_, lane = tid & 63, w = __builtin_amdgcn_readfirstlane(tid >> 6);
    const int b = u >> 7, blk = (u >> 2) & 31, qr = u & 3;
    GAS unsigned char* ws = (GAS unsigned char*)args.ws; asm volatile("" : "+s"(ws));
    GAS bf16_t* MQ = (GAS bf16_t*)(ws + WS_SEG + SEG_MQ); GAS bf16_t* MK = (GAS bf16_t*)(ws + WS_SEG + SEG_MK);
    const GAS float* COS = (const GAS float*)(ws + WS_ROPE); const GAS float* SIN = COS + 8192 * 32;
    GAS float* KMP = (GAS float*)(ws + WS_CTL + CTL_KMP);
    LAS float* RED = (LAS float*)lds;
    const int d0 = (lane & 7) * 8;
    float gq[8], gk[8], ks[8];
#pragma unroll
    for (int k = 0; k < 8; ++k) { gq[k] = args.in[6][l * 64 + d0 + k]; gk[k] = args.in[7][l * 64 + d0 + k]; ks[k] = 0.f; }
    const bool lo = (lane & 4) == 0;
    for (int i = 0; i < 8; ++i) {
        const int t = blk * 256 + qr * 64 + w * 8 + i; const size_t m = (size_t)b * T_ + t;
        const f32x4 c0 = *(const GAS f32x4*)(COS + t * 32 + (d0 & 31)), c1 = *(const GAS f32x4*)(COS + t * 32 + (d0 & 31) + 4);
        const f32x4 s0 = *(const GAS f32x4*)(SIN + t * 32 + (d0 & 31)), s1 = *(const GAS f32x4*)(SIN + t * 32 + (d0 & 31) + 4);
        const float cs[8] = {c0[0], c0[1], c0[2], c0[3], c1[0], c1[1], c1[2], c1[3]}, sn[8] = {s0[0], s0[1], s0[2], s0[3], s1[0], s1[1], s1[2], s1[3]};
#pragma unroll
        for (int which = 0; which < 2; ++which) {
            GAS bf16_t* p = (which ? MK : MQ) + m * 512 + 8 * lane;
            const u32x4 raw = *(const GAS u32x4*)p;
            float x[8] = {bf_lo(raw.x), bf_hi(raw.x), bf_lo(raw.y), bf_hi(raw.y), bf_lo(raw.z), bf_hi(raw.z), bf_lo(raw.w), bf_hi(raw.w)};
            float ss = 0.f;
#pragma unroll
            for (int k = 0; k < 8; ++k) ss += x[k] * x[k];
            ss += __shfl_xor(ss, 1); ss += __shfl_xor(ss, 2); ss += __shfl_xor(ss, 4);
            const float r = rsqrtf(ss * (1.f / 64.f) + EPS_);
            float y[8];
#pragma unroll
            for (int k = 0; k < 8; ++k) { const float v = x[k] * r * (which ? gk[k] : gq[k]); const float other = __shfl_xor(v, 4);
                y[k] = lo ? (v * cs[k] - other * sn[k]) : (v * cs[k] + other * sn[k]); }
            u32x4 o; o.x = cvt_pk_bf16(y[0], y[1]); o.y = cvt_pk_bf16(y[2], y[3]); o.z = cvt_pk_bf16(y[4], y[5]); o.w = cvt_pk_bf16(y[6], y[7]);
            *(GAS u32x4*)p = o;
            if (which) {
#pragma unroll
                for (int k = 0; k < 8; ++k) ks[k] += y[k]; }
        }
    }
    __syncthreads();
#pragma unroll
    for (int k = 0; k < 8; ++k) RED[w * 512 + 8 * lane + k] = ks[k];
    __syncthreads();
    { float s = 0.f;
#pragma unroll
      for (int ww = 0; ww < 8; ++ww) s += RED[ww * 512 + tid];
      KMP[((size_t)(b * 32 + blk) * 4 + qr) * 512 + tid] = s; }
    __syncthreads();
}

__device__ __forceinline__ void mb_topk_unit(LAS unsigned char* lds, const Args& args, int u, int wv) {
    int tid_ = (wv << 6) | lane_id(); asm volatile("" : "+v"(tid_));
    const int tid = tid_, lane = tid & 63;
    const int b = u >> 7, i = (u >> 2) & 31, hp = u & 3;
    const int hh = tid >> 8, head = 2 * hp + hh, tq = tid & 255, w4 = (tid >> 6) & 3;
    GAS unsigned char* ws = (GAS unsigned char*)args.ws; asm volatile("" : "+s"(ws));
    const GAS bf16_t* QN = (const GAS bf16_t*)(ws + WS_SEG + SEG_MQ);
    const GAS float* KMP = (const GAS float*)(ws + WS_CTL + CTL_KMP);
    GAS bf16_t* PAIRS = (GAS bf16_t*)(ws + WS_MISC + MISC_PAIRS) + ((size_t)(b * 8 + head) * 32 + i) * 768;
    GAS bf16_t* CELL = (GAS bf16_t*)(ws + WS_MISC + MISC_CELL) + ((size_t)(b * 8 + head) * 32 + i) * 34;
    LAS float* KMS = (LAS float*)lds;
    LAS unsigned* CNT = (LAS unsigned*)(lds + 16384);
    LAS unsigned* CO = (LAS unsigned*)(lds + 16384 + 1024);
    __syncthreads();
#pragma unroll
    for (int k = 0; k < 8; ++k) { const int e = tid + 512 * k, hx = e >> 11, jj = (e >> 6) & 31, dd = e & 63;
        const GAS float* kp = KMP + (size_t)(b * 32 + jj) * 2048 + (2 * hp + hx) * 64 + dd;
        KMS[e] = ((kp[0] + kp[512]) + (kp[1024] + kp[1536])) * (1.f / 256.f); }
    if (tid < 256) CNT[tid] = 0u;
    float q[64];
    { const GAS bf16_t* qp = QN + ((size_t)b * T_ + i * 256 + tq) * 512 + head * 64;
#pragma unroll
      for (int c = 0; c < 8; ++c) { const u32x4 raw = *(const GAS u32x4*)(qp + 8 * c);
          q[8 * c] = bf_lo(raw.x); q[8 * c + 1] = bf_hi(raw.x); q[8 * c + 2] = bf_lo(raw.y); q[8 * c + 3] = bf_hi(raw.y);
          q[8 * c + 4] = bf_lo(raw.z); q[8 * c + 5] = bf_hi(raw.z); q[8 * c + 6] = bf_lo(raw.w); q[8 * c + 7] = bf_hi(raw.w); } }
    __syncthreads();
    float v0 = -INFINITY, v1 = -INFINITY, v2 = -INFINITY; int j0 = -1, j1 = -1, j2 = -1;
    for (int j = 0; j < i; ++j) {
        const LAS f32x4* kp = (const LAS f32x4*)(KMS + (hh * 32 + j) * 64); float s = 0.f;
#pragma unroll
        for (int c = 0; c < 16; ++c) { const f32x4 k4 = kp[c]; s += q[4 * c] * k4[0] + q[4 * c + 1] * k4[1] + q[4 * c + 2] * k4[2] + q[4 * c + 3] * k4[3]; }
        if (s > v2) { if (s > v1) { v2 = v1; j2 = j1; if (s > v0) { v1 = v0; j1 = j0; v0 = s; j0 = j; } else { v1 = s; j1 = j; } } else { v2 = s; j2 = j; } }
    }
    int rk0 = 0, rk1 = 0, rk2 = 0;
    for (int j = 0; j < i; ++j) {
        const bool pr = (j0 == j) || (j1 == j) || (j2 == j);
        const unsigned long long mask = __ballot(pr);
        const int rank = __popcll(mask & ((1ull << lane) - 1ull));
        if (j0 == j) rk0 = rank; if (j1 == j) rk1 = rank; if (j2 == j) rk2 = rank;
        if (lane == 0) CNT[(hh * 4 + w4) * 32 + j] = (unsigned)__popcll(mask);
    }
    __syncthreads();
    if (tid < 2) { unsigned run = 0u;
        for (int j = 0; j < 32; ++j) { CO[tid * 34 + j] = run; run += CNT[(tid * 4 + 0) * 32 + j] + CNT[(tid * 4 + 1) * 32 + j] + CNT[(tid * 4 + 2) * 32 + j] + CNT[(tid * 4 + 3) * 32 + j]; }
        CO[tid * 34 + 32] = run; }
    __syncthreads();
#define MB_EMIT(jj, rk, slot) do { if ((jj) >= 0) { unsigned pos = CO[hh * 34 + (jj)] + (rk); \
        for (int ww = 0; ww < 4; ++ww) pos += (ww < w4) ? CNT[(hh * 4 + ww) * 32 + (jj)] : 0u; \
        PAIRS[pos] = (bf16_t)(tq | ((slot) << 8)); } } while (0)
    MB_EMIT(j0, rk0, 0); MB_EMIT(j1, rk1, 1); MB_EMIT(j2, rk2, 2);
#undef MB_EMIT
    if (tq < 33) CELL[tq] = (bf16_t)CO[hh * 34 + tq];
    __syncthreads();
}

#ifndef PROBE_MASK
#define PROBE_MASK 0u
#endif
#ifndef PROBE_K
#define PROBE_K 2
#endif
#define PBU_BEGIN(x) unsigned long long pbu_t0_##x = 0ull; if ((PROBE_MASK >> (x)) & 1u) pbu_t0_##x = __builtin_amdgcn_s_memrealtime()
#define PBU_END(x) do { if ((PROBE_MASK >> (x)) & 1u) { const unsigned long long t1_ = __builtin_amdgcn_s_memrealtime(); const unsigned long long until_ = t1_ + (unsigned long long)PROBE_K * (t1_ - pbu_t0_##x); \
    while (__builtin_amdgcn_s_memrealtime() < until_) __builtin_amdgcn_s_sleep(8); } } while (0)
__device__ __forceinline__ float vmax3(float a, float b, float c) { float r; asm("v_max3_f32 %0, %1, %2, %3" : "=v"(r) : "v"(a), "v"(b), "v"(c)); return r; }
struct MbUnit { int b, h, j, part, np; };
__device__ __forceinline__ MbUnit mb_decode(int q) {
    MbUnit u; const int bh = q & 15, rr = q >> 4; u.b = bh >> 3; u.h = bh & 7;
    if (rr < 16) { u.j = rr >> 2; u.part = rr & 3; u.np = 4; } else if (rr < 32) { u.j = 4 + ((rr - 16) >> 1); u.part = (rr - 16) & 1; u.np = 2; } else { u.j = 12 + (rr - 32); u.part = 0; u.np = 1; }
    return u;
}
__device__ __forceinline__ void mb_kv_load(const Args& args, int q, int tid, u32x4 (&kr)[4], u32x4 (&vr)[4]) {
    const MbUnit u = mb_decode(q);
    GAS unsigned char* ws = (GAS unsigned char*)args.ws; asm volatile("" : "+s"(ws));
    const GAS bf16_t* KN = (const GAS bf16_t*)(ws + WS_SEG + SEG_MK) + u.h * 64; const GAS bf16_t* MV = (const GAS bf16_t*)(ws + WS_SEG + SEG_MV) + u.h * 64;
    const size_t krow0 = (size_t)u.b * T_ + (size_t)u.j * 256;
#pragma unroll
    for (int k = 0; k < 4; ++k) { const int id = tid + 512 * k, row = id >> 3, c8 = id & 7;
        kr[k] = *(const GAS u32x4*)(KN + (krow0 + row) * 512 + 8 * c8); vr[k] = *(const GAS u32x4*)(MV + (krow0 + row) * 512 + 8 * c8); }
}
__device__ __forceinline__ void mb_attn_unit(LAS unsigned char* lds, const Args& args, int q, int wv, int l, int& qnext) {
    int tid_ = (wv << 6) | lane_id(); asm volatile("" : "+v"(tid_));
    const int tid = tid_, lane = tid & 63, w = __builtin_amdgcn_readfirstlane(tid >> 6), lr = lane & 15, lg = lane >> 4;
    const MbUnit un = mb_decode(q); const int b = un.b, h = un.h, j = un.j, part = un.part, np = un.np, bh = b * 8 + h;
    GAS unsigned char* ws = (GAS unsigned char*)args.ws; asm volatile("" : "+s"(ws));
    const GAS bf16_t* QN = (const GAS bf16_t*)(ws + WS_SEG + SEG_MQ) + h * 64;
    const GAS bf16_t* PAIRS = (const GAS bf16_t*)(ws + WS_MISC + MISC_PAIRS) + (size_t)bh * 32 * 768; const GAS bf16_t* CELL = (const GAS bf16_t*)(ws + WS_MISC + MISC_CELL) + (size_t)bh * 32 * 34;
    GAS bf16_t* PO = (GAS bf16_t*)(ws + WS_PO); GAS float* PML = (GAS float*)(ws + WS_PML);
    LAS bf16_t* KJ = (LAS bf16_t*)(lds + MC_K); LAS bf16_t* VT = (LAS bf16_t*)(lds + MC_VT); LAS unsigned* QL = (LAS unsigned*)(lds + MC_QL); LAS unsigned* CT = (LAS unsigned*)(lds + MC_CTL);
    PBU_BEGIN(16);
    u32x4 kr[4], vr[4];
    mb_kv_load(args, q, tid, kr, vr);
    __syncthreads();
#pragma unroll
    for (int k = 0; k < 4; ++k) { const int id = tid + 512 * k, row = id >> 3, c8 = id & 7;
        *(LAS u32x4*)(KJ + row * MC_KP + 8 * c8) = kr[k];
        const u32x4 vv = vr[k];
        LAS bf16_t* vt = VT + (8 * c8) * MC_VP + row;
        vt[0 * MC_VP] = (bf16_t)(vv.x & 0xffffu); vt[1 * MC_VP] = (bf16_t)(vv.x >> 16); vt[2 * MC_VP] = (bf16_t)(vv.y & 0xffffu); vt[3 * MC_VP] = (bf16_t)(vv.y >> 16);
        vt[4 * MC_VP] = (bf16_t)(vv.z & 0xffffu); vt[5 * MC_VP] = (bf16_t)(vv.z >> 16); vt[6 * MC_VP] = (bf16_t)(vv.w & 0xffffu); vt[7 * MC_VP] = (bf16_t)(vv.w >> 16); }
    if (tid == 0) CT[100] = __hip_atomic_fetch_add((GAS unsigned*)((GAS unsigned*)ws + CW_MBQ + 64 * l), 1u, __ATOMIC_RELAXED, __HIP_MEMORY_SCOPE_AGENT);
    if (tid < 256) QL[tid] = (unsigned)(j * 256 + tid) | (3u << 13);
    if (tid < 64) { const int i = tid & 31; unsigned c0 = 0u, cnt = 0u;
        if (i > j) { c0 = CELL[i * 34 + j]; cnt = (unsigned)CELL[i * 34 + j + 1] - c0; }
        unsigned inc = cnt;
#pragma unroll
        for (int o = 1; o < 32; o <<= 1) { const unsigned v = __shfl_up(inc, o); if ((tid & 31) >= o) inc += v; }
        if (tid < 32) { CT[i] = 256u + inc - cnt; CT[33 + i] = c0; CT[66 + i] = cnt; if (i == 31) CT[32] = 256u + inc; } }
    __syncthreads();
    for (int i = j + 1 + w; i < 32; i += 8) { const unsigned c0 = CT[33 + i], cnt = CT[66 + i], dst = CT[i];
        for (unsigned e = lane; e < cnt; e += 64) { const unsigned pr = PAIRS[(size_t)i * 768 + c0 + e]; QL[dst + e] = (unsigned)(i * 256 + (pr & 255u)) | ((pr >> 8) << 13); } }
    __syncthreads();
    qnext = (int)CT[100];
    PBU_END(16);
    PBU_BEGIN(17);
    const int n = (int)CT[32], nitems = (n + 15) >> 4;
    unsigned ent_n = 0u; bf16x8 qn0 = {0, 0, 0, 0, 0, 0, 0, 0}, qn1 = {0, 0, 0, 0, 0, 0, 0, 0}; bool valid_n = false;
    { const int item0 = part + np * w; if (item0 < nitems) { const int e0 = item0 * 16 + lr; valid_n = e0 < n; ent_n = QL[valid_n ? e0 : 0];
        const GAS bf16_t* qp = QN + ((size_t)b * T_ + (ent_n & 8191u)) * 512 + 8 * lg; qn0 = *(const GAS bf16x8*)qp; qn1 = *(const GAS bf16x8*)(qp + 32); } }
    for (int item = part + np * w; item < nitems; item += np * 8) {
        const bool valid = valid_n; const unsigned ent = ent_n;
        const int tok = (int)(ent & 8191u), slot = (int)((ent >> 13) & 3u); const bool own = slot == 3; const int qpos = tok & 255;
        const size_t m = (size_t)b * T_ + tok;
        bf16x8 qb[2]; qb[0] = qn0; qb[1] = qn1;
        { const int itn = item + np * 8; if (itn < nitems) { const int e1 = itn * 16 + lr; valid_n = e1 < n; ent_n = QL[valid_n ? e1 : 0];
            const GAS bf16_t* qp = QN + ((size_t)b * T_ + (ent_n & 8191u)) * 512 + 8 * lg; qn0 = *(const GAS bf16x8*)qp; qn1 = *(const GAS bf16x8*)(qp + 32); } }
        f32x4 sc[16];
#pragma unroll
        for (int g = 0; g < 8; ++g) {
            bf16x8 ka[4];
#pragma unroll
            for (int k2 = 0; k2 < 2; ++k2)
#pragma unroll
                for (int ks = 0; ks < 2; ++ks) ka[2 * k2 + ks] = lds16(KJ + (16 * (2 * g + k2) + lr) * MC_KP + 32 * ks + 8 * lg);
            __builtin_amdgcn_sched_barrier(0);
#pragma unroll
            for (int k2 = 0; k2 < 2; ++k2) { f32x4 a = (f32x4){0.f, 0.f, 0.f, 0.f}; a = MFMA16(ka[2 * k2], qb[0], a); sc[2 * g + k2] = MFMA16(ka[2 * k2 + 1], qb[1], a); }
            __builtin_amdgcn_sched_barrier(0);
        }
        if (item < 16) {
#pragma unroll
            for (int kt = 0; kt < 16; ++kt)
#pragma unroll
                for (int r = 0; r < 4; ++r) if ((16 * kt + 4 * lg + r) > qpos) sc[kt][r] = -1e30f; }
        float mx = -1e30f;
#pragma unroll
        for (int kt = 0; kt < 16; ++kt) { mx = vmax3(mx, sc[kt][0], sc[kt][1]); mx = vmax3(mx, sc[kt][2], sc[kt][3]); }
        mx = fmaxf(mx, __shfl_xor(mx, 16)); mx = fmaxf(mx, __shfl_xor(mx, 32));
        const float cexp = 0.18033688011112042f, mneg = -mx * cexp;
        const f32x2 c2 = {cexp, cexp}, m2 = {mneg, mneg};
        f32x2 ls2 = {0.f, 0.f};
#pragma unroll
        for (int kt = 0; kt < 16; ++kt)
#pragma unroll
            for (int hlf = 0; hlf < 2; ++hlf) { f32x2 t = {sc[kt][2 * hlf], sc[kt][2 * hlf + 1]}; t = t * c2 + m2;
                t.x = __builtin_amdgcn_exp2f(t.x); t.y = __builtin_amdgcn_exp2f(t.y); ls2 = ls2 + t; sc[kt][2 * hlf] = t.x; sc[kt][2 * hlf + 1] = t.y; }
        float lsum = ls2.x + ls2.y;
        lsum += __shfl_xor(lsum, 16); lsum += __shfl_xor(lsum, 32);
        mx *= 0.125f;
        f32x4 o[4];
#pragma unroll
        for (int dv = 0; dv < 4; ++dv) o[dv] = (f32x4){0.f, 0.f, 0.f, 0.f};
#pragma unroll
        for (int g = 0; g < 8; ++g) {
            bf16x8 va[4];
#pragma unroll
            for (int dv = 0; dv < 4; ++dv) { const LAS bf16_t* vp = VT + (16 * dv + lr) * MC_VP + 32 * g + 4 * lg; va[dv] = lds8x2(vp, vp + 16); }
            const bf16x8 pb0 = pack8(sc[2 * g], sc[2 * g + 1]);
            __builtin_amdgcn_sched_barrier(0);
#pragma unroll
            for (int dv = 0; dv < 4; ++dv) o[dv] = MFMA16(va[dv], pb0, o[dv]);
            __builtin_amdgcn_sched_barrier(0);
        }
        const float inv = 1.f / lsum;
        if (valid) { const size_t pbase = ((m * 8 + h) * 4 + slot);
#pragma unroll
            for (int dv = 0; dv < 4; ++dv) { u32x2 pk; pk.x = cvt_pk_bf16(o[dv][0] * inv, o[dv][1] * inv); pk.y = cvt_pk_bf16(o[dv][2] * inv, o[dv][3] * inv);
                *(GAS u32x2*)(PO + pbase * 64 + 16 * dv + 4 * lg) = pk; }
            if (lg == 0) { f32x2 ml; ml.x = mx; ml.y = lsum; *(GAS f32x2*)(PML + pbase * 2) = ml; } }
    }
    PBU_END(17);
}

__device__ __forceinline__ void mb_combine(const Args& args, int gtid, int gthreads) {
    GAS unsigned char* ws = (GAS unsigned char*)args.ws; asm volatile("" : "+s"(ws));
    const GAS bf16_t* PO = (const GAS bf16_t*)(ws + WS_PO); const GAS float* PML = (const GAS float*)(ws + WS_PML); GAS bf16_t* Y = (GAS bf16_t*)(ws + WS_SEG + SEG_MQ);
    for (int idx = gtid; idx < M_ * 8 * 8; idx += gthreads) {
        const int mh = idx >> 3, c8 = idx & 7, m = mh >> 3, h = mh & 7, t = m & (T_ - 1), ib = t >> 8; const int nv = ib < 3 ? ib : 3;
        const size_t base = (size_t)mh * 4;
        float ms[4], ls[4];
#pragma unroll
        for (int s = 0; s < 4; ++s) { const bool on = (s == 3) || (s < nv); const f32x2 ml = on ? *(const GAS f32x2*)(PML + (base + s) * 2) : (f32x2){-1e30f, 0.f}; ms[s] = ml.x; ls[s] = ml.y; }
        const float Mx = fmaxf(fmaxf(ms[0], ms[1]), fmaxf(ms[2], ms[3]));
        float acc[8] = {0.f, 0.f, 0.f, 0.f, 0.f, 0.f, 0.f, 0.f}; float W = 0.f;
#pragma unroll
        for (int s = 0; s < 4; ++s) { const bool on = (s == 3) || (s < nv);
            if (on) { const float wgt = ls[s] * __expf(ms[s] - Mx); W += wgt; const u32x4 raw = *(const GAS u32x4*)(PO + (base + s) * 64 + 8 * c8);
                acc[0] += wgt * bf_lo(raw.x); acc[1] += wgt * bf_hi(raw.x); acc[2] += wgt * bf_lo(raw.y); acc[3] += wgt * bf_hi(raw.y);
                acc[4] += wgt * bf_lo(raw.z); acc[5] += wgt * bf_hi(raw.z); acc[6] += wgt * bf_lo(raw.w); acc[7] += wgt * bf_hi(raw.w); } }
        const float iw = 1.f / W;
        u32x4 o; o.x = cvt_pk_bf16(acc[0] * iw, acc[1] * iw); o.y = cvt_pk_bf16(acc[2] * iw, acc[3] * iw); o.z = cvt_pk_bf16(acc[4] * iw, acc[5] * iw); o.w = cvt_pk_bf16(acc[6] * iw, acc[7] * iw);
        *(GAS u32x4*)(Y + (size_t)m * 512 + h * 64 + 8 * c8) = o;
    }
}
}
namespace mk {
constexpr int PH_PRO = 0, PH_PER_LAYER = 9, PH_WIN = 0, PH_MIXA = 1, PH_MIXB = 2, PH_MIXC = 3, PH_MIXD = 4, PH_BRANCH = 5, PH_WOUT = 6, PH_FF1 = 7, PH_FF2 = 8;
constexpr int PH_TOTAL = 1 + PH_PER_LAYER * DEPTH_;

#ifndef PROBE_MASK
#define PROBE_MASK 0u
#endif
#ifndef PROBE_K
#define PROBE_K 2
#endif
#define PB_BEGIN(x) unsigned long long pb_t0_##x = 0ull; if ((PROBE_MASK >> (x)) & 1u) pb_t0_##x = __builtin_amdgcn_s_memrealtime()
#define PB_END(x) do { if ((PROBE_MASK >> (x)) & 1u) { const unsigned long long t1_ = __builtin_amdgcn_s_memrealtime(); const unsigned long long until_ = t1_ + (unsigned long long)PROBE_K * (t1_ - pb_t0_##x); \
    while (__builtin_amdgcn_s_memrealtime() < until_) __builtin_amdgcn_s_sleep(8); } } while (0)
__global__ void __launch_bounds__(NTHREADS, 2) mk_fwd(Args args) {
    extern __shared__ __attribute__((aligned(16))) unsigned char lds_raw[];
    Frame F;
    F.lds = (LAS unsigned char*)lds_raw;
    F.MISC = (volatile LAS unsigned*)(F.lds + MISC_OFF);
    F.tid = threadIdx.x; F.lane = F.tid & 63; F.wave = __builtin_amdgcn_readfirstlane(F.tid >> 6);
    F.G = gridDim.x; { const int bx = blockIdx.x; F.vcu = (F.G % 8 == 0) ? (bx % 8) * (F.G / 8) + bx / 8 : bx; }
    F.ws = args.ws; F.ctl = (gu32*)(args.ws + WS_CTL);
    for (int u = F.tid; u < (LDS_BYTES - RING_BYTES) / 4; u += NTHREADS) ((LAS unsigned*)(F.lds + RING_BYTES))[u] = 0u;
    __syncthreads();
    XcdBarrier bar = xcd_barrier_post((unsigned*)(F.ctl + CW_BAR) + args.li * XCD_BAR_WORDS, F.MISC + 8);
    const int lo = args.ph_lo, hi = args.ph_hi;
    const int wv = F.wave;
#define IN(k) (lo <= (k) && (k) < hi)
#define SEAM(k) do { if (IN((k) + 1)) { XcdBarrier bq = bar; asm volatile("" : "+s"(bq.bar)); const bool ld_ = ((wv << 6) | lane_id()) == 0; xcd_barrier(bq, ld_); if (PROBE_MASK & 0x40000u) { xcd_barrier(bq, ld_); xcd_barrier(bq, ld_); } } } while (0)
#define OPQ_WS unsigned char* wsq = args.ws; int bxq = blockIdx.x, Gq = gridDim.x, tidq = (wv << 6) | lane_id(); \
    asm volatile("" : "+s"(wsq), "+s"(bxq), "+s"(Gq), "+v"(tidq)); \
    const int vcuq = (Gq % 8 == 0) ? (bxq % 8) * (Gq / 8) + bxq / 8 : bxq; (void)vcuq; (void)tidq
#define WSP(T, off) ((T*)(wsq + (off)))
#define WL(T, off) ((const T*)(wsq + WS_WTS + (size_t)l * WL_STRIDE + (off)))

    if (IN(PH_PRO)) { PB_BEGIN(0); p0_prologue(F, args, 0, DEPTH_, true); PB_END(0); SEAM(PH_PRO); }

    for (int l = 0; l < DEPTH_; ++l) {
        const int pb = 1 + PH_PER_LAYER * l;
        if (hi <= pb || lo >= pb + PH_PER_LAYER) continue;

        if (IN(pb + PH_WIN)) { OPQ_WS; PB_BEGIN(1);
            { pg8::Gemm g{WSP(bf16_t, WS_ACT), WL(bf16_t, WL_WIN)}; pg8::StaticOrder<32> S; S.init(Gq, bxq);
              EpiWin E{WSP(bf16_t, WS_SEG), WSP(float, WS_SS)};
              pg8::gemm_phase<1024, EpiWin, pg8::StaticOrder<32>, true, true>(F.lds, g, S, E, wv); }
            __builtin_amdgcn_sched_barrier(0); asm volatile("" ::: "memory");
            {
              typedef pg8::SplitKOrder<4, 512> TailOrder;
              pg8::Gemm g{WSP(bf16_t, WS_ACT), WL(bf16_t, WL_WIN) + (size_t)8192 * 1024}; TailOrder S; S.init(Gq, bxq);
              EpiSmall E{WSP(float, WS_SMALL), WSP(float, WS_SS)};
              pg8::gemm_phase<256, EpiSmall, TailOrder, false, true, 1024, 1024>(F.lds, g, S, E, wv); }
            PB_END(1); SEAM(pb + PH_WIN);
        }
        if (IN(pb + PH_MIXA)) { OPQ_WS; PB_BEGIN(2);
            { PB_BEGIN(10); if (args.mix & 1) for (int u = vcuq; u < 256; u += Gq) gla_unit<false>(F.lds, args, l, u, wv); PB_END(10); }
            { PB_BEGIN(11); if (args.mix & 2) for (int u = vcuq; u < 256; u += Gq) ml_unit<false>(F.lds, args, l, u, wv); PB_END(11); }
            { PB_BEGIN(12); if (args.mix & 4) for (int u = vcuq; u < 256; u += Gq) mb_prep_unit(F.lds, args, l, u, wv); PB_END(12); }
            PB_END(2); SEAM(pb + PH_MIXA); }
        if (IN(pb + PH_MIXB)) { OPQ_WS; PB_BEGIN(3);
            if (args.mix & 1) gla_scan(args, vcuq * NTHREADS + tidq, Gq * NTHREADS);
            if (args.mix & 2) ml_scan(args, vcuq * NTHREADS + tidq, Gq * NTHREADS);
            if (args.mix & 4) for (int u = vcuq; u < 256; u += Gq) mb_topk_unit(F.lds, args, u, wv);
            PB_END(3); SEAM(pb + PH_MIXB); }
        if (IN(pb + PH_MIXC)) { OPQ_WS; PB_BEGIN(4);
            { PB_BEGIN(13); if (args.mix & 1) for (int u = vcuq; u < 256; u += Gq) gla_unit<true>(F.lds, args, l, u, wv); PB_END(13); }
            { PB_BEGIN(14); if (args.mix & 2) for (int u = vcuq; u < 256; u += Gq) ml_unit<true>(F.lds, args, l, u, wv); PB_END(14); }
            if (args.mix & 4) { PB_BEGIN(15);
                if (tidq == 0) F.MISC[16] = __hip_atomic_fetch_add((unsigned*)((gu32*)wsq + CW_MBQ + 64 * l), 1u, __ATOMIC_RELAXED, __HIP_MEMORY_SCOPE_AGENT);
                __syncthreads();
                int q = (int)F.MISC[16];
                while (q < MB_NUNITS) { int qn; mb_attn_unit(F.lds, args, q, wv, l, qn); q = qn; }
                __syncthreads();
                PB_END(15);
            }
            PB_END(4); SEAM(pb + PH_MIXC); }
        if (IN(pb + PH_MIXD)) { OPQ_WS; PB_BEGIN(5);
            if (args.mix & 4) mb_combine(args, vcuq * NTHREADS + tidq, Gq * NTHREADS);
            PB_END(5); SEAM(pb + PH_MIXD); }
        if (IN(pb + PH_BRANCH)) { OPQ_WS; PB_BEGIN(6);
            static_assert(SEG_MQ - SEG_GG == 16 * MiB && SEG_LO - SEG_MQ == 16 * MiB, "y buffers equally spaced");
            typedef pg8::ZOrder<4, 3, 16 * MiB, 1 * MiB> BrOrder;
            pg8::Gemm g{WSP(bf16_t, WS_SEG + SEG_GG), WL(bf16_t, WL_WBR)}; BrOrder S; S.init(Gq, bxq);
            EpiBranch E{WSP(bf16_t, WS_SEG + SEG_BG), args.in[12] + (size_t)l * 3072, WSP(bf16_t, WS_MIXB)};
            pg8::gemm_phase<512, EpiBranch, BrOrder, true, true>(F.lds, g, S, E, wv);
            PB_END(6); SEAM(pb + PH_BRANCH);
        }
        if (IN(pb + PH_WOUT)) { OPQ_WS; PB_BEGIN(7);
            pg8::Gemm g{WSP(bf16_t, WS_MIXB), WL(bf16_t, WL_WOUT)}; pg8::StaticOrder<4> S; S.init(Gq, bxq);
            EpiRes<false> E{l == 0 ? args.in[0] : args.out, args.out, WSP(bf16_t, WS_ACT), WSP(float, WS_SS), args.in[17] + (size_t)l * 1024, (LAS float*)(F.lds + RING_BYTES + 1024)};
            pg8::gemm_phase<1024, EpiRes<false>, pg8::StaticOrder<4>, true, true>(F.lds, g, S, E, wv);
            PB_END(7); SEAM(pb + PH_WOUT);
        }
        if (IN(pb + PH_FF1)) { OPQ_WS; PB_BEGIN(8);
            pg8::Gemm g{WSP(bf16_t, WS_ACT), WL(bf16_t, WL_FF1)}; pg8::StaticOrder<16> S; S.init(Gq, bxq);
            EpiFf1 E{WSP(bf16_t, WS_H), WSP(float, WS_SS)};
            pg8::gemm_phase<1024, EpiFf1, pg8::StaticOrder<16>, true, true>(F.lds, g, S, E, wv);
            PB_END(8); SEAM(pb + PH_FF1);
        }
        if (IN(pb + PH_FF2)) { OPQ_WS; PB_BEGIN(9);
            pg8::Gemm g{WSP(bf16_t, WS_H), WL(bf16_t, WL_FF2)}; pg8::StaticOrder<4> S; S.init(Gq, bxq);
            if (l < DEPTH_ - 1) { EpiRes<false> E{args.out, args.out, WSP(bf16_t, WS_ACT), WSP(float, WS_SS), args.in[1] + (size_t)(l + 1) * 1024, (LAS float*)(F.lds + RING_BYTES + 1024)};
                pg8::gemm_phase<4096, EpiRes<false>, pg8::StaticOrder<4>, true, true>(F.lds, g, S, E, wv); }
            else { EpiRes<true> E{args.out, args.out, WSP(bf16_t, WS_ACT), WSP(float, WS_SS), args.in[1], (LAS float*)(F.lds + RING_BYTES + 1024)};
                pg8::gemm_phase<4096, EpiRes<true>, pg8::StaticOrder<4>, true, true>(F.lds, g, S, E, wv); }
            PB_END(9); SEAM(pb + PH_FF2);
        }
    }
#undef IN
#undef SEAM
#undef WSP
#undef WL
#undef OPQ_WS
}

static int g_grid = 0;
static bool mk_setup() {
    if (g_grid) return g_grid > 0;
    int dev = 0, cus = 0;
    if (hipGetDevice(&dev) != hipSuccess || hipDeviceGetAttribute(&cus, hipDeviceAttributeMultiprocessorCount, dev) != hipSuccess) { g_grid = -1; return false; }
    if (hipFuncSetAttribute((const void*)mk_fwd, hipFuncAttributeMaxDynamicSharedMemorySize, LDS_BYTES) != hipSuccess) { fprintf(stderr, "mk: hipFuncSetAttribute failed\n"); g_grid = -1; return false; }
    (void)hipGetLastError();
    g_grid = cus;
    return true;
}
static void mk_launch(const Args& base, int lo, int hi, int li, hipStream_t st) {
    Args a = base; a.ph_lo = lo; a.ph_hi = hi; a.li = li;
    hipLaunchKernelGGL(mk_fwd, dim3(g_grid), dim3(NTHREADS), LDS_BYTES, st, a);
}
}
extern "C" void kernel_launch(void* const* d_in, const int* in_sizes, int n_in, void* d_out, int out_size, void* d_ws, size_t ws_size, hipStream_t stream) {
    using namespace mk;
    if (n_in != 20 || out_size != M_ * D_ || ws_size < WS_END) { fprintf(stderr, "kernel_launch: unexpected shapes (n_in %d out %d ws %zu)\n", n_in, out_size, ws_size); return; }
    if (!mk_setup()) return;
    unsigned char* ws = (unsigned char*)d_ws;
    (void)hipMemsetAsync(ws + WS_CTL, 0, CTL_ZERO_BYTES, stream);
    Args a{}; for (int i = 0; i < 20; ++i) a.in[i] = (const float*)d_in[i]; a.out = (float*)d_out; a.ws = ws; a.mix = 7;
    mk_launch(a, 0, PH_TOTAL, 0, stream);
}
```
